# Optimizing an MI355X kernel written in HIP

```python
import math
import jax
import jax.numpy as jnp
from jax import lax
import numpy as np


D_MODEL = 1024
BATCH = 2
SEQ = 8192
DEPTH = 1

GRID_W = 64
CTX_LEN = 256
EPS = 1e-6
NEG_INF = -1e30

D_A = 512
SSM_CPG = 16
SSM_GROUPS = D_A // SSM_CPG
SSM_STATE = 64
DT_MIN = 1e-3
DT_MAX = 1e-1

NA_HEADS = 8
NA_HEAD_DIM = 64
D_B = NA_HEADS * NA_HEAD_DIM
WIN_R = 8
WIN_C = 16
Q_BLOCK = 16
K_BLOCK_W = Q_BLOCK + WIN_C
N_COL_BLOCKS = GRID_W // Q_BLOCK

IN_COLS = D_A + 3 * D_B + 2 * D_MODEL
SPLIT_POINTS = (D_A, D_A + D_B, D_A + 2 * D_B, D_A + 3 * D_B, D_A + 3 * D_B + D_MODEL)

N_EXPERTS = 16
CAPACITY_FACTOR = 2
D_EXPERT = 1024

kernel_name = "hybrid_s5_natten_ec_moe_dit_block"


def rmsnorm(x, g):
    xf = x.astype(jnp.float32)
    y = xf * lax.rsqrt(jnp.mean(xf * xf, axis=-1, keepdims=True) + EPS)
    return (y * g.astype(jnp.float32)).astype(x.dtype)


def modulate(h, shift, scale):
    return h * (1 + scale[:, None, :]) + shift[:, None, :]


def s5_discretize(lam_re, lam_im, log_dt, b_re, b_im):
    lam = lax.complex(lam_re.astype(jnp.float32), lam_im.astype(jnp.float32))
    dt = jnp.exp(log_dt.astype(jnp.float32))[:, None]
    lam_bar = jnp.exp(lam * dt)
    b = lax.complex(b_re.astype(jnp.float32), b_im.astype(jnp.float32))
    b_bar = ((lam_bar - 1.0) / lam)[..., None] * b
    return lam_bar, b_bar


def s5_drive(u, b_bar):
    re = jnp.einsum('bngc,gpc->bngp', u, jnp.real(b_bar))
    im = jnp.einsum('bngc,gpc->bngp', u, jnp.imag(b_bar))
    return lax.complex(re, im)


def s5_readout(xs, c_re, c_im):
    return (jnp.einsum('bngp,gcp->bngc', jnp.real(xs), c_re)
            - jnp.einsum('bngp,gcp->bngc', jnp.imag(xs), c_im))


def _linear_recurrence(e1, e2):
    a1, b1 = e1
    a2, b2 = e2
    return a1 * a2, a2 * b1 + b2


def s5_scan(lam_bar, bu, h0, reverse):
    if h0 is not None:
        first = -1 if reverse else 0
        bu = bu.at[:, first].add(lam_bar * h0)
    a = jnp.broadcast_to(lam_bar, bu.shape)
    _, xs = lax.associative_scan(_linear_recurrence, (a, bu), axis=1, reverse=reverse)
    return xs


def s5_glu(y, w_glu, b_glu):
    a = jax.nn.gelu(y)
    return a * jax.nn.sigmoid(a @ w_glu.astype(jnp.float32) + b_glu.astype(jnp.float32))


def s5_branch(u, u_ctx, lam_re, lam_im, log_dt, b_re, b_im, c_re, c_im, d_skip, w_glu, b_glu, update_ctx):
    bsz, n_lat, _ = u.shape
    n_ctx = u_ctx.shape[1]
    u32 = u.astype(jnp.float32).reshape(bsz, n_lat, SSM_GROUPS, SSM_CPG)
    uc32 = u_ctx.astype(jnp.float32).reshape(bsz, n_ctx, SSM_GROUPS, SSM_CPG)
    d32 = d_skip.astype(jnp.float32).reshape(SSM_GROUPS, SSM_CPG)
    y = u32 * d32
    yc = uc32 * d32 if update_ctx else None
    for direction, reverse in ((0, False), (1, True)):
        lam_bar, b_bar = s5_discretize(lam_re[direction], lam_im[direction], log_dt[direction],
                                       b_re[direction], b_im[direction])
        c_r = c_re[direction].astype(jnp.float32)
        c_i = c_im[direction].astype(jnp.float32)
        xs_ctx = s5_scan(lam_bar, s5_drive(uc32, b_bar), None, reverse)
        h_end = xs_ctx[:, 0] if reverse else xs_ctx[:, -1]
        xs_lat = s5_scan(lam_bar, s5_drive(u32, b_bar), h_end, reverse)
        y = y + s5_readout(xs_lat, c_r, c_i)
        if update_ctx:
            yc = yc + s5_readout(xs_ctx, c_r, c_i)
    out = s5_glu(y.reshape(bsz, n_lat, D_A), w_glu, b_glu).astype(u.dtype)
    out_ctx = s5_glu(yc.reshape(bsz, n_ctx, D_A), w_glu, b_glu).astype(u.dtype) if update_ctx else None
    return out, out_ctx


def na_branch(q, k, v, q_ctx, k_ctx, v_ctx, rpb, update_ctx):
    bsz, n_lat, n_heads, head_dim = q.shape
    rows = n_lat // GRID_W
    win_r = min(WIN_R, rows)
    n_nb = win_r * K_BLOCK_W
    r = jnp.arange(rows)
    row_idx = jnp.clip(r - WIN_R // 2, 0, rows - win_r)[:, None] + jnp.arange(win_r)[None, :]
    blk = jnp.arange(N_COL_BLOCKS)
    col_idx = (jnp.clip(blk * Q_BLOCK - WIN_C // 2, 0, GRID_W - K_BLOCK_W)[:, None]
               + jnp.arange(K_BLOCK_W)[None, :])
    key_row = jnp.repeat(row_idx, K_BLOCK_W, axis=1)
    key_col = jnp.tile(col_idx, (1, win_r))
    tok_idx = key_row[:, None, :] * GRID_W + key_col[None, :, :]
    k_nb = k[:, tok_idx]
    v_nb = v[:, tok_idx]
    q_blk = q.reshape(bsz, rows, N_COL_BLOCKS, Q_BLOCK, n_heads, head_dim)
    s_nb = jnp.einsum('brjqhd,brjkhd->bhrjqk', q_blk, k_nb).astype(jnp.float32)
    q_col = blk[:, None] * Q_BLOCK + jnp.arange(Q_BLOCK)[None, :]
    q_cs = jnp.clip(q_col - WIN_C // 2, 0, GRID_W - WIN_C)
    in_win = ((key_col[:, None, :] >= q_cs[:, :, None])
              & (key_col[:, None, :] < q_cs[:, :, None] + WIN_C))
    d_col = jnp.clip(key_col[:, None, :] - q_col[:, :, None] + WIN_C - 1, 0, 2 * WIN_C - 2)
    d_row = key_row - r[:, None] + WIN_R - 1
    bias = rpb[:, d_row[:, None, None, :], d_col[None]].astype(jnp.float32)
    s_nb = jnp.where(in_win, s_nb + bias, NEG_INF)
    s_ctx = jnp.einsum('bqhd,bkhd->bhqk', q, k_ctx).astype(jnp.float32)
    s_ctx = s_ctx.reshape(bsz, n_heads, rows, N_COL_BLOCKS, Q_BLOCK, -1)
    p = jax.nn.softmax(jnp.concatenate([s_nb, s_ctx], axis=-1), axis=-1).astype(v.dtype)
    o = (jnp.einsum('bhrjqk,brjkhd->brjqhd', p[..., :n_nb], v_nb)
         + jnp.einsum('bhrjqk,bkhd->brjqhd', p[..., n_nb:], v_ctx))
    out = o.reshape(bsz, n_lat, n_heads * head_dim)
    out_ctx = None
    if update_ctx:
        sc = jnp.einsum('bqhd,bkhd->bhqk', q_ctx, k_ctx).astype(jnp.float32)
        pc = jax.nn.softmax(sc, axis=-1).astype(v_ctx.dtype)
        out_ctx = jnp.einsum('bhqk,bkhd->bqhd', pc, v_ctx).reshape(bsz, q_ctx.shape[1], n_heads * head_dim)
    return out, out_ctx


def token_mixer(h, hc, w_in, ssm_lam_re, ssm_lam_im, ssm_log_dt, ssm_b_re, ssm_b_im, ssm_c_re, ssm_c_im,
                ssm_d, w_glu, b_glu, q_norm, k_norm, na_rpb, w_proj_a, w_proj_b, w_out, update_ctx):
    def project(t):
        z = t @ w_in
        u, q, k, v, ga, gb = jnp.split(z, list(SPLIT_POINTS), axis=-1)
        shape = t.shape[:2] + (NA_HEADS, NA_HEAD_DIM)
        q = rmsnorm(q.reshape(shape), q_norm) * (NA_HEAD_DIM ** -0.5)
        k = rmsnorm(k.reshape(shape), k_norm)
        return u, q, k, v.reshape(shape), ga, gb

    def merge(ya, yb, ga, gb):
        return (jax.nn.sigmoid(ga) * (ya @ w_proj_a) + jax.nn.sigmoid(gb) * (yb @ w_proj_b)) @ w_out

    u, q, k, v, ga, gb = project(h)
    uc, qc, kc, vc, gac, gbc = project(hc)
    ya, yac = s5_branch(u, uc, ssm_lam_re, ssm_lam_im, ssm_log_dt, ssm_b_re, ssm_b_im, ssm_c_re, ssm_c_im,
                        ssm_d, w_glu, b_glu, update_ctx)
    yb, ybc = na_branch(q, k, v, qc, kc, vc, na_rpb, update_ctx)
    y = merge(ya, yb, ga, gb)
    yc = merge(yac, ybc, gac, gbc) if update_ctx else None
    return y, yc


def ec_moe_set(h, w_router, w_e_gate, w_e_up, w_e_down):
    n_tok = h.shape[0]
    cap = CAPACITY_FACTOR * n_tok // N_EXPERTS
    aff = jax.nn.softmax((h @ w_router).astype(jnp.float32), axis=-1)
    g, idx = lax.top_k(aff.T, cap)
    xe = h[idx]
    hid = jax.nn.silu(jnp.einsum('ecd,edf->ecf', xe, w_e_gate)) * jnp.einsum('ecd,edf->ecf', xe, w_e_up)
    ye = jnp.einsum('ecf,efd->ecd', hid, w_e_down) * g[..., None].astype(h.dtype)
    return jnp.zeros_like(h).at[idx.reshape(-1)].add(ye.reshape(-1, h.shape[-1]))


def ec_moe(h, w_router, w_e_gate, w_e_up, w_e_down):
    return jax.vmap(ec_moe_set, in_axes=(0, None, None, None, None))(h, w_router, w_e_gate, w_e_up, w_e_down)


def block(x, ctx_s, mod, mod_ctx, norm_mix, norm_ffn, w_in, ssm_lam_re, ssm_lam_im, ssm_log_dt, ssm_b_re,
          ssm_b_im, ssm_c_re, ssm_c_im, ssm_d, w_glu, b_glu, q_norm, k_norm, na_rpb, w_proj_a, w_proj_b,
          w_out, w_router, w_e_gate, w_e_up, w_e_down, update_ctx):
    sh1, sc1, g1, sh2, sc2, g2 = jnp.split(mod, 6, axis=-1)
    csh1, csc1, cg1, csh2, csc2, cg2 = jnp.split(mod_ctx, 6, axis=-1)
    h = modulate(rmsnorm(x, norm_mix), sh1, sc1)
    hc = modulate(rmsnorm(ctx_s, norm_mix), csh1, csc1)
    y, yc = token_mixer(h, hc, w_in, ssm_lam_re, ssm_lam_im, ssm_log_dt, ssm_b_re, ssm_b_im, ssm_c_re,
                        ssm_c_im, ssm_d, w_glu, b_glu, q_norm, k_norm, na_rpb, w_proj_a, w_proj_b, w_out,
                        update_ctx)
    x = x + g1[:, None, :] * y
    h2 = modulate(rmsnorm(x, norm_ffn), sh2, sc2)
    x = x + g2[:, None, :] * ec_moe(h2, w_router, w_e_gate, w_e_up, w_e_down)
    if update_ctx:
        ctx_s = ctx_s + cg1[:, None, :] * yc
        hc2 = modulate(rmsnorm(ctx_s, norm_ffn), csh2, csc2)
        ctx_s = ctx_s + cg2[:, None, :] * ec_moe(hc2, w_router, w_e_gate, w_e_up, w_e_down)
    return x, ctx_s


def setup_inputs(seed: int = 0) -> dict:
    key = jax.random.key(seed)
    ks = jax.random.split(key, 32)
    f32 = jnp.float32

    def nrm(k, shape, s):
        return jax.random.normal(k, shape, f32) * s

    two = 2
    lam_im_base = jnp.pi * jnp.arange(SSM_STATE, dtype=f32)
    return {
        'x': nrm(ks[0], (BATCH, SEQ, D_MODEL), 1.0),
        'c': nrm(ks[1], (BATCH, D_MODEL), 1.0),
        'ctx': nrm(ks[2], (BATCH, CTX_LEN, D_MODEL), 1.0),
        'c_ctx': nrm(ks[3], (D_MODEL,), 1.0),
        'w_ada': nrm(ks[4], (DEPTH, D_MODEL, 6 * D_MODEL), 0.5 * D_MODEL ** -0.5),
        'b_ada': nrm(ks[5], (DEPTH, 6 * D_MODEL), 0.01),
        'norm_mix': 1.0 + nrm(ks[6], (DEPTH, D_MODEL), 0.01),
        'norm_ffn': 1.0 + nrm(ks[7], (DEPTH, D_MODEL), 0.01),
        'w_in': nrm(ks[8], (DEPTH, D_MODEL, IN_COLS), D_MODEL ** -0.5),
        'ssm_lam_re': -0.5 + nrm(ks[9], (DEPTH, two, SSM_GROUPS, SSM_STATE), 0.01),
        'ssm_lam_im': lam_im_base + nrm(ks[10], (DEPTH, two, SSM_GROUPS, SSM_STATE), 0.01),
        'ssm_log_dt': jax.random.uniform(ks[11], (DEPTH, two, SSM_GROUPS), f32,
                                         minval=math.log(DT_MIN), maxval=math.log(DT_MAX)),
        'ssm_b_re': nrm(ks[12], (DEPTH, two, SSM_GROUPS, SSM_STATE, SSM_CPG), (2 * SSM_CPG) ** -0.5),
        'ssm_b_im': nrm(ks[13], (DEPTH, two, SSM_GROUPS, SSM_STATE, SSM_CPG), (2 * SSM_CPG) ** -0.5),
        'ssm_c_re': nrm(ks[14], (DEPTH, two, SSM_GROUPS, SSM_CPG, SSM_STATE), (2 * SSM_STATE) ** -0.5),
        'ssm_c_im': nrm(ks[15], (DEPTH, two, SSM_GROUPS, SSM_CPG, SSM_STATE), (2 * SSM_STATE) ** -0.5),
        'ssm_d': nrm(ks[16], (DEPTH, D_A), 1.0),
        'w_glu': nrm(ks[17], (DEPTH, D_A, D_A), D_A ** -0.5),
        'b_glu': nrm(ks[18], (DEPTH, D_A), 0.01),
        'q_norm': 1.0 + nrm(ks[19], (DEPTH, NA_HEAD_DIM), 0.01),
        'k_norm': 1.0 + nrm(ks[20], (DEPTH, NA_HEAD_DIM), 0.01),
        'na_rpb': nrm(ks[21], (DEPTH, NA_HEADS, 2 * WIN_R - 1, 2 * WIN_C - 1), 0.02),
        'w_proj_a': nrm(ks[22], (DEPTH, D_A, D_MODEL), D_A ** -0.5),
        'w_proj_b': nrm(ks[23], (DEPTH, D_B, D_MODEL), D_B ** -0.5),
        'w_out': nrm(ks[24], (DEPTH, D_MODEL, D_MODEL), D_MODEL ** -0.5),
        'w_router': nrm(ks[25], (DEPTH, D_MODEL, N_EXPERTS), D_MODEL ** -0.5),
        'w_e_gate': nrm(ks[26], (DEPTH, N_EXPERTS, D_MODEL, D_EXPERT), D_MODEL ** -0.5),
        'w_e_up': nrm(ks[27], (DEPTH, N_EXPERTS, D_MODEL, D_EXPERT), D_MODEL ** -0.5),
        'w_e_down': nrm(ks[28], (DEPTH, N_EXPERTS, D_EXPERT, D_MODEL), D_EXPERT ** -0.5),
    }


def reference(x, c, ctx, c_ctx, w_ada, b_ada, norm_mix, norm_ffn, w_in, ssm_lam_re, ssm_lam_im, ssm_log_dt,
              ssm_b_re, ssm_b_im, ssm_c_re, ssm_c_im, ssm_d, w_glu, b_glu, q_norm, k_norm, na_rpb, w_proj_a,
              w_proj_b, w_out, w_router, w_e_gate, w_e_up, w_e_down):
    ctx_s = ctx
    for layer in range(DEPTH):
        update_ctx = layer < DEPTH - 1
        mod = jax.nn.silu(c) @ w_ada[layer] + b_ada[layer]
        mod_ctx = jnp.broadcast_to(jax.nn.silu(c_ctx) @ w_ada[layer] + b_ada[layer], mod.shape)
        x, ctx_s = block(x, ctx_s, mod, mod_ctx, norm_mix[layer], norm_ffn[layer], w_in[layer],
                         ssm_lam_re[layer], ssm_lam_im[layer], ssm_log_dt[layer], ssm_b_re[layer],
                         ssm_b_im[layer], ssm_c_re[layer], ssm_c_im[layer], ssm_d[layer], w_glu[layer],
                         b_glu[layer], q_norm[layer], k_norm[layer], na_rpb[layer], w_proj_a[layer],
                         w_proj_b[layer], w_out[layer], w_router[layer], w_e_gate[layer], w_e_up[layer],
                         w_e_down[layer], update_ctx)
    return x
```

```cpp
#include <hip/hip_runtime.h>
#include <stdint.h>
#include <stdio.h>

typedef unsigned short bf16;
__device__ __forceinline__ float bf2f(bf16 v) { return __uint_as_float(((unsigned)v) << 16); }
__device__ __forceinline__ bf16 f2bf(float f) { unsigned u = __float_as_uint(f); return (bf16)((u + 0x7fffu + ((u >> 16) & 1u)) >> 16); }
__device__ __forceinline__ float silu_f(float x) { return x / (1.f + __expf(-x)); }
__device__ __forceinline__ float sigmoid_f(float x) { return 1.f / (1.f + __expf(-x)); }
__device__ __forceinline__ float gelu_tanh(float y) { return 0.5f * y * (1.f + tanhf(0.7978845608028654f * (y + 0.044715f * y * y * y))); }

constexpr int D = 1024, SEQ = 8192, MLAT = 16384, NCTX = 256, MCTX = 512, MALL = MLAT + MCTX;
constexpr float EPS = 1e-6f;

__global__ void k_ada(const float* c, const float* cctx, const float* w_ada, const float* b_ada, float* mod) {
    const int n = blockIdx.x * 256 + threadIdx.x, ks = blockIdx.y;
    float a0 = 0.f, a1 = 0.f, a2 = 0.f;
    for (int k = ks * 64; k < ks * 64 + 64; ++k) {
        const float w = w_ada[(size_t)k * 6144 + n];
        a0 += silu_f(c[k]) * w; a1 += silu_f(c[1024 + k]) * w; a2 += silu_f(cctx[k]) * w;
    }
    if (ks == 0) { const float bb = b_ada[n]; a0 += bb; a1 += bb; a2 += bb; }
    atomicAdd(&mod[n], a0); atomicAdd(&mod[6144 + n], a1); atomicAdd(&mod[2 * 6144 + n], a2);
}

__device__ __forceinline__ float wave_sum(float v) {
#pragma unroll
    for (int o = 1; o < 64; o <<= 1) v += __shfl_xor(v, o);
    return v;
}

__global__ void k_norm1(const float* x, const float* ctx, const float* gw, const float* mod, bf16* H) {
    const int row = blockIdx.x * 4 + (threadIdx.x >> 6), lane = threadIdx.x & 63;
    if (row >= MALL) return;
    const float* src = row < MLAT ? x + (size_t)row * D : ctx + (size_t)(row - MLAT) * D;
    const float* md = mod + (row < MLAT ? (row >> 13) : 2) * 6144;
    float4 v[4]; float ss = 0.f;
#pragma unroll
    for (int j = 0; j < 4; ++j) { v[j] = *(const float4*)(src + j * 256 + lane * 4); ss += v[j].x * v[j].x + v[j].y * v[j].y + v[j].z * v[j].z + v[j].w * v[j].w; }
    const float r = rsqrtf(wave_sum(ss) * (1.f / D) + EPS);
#pragma unroll
    for (int j = 0; j < 4; ++j) {
        const int col = j * 256 + lane * 4;
        const float4 g = *(const float4*)(gw + col), sh = *(const float4*)(md + col), sc = *(const float4*)(md + 1024 + col);
        bf16* o = H + (size_t)row * D + col;
        o[0] = f2bf(v[j].x * r * g.x * (1.f + sc.x) + sh.x); o[1] = f2bf(v[j].y * r * g.y * (1.f + sc.y) + sh.y);
        o[2] = f2bf(v[j].z * r * g.z * (1.f + sc.z) + sh.z); o[3] = f2bf(v[j].w * r * g.w * (1.f + sc.w) + sh.w);
    }
}

template <class Epi>
__global__ __launch_bounds__(256) void k_gemm(const bf16* A, int lda, long a_gs, const float* W, int ldw, long w_gs, int K, Epi epi) {
    __shared__ float As[16][68];
    __shared__ float Ws[16][64];
    const int g = blockIdx.z, tid = threadIdx.x, tx = tid & 15, ty = tid >> 4;
    const bf16* Ag = A + (size_t)g * a_gs + (size_t)(blockIdx.y * 64) * lda;
    const float* Wg = W + (size_t)(g & 15) * w_gs + blockIdx.x * 64;
    float acc[4][4];
#pragma unroll
    for (int i = 0; i < 4; ++i)
#pragma unroll
        for (int j = 0; j < 4; ++j) acc[i][j] = 0.f;
    const int ar = tid >> 2, ak = (tid & 3) * 4, wk = tid >> 4, wn = (tid & 15) * 4;
    for (int k0 = 0; k0 < K; k0 += 16) {
        const ushort4 av = *(const ushort4*)(Ag + (size_t)ar * lda + k0 + ak);
        const float4 wv = *(const float4*)(Wg + (size_t)(k0 + wk) * ldw + wn);
        __syncthreads();
        As[ak + 0][ar] = bf2f(av.x); As[ak + 1][ar] = bf2f(av.y); As[ak + 2][ar] = bf2f(av.z); As[ak + 3][ar] = bf2f(av.w);
        *(float4*)&Ws[wk][wn] = wv;
        __syncthreads();
#pragma unroll
        for (int k = 0; k < 16; ++k) {
            const float4 a = *(const float4*)&As[k][ty * 4];
            const float4 w = *(const float4*)&Ws[k][tx * 4];
            const float aa[4] = {a.x, a.y, a.z, a.w}, ww[4] = {w.x, w.y, w.z, w.w};
#pragma unroll
            for (int i = 0; i < 4; ++i)
#pragma unroll
                for (int j = 0; j < 4; ++j) acc[i][j] += aa[i] * ww[j];
        }
    }
#pragma unroll
    for (int i = 0; i < 4; ++i)
#pragma unroll
        for (int j = 0; j < 4; ++j) epi(g, blockIdx.y * 64 + ty * 4 + i, blockIdx.x * 64 + tx * 4 + j, acc[i][j]);
}

struct EpiInproj {
    bf16 *U, *V, *SGA, *SGB; float *QF, *KF;
    __device__ void operator()(int, int row, int col, float v) const {
        if (col < 512) U[(size_t)row * 512 + col] = f2bf(v);
        else if (col < 1024) { if (row < MLAT) QF[(size_t)row * 512 + col - 512] = v; }
        else if (col < 1536) KF[(size_t)row * 512 + col - 1024] = v;
        else if (col < 2048) V[(size_t)row * 512 + col - 1536] = f2bf(v);
        else if (col < 3072) { if (row < MLAT) SGA[(size_t)row * 1024 + col - 2048] = f2bf(sigmoid_f(v)); }
        else { if (row < MLAT) SGB[(size_t)row * 1024 + col - 3072] = f2bf(sigmoid_f(v)); }
    }
};
struct EpiGlu { const bf16* Ain; const float* bglu; bf16* YA;
    __device__ void operator()(int, int row, int col, float v) const { const float a = bf2f(Ain[(size_t)row * 512 + col]); YA[(size_t)row * 512 + col] = f2bf(a * sigmoid_f(v + bglu[col])); } };
struct EpiProjA { const bf16* SGA; float* T;
    __device__ void operator()(int, int row, int col, float v) const { T[(size_t)row * 1024 + col] = bf2f(SGA[(size_t)row * 1024 + col]) * v; } };
struct EpiProjB { const bf16* SGB; const float* T; bf16* M;
    __device__ void operator()(int, int row, int col, float v) const { const size_t o = (size_t)row * 1024 + col; M[o] = f2bf(T[o] + bf2f(SGB[o]) * v); } };
struct EpiOut { const float* x; const float* mod; float* X1;
    __device__ void operator()(int, int row, int col, float v) const { const size_t o = (size_t)row * 1024 + col; X1[o] = x[o] + mod[(row >> 13) * 6144 + 2048 + col] * v; } };
struct EpiGate { bf16* HID;
    __device__ void operator()(int g, int row, int col, float v) const { HID[((size_t)g * 1024 + row) * 1024 + col] = f2bf(v); } };
struct EpiUp { bf16* HID;
    __device__ void operator()(int g, int row, int col, float v) const { const size_t o = ((size_t)g * 1024 + row) * 1024 + col; HID[o] = f2bf(silu_f(bf2f(HID[o])) * v); } };
struct EpiDown { const float* GSEL; bf16* Y;
    __device__ void operator()(int g, int row, int col, float v) const { Y[((size_t)g * 1024 + row) * 1024 + col] = f2bf(v * GSEL[g * 1024 + row]); } };

__global__ void k_qknorm(const float* QF, const float* KF, const float* qn, const float* kn, bf16* Q, bf16* Kb) {
    const int gid = blockIdx.x * 256 + threadIdx.x;
    const int h = gid & 7, row = (gid >> 3) % MALL, which = (gid >> 3) / MALL;
    if (which > 1) return;
    if (which == 0 && row >= MLAT) return;
    const float* src = (which ? KF : QF) + (size_t)row * 512 + h * 64;
    const float* w = which ? kn : qn;
    float ss = 0.f;
    for (int d = 0; d < 64; ++d) ss += src[d] * src[d];
    const float r = rsqrtf(ss * (1.f / 64.f) + EPS) * (which ? 1.f : 0.125f);
    bf16* dst = (which ? Kb : Q) + (size_t)row * 512 + h * 64;
    for (int d = 0; d < 64; ++d) dst[d] = f2bf(src[d] * r * w[d]);
}

__global__ __launch_bounds__(64) void k_s5_ref(const bf16* U, const float* lam_re, const float* lam_im, const float* log_dt, const float* b_re, const float* b_im,
                                               const float* c_re, const float* c_im, const float* dskip, float* YS, bf16* Aout) {
    const int b = blockIdx.x >> 5, g = blockIdx.x & 31, p = threadIdx.x, c = p & 15, qtr = p >> 4;
    __shared__ float xs[2][64];
    for (int dir = 0; dir < 2; ++dir) {
        const int dg = dir * 32 + g;
        const float lre = lam_re[dg * 64 + p], lim = lam_im[dg * 64 + p], dt = expf(log_dt[dg]);
        const float er = expf(lre * dt), lbr = er * cosf(lim * dt), lbi = er * sinf(lim * dt);
        const float nr = lbr - 1.f, ni = lbi, den = lre * lre + lim * lim;
        const float cr = (nr * lre + ni * lim) / den, ci = (ni * lre - nr * lim) / den;
        float bbr[16], bbi[16], ccr[16], cci[16];
#pragma unroll
        for (int j = 0; j < 16; ++j) {
            const float br = b_re[(dg * 64 + p) * 16 + j], bi = b_im[(dg * 64 + p) * 16 + j];
            bbr[j] = cr * br - ci * bi; bbi[j] = cr * bi + ci * br;
            ccr[j] = c_re[(dg * 16 + c) * 64 + qtr * 16 + j]; cci[j] = c_im[(dg * 16 + c) * 64 + qtr * 16 + j];
        }
        float xr = 0.f, xi = 0.f;
        for (int step = 0; step < NCTX + SEQ; ++step) {
            int row; const bool lat = step >= NCTX;
            if (!lat) { const int s = dir ? (NCTX - 1 - step) : step; row = MLAT + b * NCTX + s; }
            else { int t = step - NCTX; if (dir) t = SEQ - 1 - t; row = b * SEQ + t; }
            const bf16* up = U + (size_t)row * 512 + g * 16;
            const uint4 u0 = *(const uint4*)up, u1 = *(const uint4*)(up + 8);
            const unsigned uw[8] = {u0.x, u0.y, u0.z, u0.w, u1.x, u1.y, u1.z, u1.w};
            float bur = 0.f, bui = 0.f, myu = 0.f;
#pragma unroll
            for (int j = 0; j < 8; ++j) {
                const float lo = __uint_as_float(uw[j] << 16), hi = __uint_as_float(uw[j] & 0xffff0000u);
                bur += bbr[2 * j] * lo + bbr[2 * j + 1] * hi; bui += bbi[2 * j] * lo + bbi[2 * j + 1] * hi;
                if (c == 2 * j) myu = lo; if (c == 2 * j + 1) myu = hi;
            }
            const float nxr = lbr * xr - lbi * xi + bur, nxi = lbr * xi + lbi * xr + bui; xr = nxr; xi = nxi;
            if (lat) {
                xs[0][p] = xr; xs[1][p] = xi;
                __syncthreads();
                float acc = 0.f;
#pragma unroll
                for (int j = 0; j < 16; ++j) acc += ccr[j] * xs[0][qtr * 16 + j] - cci[j] * xs[1][qtr * 16 + j];
                acc += __shfl_xor(acc, 16); acc += __shfl_xor(acc, 32);
                __syncthreads();
                if (qtr == 0) {
                    const size_t o = (size_t)row * 512 + g * 16 + c;
                    if (dir == 0) YS[o] = acc;
                    else Aout[o] = f2bf(gelu_tanh(YS[o] + acc + myu * dskip[g * 16 + c]));
                }
            }
        }
    }
}

__global__ __launch_bounds__(256) void k_attn_ref(const bf16* Q, const bf16* Kb, const bf16* V, const float* rpb, bf16* YB) {
    const int gid = blockIdx.x * 256 + threadIdx.x, h = gid & 7, row = gid >> 3;
    const int b = row >> 13, t = row & 8191, r = t >> 6, qc = t & 63;
    float q[64], o[64];
    {
        const uint4* qp = (const uint4*)(Q + (size_t)row * 512 + h * 64);
#pragma unroll
        for (int j = 0; j < 8; ++j) { const uint4 w = qp[j]; const unsigned ww[4] = {w.x, w.y, w.z, w.w};
#pragma unroll
            for (int e = 0; e < 4; ++e) { q[j * 8 + e * 2] = __uint_as_float(ww[e] << 16); q[j * 8 + e * 2 + 1] = __uint_as_float(ww[e] & 0xffff0000u); } }
    }
#pragma unroll
    for (int d = 0; d < 64; ++d) o[d] = 0.f;
    const int rs = min(max(r - 4, 0), 120), cs = min(max(qc - 8, 0), 48);
    float m = -1e30f, l = 0.f;
    for (int i = 0; i < 128 + NCTX; ++i) {
        size_t krow; float bias = 0.f;
        if (i < 128) { const int kr = rs + (i >> 4), kc = cs + (i & 15); krow = (size_t)b * SEQ + kr * 64 + kc; bias = rpb[(h * 15 + kr - r + 7) * 31 + kc - qc + 15]; }
        else krow = (size_t)MLAT + b * NCTX + (i - 128);
        const uint4* kp = (const uint4*)(Kb + krow * 512 + h * 64);
        float s = 0.f;
#pragma unroll
        for (int j = 0; j < 8; ++j) { const uint4 w = kp[j]; const unsigned ww[4] = {w.x, w.y, w.z, w.w};
#pragma unroll
            for (int e = 0; e < 4; ++e) s += q[j * 8 + e * 2] * __uint_as_float(ww[e] << 16) + q[j * 8 + e * 2 + 1] * __uint_as_float(ww[e] & 0xffff0000u); }
        s += bias;
        const float mn = fmaxf(m, s), al = __expf(m - mn), pp = __expf(s - mn);
        l = l * al + pp; m = mn;
        const uint4* vp = (const uint4*)(V + krow * 512 + h * 64);
#pragma unroll
        for (int j = 0; j < 8; ++j) { const uint4 w = vp[j]; const unsigned ww[4] = {w.x, w.y, w.z, w.w};
#pragma unroll
            for (int e = 0; e < 4; ++e) { o[j * 8 + e * 2] = o[j * 8 + e * 2] * al + pp * __uint_as_float(ww[e] << 16); o[j * 8 + e * 2 + 1] = o[j * 8 + e * 2 + 1] * al + pp * __uint_as_float(ww[e] & 0xffff0000u); } }
    }
    const float il = 1.f / l;
    bf16* op = YB + (size_t)row * 512 + h * 64;
#pragma unroll
    for (int d = 0; d < 64; ++d) op[d] = f2bf(o[d] * il);
}

__global__ void k_norm2(const float* X1, const float* gw, const float* mod, const float* w_router, bf16* H2, float* AFF) {
    const int row = blockIdx.x * 4 + (threadIdx.x >> 6), lane = threadIdx.x & 63;
    const float* src = X1 + (size_t)row * D;
    const float* md = mod + (row >> 13) * 6144;
    float4 v[4]; float ss = 0.f;
#pragma unroll
    for (int j = 0; j < 4; ++j) { v[j] = *(const float4*)(src + j * 256 + lane * 4); ss += v[j].x * v[j].x + v[j].y * v[j].y + v[j].z * v[j].z + v[j].w * v[j].w; }
    const float r = rsqrtf(wave_sum(ss) * (1.f / D) + EPS);
    float lg[16];
#pragma unroll
    for (int e = 0; e < 16; ++e) lg[e] = 0.f;
#pragma unroll
    for (int j = 0; j < 4; ++j) {
        const int col = j * 256 + lane * 4;
        const float4 g = *(const float4*)(gw + col), sh = *(const float4*)(md + 3072 + col), sc = *(const float4*)(md + 4096 + col);
        const float hv[4] = {v[j].x * r * g.x * (1.f + sc.x) + sh.x, v[j].y * r * g.y * (1.f + sc.y) + sh.y, v[j].z * r * g.z * (1.f + sc.z) + sh.z, v[j].w * r * g.w * (1.f + sc.w) + sh.w};
        bf16* o = H2 + (size_t)row * D + col;
#pragma unroll
        for (int i = 0; i < 4; ++i) {
            o[i] = f2bf(hv[i]);
            const float4* wr = (const float4*)(w_router + (size_t)(col + i) * 16);
#pragma unroll
            for (int e4 = 0; e4 < 4; ++e4) { const float4 w = wr[e4]; lg[e4 * 4] += hv[i] * w.x; lg[e4 * 4 + 1] += hv[i] * w.y; lg[e4 * 4 + 2] += hv[i] * w.z; lg[e4 * 4 + 3] += hv[i] * w.w; }
        }
    }
    float mx = -1e30f;
#pragma unroll
    for (int e = 0; e < 16; ++e) { lg[e] = wave_sum(lg[e]); mx = fmaxf(mx, lg[e]); }
    float sum = 0.f;
#pragma unroll
    for (int e = 0; e < 16; ++e) { lg[e] = expf(lg[e] - mx); sum += lg[e]; }
    if (lane < 16) {
        float mine = 0.f;
#pragma unroll
        for (int e = 0; e < 16; ++e) if (lane == e) mine = lg[e];
        AFF[(size_t)row * 16 + lane] = mine / sum;
    }
}

__global__ __launch_bounds__(1024) void k_topk_ref(const float* AFF, int* IDX, float* GSEL, int* SLOT) {
    __shared__ float vals[8192];
    const int be = blockIdx.x, b = be >> 4, e = be & 15, tid = threadIdx.x;
    for (int i = tid; i < 8192; i += 1024) vals[i] = AFF[((size_t)b * SEQ + i) * 16 + e];
    __syncthreads();
    float v[8]; int rank[8];
#pragma unroll
    for (int k = 0; k < 8; ++k) { v[k] = vals[tid + 1024 * k]; rank[k] = 0; }
    for (int j = 0; j < 8192; ++j) {
        const float vj = vals[j];
#pragma unroll
        for (int k = 0; k < 8; ++k) rank[k] += (vj > v[k] || (vj == v[k] && j < tid + 1024 * k)) ? 1 : 0;
    }
#pragma unroll
    for (int k = 0; k < 8; ++k) {
        const int i = tid + 1024 * k;
        if (rank[k] < 1024) { IDX[be * 1024 + rank[k]] = i; GSEL[be * 1024 + rank[k]] = v[k]; SLOT[be * 8192 + i] = rank[k]; }
        else SLOT[be * 8192 + i] = -1;
    }
}

__global__ void k_gather(const bf16* H2, const int* IDX, bf16* XE) {
    const int slot = blockIdx.x, be = slot >> 10, b = be >> 4;
    const int tok = IDX[slot];
    const uint4* src = (const uint4*)(H2 + ((size_t)b * SEQ + tok) * D);
    uint4* dst = (uint4*)(XE + (size_t)slot * D);
    dst[threadIdx.x] = src[threadIdx.x];
}

__global__ void k_combine(float* out, const float* mod, const int* SLOT, const bf16* Y) {
    const int gid = blockIdx.x * 256 + threadIdx.x;
    const int row = gid >> 8, col = (gid & 255) * 4, b = row >> 13, t = row & 8191;
    float a[4] = {0.f, 0.f, 0.f, 0.f};
    for (int e = 0; e < 16; ++e) {
        const int s = SLOT[(b * 16 + e) * 8192 + t];
        if (s >= 0) { const ushort4 y = *(const ushort4*)(Y + ((size_t)(b * 16 + e) * 1024 + s) * D + col); a[0] += bf2f(y.x); a[1] += bf2f(y.y); a[2] += bf2f(y.z); a[3] += bf2f(y.w); }
    }
    float4 o = *(float4*)(out + (size_t)row * D + col);
    const float4 g2 = *(const float4*)(mod + b * 6144 + 5120 + col);
    o.x += g2.x * a[0]; o.y += g2.y * a[1]; o.z += g2.z * a[2]; o.w += g2.w * a[3];
    *(float4*)(out + (size_t)row * D + col) = o;
}

extern "C" void kernel_launch(void* const* d_in, const int* in_sizes, int n_in, void* d_out, int out_size, void* d_ws, size_t ws_size, hipStream_t stream) {
    const float* x = (const float*)d_in[0]; const float* c = (const float*)d_in[1]; const float* ctx = (const float*)d_in[2]; const float* cctx = (const float*)d_in[3];
    const float* w_ada = (const float*)d_in[4]; const float* b_ada = (const float*)d_in[5]; const float* norm_mix = (const float*)d_in[6]; const float* norm_ffn = (const float*)d_in[7];
    const float* w_in = (const float*)d_in[8]; const float* lam_re = (const float*)d_in[9]; const float* lam_im = (const float*)d_in[10]; const float* log_dt = (const float*)d_in[11];
    const float* b_re = (const float*)d_in[12]; const float* b_im = (const float*)d_in[13]; const float* c_re = (const float*)d_in[14]; const float* c_im = (const float*)d_in[15];
    const float* ssm_d = (const float*)d_in[16]; const float* w_glu = (const float*)d_in[17]; const float* b_glu = (const float*)d_in[18]; const float* q_norm = (const float*)d_in[19];
    const float* k_norm = (const float*)d_in[20]; const float* rpb = (const float*)d_in[21]; const float* w_pa = (const float*)d_in[22]; const float* w_pb = (const float*)d_in[23];
    const float* w_out = (const float*)d_in[24]; const float* w_router = (const float*)d_in[25]; const float* w_eg = (const float*)d_in[26]; const float* w_eu = (const float*)d_in[27];
    const float* w_ed = (const float*)d_in[28];
    float* out = (float*)d_out;
    char* ws = (char*)d_ws;
    const size_t MB = 1u << 20;
    if (ws_size < 300 * MB) { fprintf(stderr, "kernel_launch: workspace too small (%zu)\n", ws_size); return; }
    float* mod = (float*)ws;
    float* AFF = (float*)(ws + 256 * 1024);
    int* IDX = (int*)(ws + 2 * MB); float* GSEL = (float*)(ws + 2 * MB + 256 * 1024); int* SLOT = (int*)(ws + 3 * MB);
    bf16* H = (bf16*)(ws + 4 * MB);
    bf16* Abuf = (bf16*)(ws + 4 * MB); bf16* YA = (bf16*)(ws + 21 * MB);
    char* Bg = ws + 38 * MB;
    bf16* U = (bf16*)(Bg); bf16* V = (bf16*)(Bg + 17 * MB); bf16* Kb = (bf16*)(Bg + 34 * MB); bf16* Q = (bf16*)(Bg + 51 * MB);
    bf16* SGA = (bf16*)(Bg + 68 * MB); bf16* SGB = (bf16*)(Bg + 100 * MB);
    float* KF = (float*)(Bg + 132 * MB);
    bf16* Mm = (bf16*)(Bg + 132 * MB);
    float* YS = (float*)(Bg + 166 * MB);
    bf16* YB = (bf16*)(Bg + 198 * MB);
    float* QF = out;
    bf16* XE = (bf16*)(Bg); bf16* HID = (bf16*)(Bg + 64 * MB); bf16* Y = (bf16*)(Bg + 128 * MB);

    hipMemsetAsync(mod, 0, 3 * 6144 * 4, stream);
    k_ada<<<dim3(24, 16), 256, 0, stream>>>(c, cctx, w_ada, b_ada, mod);
    k_norm1<<<MALL / 4, 256, 0, stream>>>(x, ctx, norm_mix, mod, H);
    k_gemm<EpiInproj><<<dim3(4096 / 64, MALL / 64, 1), 256, 0, stream>>>(H, 1024, 0, w_in, 4096, 0, 1024, EpiInproj{U, V, SGA, SGB, QF, KF});
    k_qknorm<<<(MALL * 8 * 2 + 255) / 256, 256, 0, stream>>>(QF, KF, q_norm, k_norm, Q, Kb);
    k_s5_ref<<<64, 64, 0, stream>>>(U, lam_re, lam_im, log_dt, b_re, b_im, c_re, c_im, ssm_d, YS, Abuf);
    k_attn_ref<<<MLAT * 8 / 256, 256, 0, stream>>>(Q, Kb, V, rpb, YB);
    k_gemm<EpiGlu><<<dim3(512 / 64, MLAT / 64, 1), 256, 0, stream>>>(Abuf, 512, 0, w_glu, 512, 0, 512, EpiGlu{Abuf, b_glu, YA});
    k_gemm<EpiProjA><<<dim3(1024 / 64, MLAT / 64, 1), 256, 0, stream>>>(YA, 512, 0, w_pa, 1024, 0, 512, EpiProjA{SGA, out});
    k_gemm<EpiProjB><<<dim3(1024 / 64, MLAT / 64, 1), 256, 0, stream>>>(YB, 512, 0, w_pb, 1024, 0, 512, EpiProjB{SGB, out, Mm});
    k_gemm<EpiOut><<<dim3(1024 / 64, MLAT / 64, 1), 256, 0, stream>>>(Mm, 1024, 0, w_out, 1024, 0, 1024, EpiOut{x, mod, out});
    bf16* H2 = H;
    k_norm2<<<MLAT / 4, 256, 0, stream>>>(out, norm_ffn, mod, w_router, H2, AFF);
    k_topk_ref<<<32, 1024, 0, stream>>>(AFF, IDX, GSEL, SLOT);
    k_gather<<<32768, 128, 0, stream>>>(H2, IDX, XE);
    k_gemm<EpiGate><<<dim3(1024 / 64, 1024 / 64, 32), 256, 0, stream>>>(XE, 1024, (long)1024 * 1024, w_eg, 1024, (long)1024 * 1024, 1024, EpiGate{HID});
    k_gemm<EpiUp><<<dim3(1024 / 64, 1024 / 64, 32), 256, 0, stream>>>(XE, 1024, (long)1024 * 1024, w_eu, 1024, (long)1024 * 1024, 1024, EpiUp{HID});
    k_gemm<EpiDown><<<dim3(1024 / 64, 1024 / 64, 32), 256, 0, stream>>>(HID, 1024, (long)1024 * 1024, w_ed, 1024, (long)1024 * 1024, 1024, EpiDown{GSEL, Y});
    k_combine<<<MLAT * 256 / 256, 256, 0, stream>>>(out, mod, SLOT, Y);
}
```

```cpp
#include <hip/hip_runtime.h>
#include <cstdio>
#include <cstdint>
#include <stdint.h>

__device__ __forceinline__ float bf2f(unsigned short v) { return __uint_as_float(((unsigned)v) << 16); }
__device__ __forceinline__ float silu_f(float x) { return x / (1.f + __expf(-x)); }
__device__ __forceinline__ float sigmoid_f(float x) { return 1.f / (1.f + __expf(-x)); }
__device__ __forceinline__ float gelu_tanh(float y) { return 0.5f * y * (1.f + tanhf(0.7978845608028654f * (y + 0.044715f * y * y * y))); }

constexpr int D = 1024, SEQ = 8192, MLAT = 16384, NCTX = 256, MCTX = 512, MALL = MLAT + MCTX;
constexpr float EPS = 1e-6f;
namespace pg8 {
#define PG8_LAS __attribute__((address_space(3)))
typedef unsigned short bf16_t;
typedef short bf16x8 __attribute__((ext_vector_type(8)));
typedef float f32x4 __attribute__((ext_vector_type(4)));
typedef unsigned u32x4 __attribute__((ext_vector_type(4)));
constexpr int BM = 256, BK = 64, HALF = 128, HTB = HALF * BK * 2  , STAGE_BYTES = 8 * HTB, NXCD = 8, WGM = 8;

__host__ __device__ __forceinline__ int lds_byte(int r, int c) { const int st = (r >> 4) * 2 + (c >> 5), rr = r & 15, cc = c & 31, ob = rr * 64 + cc * 2; return st * 1024 + (ob ^ (((ob >> 9) & 1) << 5)); }
__host__ __device__ __forceinline__ void stage_rc(int b, int& R, int& C) { const int st = b / 1024, sb = b % 1024, swz = sb ^ (((sb >> 9) & 1) << 5); R = (st >> 1) * 16 + swz / 64; C = (st & 1) * 32 + (swz % 64) / 2; }
__host__ __device__ __forceinline__ int perm32(int rho) { const int n = rho >> 4, i = rho & 15; return 8 * (i >> 2) + 4 * n + (i & 3); }

struct Unit { int pm, pn; };
struct Gemm { const bf16_t* A; const bf16_t* Bt; int M, N, K; };

struct StaticOrder {
    int nM, nN, nwg, G, c;
    __host__ __device__ void init(int M, int N, int G_, int c_) { nM = M / BM; nN = N / BM; nwg = nM * nN; G = G_; c = c_; }
    __host__ __device__ bool next(int i, Unit& u) const {
        const long L = (long)i * G + c; if (L >= nwg) return false;
        int wgid = (int)L; { const int q = nwg / NXCD, r = nwg % NXCD, xcd = wgid % NXCD, off = wgid / NXCD; wgid = (xcd < r ? xcd * (q + 1) : r * (q + 1) + (xcd - r) * q) + off; }
        const int nig = WGM * nN, gid = wgid / nig, fm = gid * WGM, gsz = (nM - fm) < WGM ? (nM - fm) : WGM;
        u.pm = fm + ((wgid % nig) % gsz); u.pn = (wgid % nig) / gsz; return true;
    }
    __device__ __forceinline__ void a_ready(const Unit&) const {}
    __device__ __forceinline__ void done(const Unit&) const {}
};

__device__ __forceinline__ unsigned cvt_pk_bf16(float lo, float hi) { unsigned r; asm volatile("v_cvt_pk_bf16_f32 %0, %1, %2" : "=v"(r) : "v"(lo), "v"(hi)); return r; }
typedef float f32x2 __attribute__((ext_vector_type(2)));
typedef unsigned u32x2 __attribute__((ext_vector_type(2)));
__device__ __forceinline__ u32x4 pack8(const f32x4 a, const f32x4 b) { u32x4 w; w.x = cvt_pk_bf16(a[0], a[1]); w.y = cvt_pk_bf16(a[2], a[3]); w.z = cvt_pk_bf16(b[0], b[1]); w.w = cvt_pk_bf16(b[2], b[3]); return w; }
__device__ __forceinline__ f32x4 sig4(const f32x4 v) { f32x4 r; r[0] = sigmoid_f(v[0]); r[1] = sigmoid_f(v[1]); r[2] = sigmoid_f(v[2]); r[3] = sigmoid_f(v[3]); return r; }
__device__ __forceinline__ void unpack8(const u32x4 w, f32x4& a, f32x4& b) {
    a[0] = __uint_as_float(w.x << 16); a[1] = __uint_as_float(w.x & 0xffff0000u); a[2] = __uint_as_float(w.y << 16); a[3] = __uint_as_float(w.y & 0xffff0000u);
    b[0] = __uint_as_float(w.z << 16); b[1] = __uint_as_float(w.z & 0xffff0000u); b[2] = __uint_as_float(w.w << 16); b[3] = __uint_as_float(w.w & 0xffff0000u); }

struct OneUnit {
    int pm, pn;
    __device__ bool next(int i, Unit& u) const { u.pm = pm; u.pn = pn; return i == 0; }
    __device__ __forceinline__ void a_ready(const Unit&) const {}
    __device__ __forceinline__ void done(const Unit&) const {}
};
struct InprojOrder {
    StaticOrder so; int G, c; bool with_ctx;
    __device__ void init(int G_, int c_, bool wc_) { so.init(MLAT, 4096, G_, c_); G = G_; c = c_; with_ctx = wc_; }
    __device__ bool next(int i, Unit& u) const {
        const long L = (long)i * G + c; if (L < 1024) return so.next(i, u);
        const int r = (int)(L - 1024); if (r >= 12 || !with_ctx) return false;
        const int j = r % 6; u.pm = 64 + r / 6; u.pn = j < 2 ? j : j + 2; return true;
    }
    __device__ __forceinline__ void a_ready(const Unit&) const {}
    __device__ __forceinline__ void done(const Unit&) const {}
};
struct EpiInproj {
    static constexpr bool PERM = true, AFTER_DRAIN = false, MID = false;
    bf16_t *U, *Q, *K, *V, *SGA, *SGB; const float *qn, *kn;
    __device__ __forceinline__ void operator()(const f32x4 (&acc)[2][2][4][2], const Unit& u, int wr, int wc, int fr, int fq) const {
        const int row0 = u.pm * BM + wr * 64 + fr, pn = u.pn;
        if (pn < 2 || pn == 6 || pn == 7) {
            bf16_t* base = (pn < 2 ? U : V) + (pn & 1) * 256 + wc * 32 + 8 * fq;
#pragma unroll
            for (int ai = 0; ai < 2; ++ai)
#pragma unroll
                for (int m = 0; m < 4; ++m) { bf16_t* rowp = base + (size_t)(row0 + ai * HALF + m * 16) * 512;
#pragma unroll
                    for (int bj = 0; bj < 2; ++bj) *(u32x4*)(rowp + bj * HALF) = pack8(acc[ai][bj][m][0], acc[ai][bj][m][1]); }
        } else if (pn < 6) {
            const bool isq = pn < 4; const float* wn = isq ? qn : kn; const float sc = isq ? 0.125f : 1.f;
            bf16_t* base = (isq ? Q : K) + ((pn & 1) * 4 + wc) * 64 + 8 * fq;
            f32x4 wv[2][2];
#pragma unroll
            for (int bj = 0; bj < 2; ++bj)
#pragma unroll
                for (int n = 0; n < 2; ++n) wv[bj][n] = *(const f32x4*)(wn + 32 * bj + 8 * fq + 4 * n);
#pragma unroll
            for (int ai = 0; ai < 2; ++ai)
#pragma unroll
                for (int m = 0; m < 4; ++m) {
                    float ss = 0.f;
#pragma unroll
                    for (int bj = 0; bj < 2; ++bj)
#pragma unroll
                        for (int n = 0; n < 2; ++n) { const f32x4 x = acc[ai][bj][m][n]; ss += (x[0] * x[0] + x[1] * x[1]) + (x[2] * x[2] + x[3] * x[3]); }
                    ss += __shfl_xor(ss, 16); ss += __shfl_xor(ss, 32);
                    const float r = rsqrtf(ss * (1.f / 64.f) + EPS) * sc;
                    bf16_t* rowp = base + (size_t)(row0 + ai * HALF + m * 16) * 512;
#pragma unroll
                    for (int bj = 0; bj < 2; ++bj) *(u32x4*)(rowp + bj * 32) = pack8(acc[ai][bj][m][0] * r * wv[bj][0], acc[ai][bj][m][1] * r * wv[bj][1]);
                }
        } else {
            bf16_t* base = (pn < 12 ? SGA : SGB) + ((pn - 8) & 3) * 256 + wc * 32 + 8 * fq;
#pragma unroll
            for (int ai = 0; ai < 2; ++ai)
#pragma unroll
                for (int m = 0; m < 4; ++m) { bf16_t* rowp = base + (size_t)(row0 + ai * HALF + m * 16) * 1024;
#pragma unroll
                    for (int bj = 0; bj < 2; ++bj) *(u32x4*)(rowp + bj * HALF) = pack8(sig4(acc[ai][bj][m][0]), sig4(acc[ai][bj][m][1])); }
        }
    }
};
struct EpiGlu {
    static constexpr bool PERM = true, AFTER_DRAIN = false, MID = false;
    const bf16_t* Ain; const float* bglu; bf16_t* YA; int ldo;
    __device__ __forceinline__ void operator()(const f32x4 (&acc)[2][2][4][2], const Unit& u, int wr, int wc, int fr, int fq) const {
        const int row0 = u.pm * BM + wr * 64 + fr, col0 = u.pn * BM + wc * 32 + 8 * fq;
        f32x4 bv[2][2];
#pragma unroll
        for (int bj = 0; bj < 2; ++bj)
#pragma unroll
            for (int n = 0; n < 2; ++n) bv[bj][n] = *(const f32x4*)(bglu + col0 + bj * HALF + 4 * n);
#pragma unroll
        for (int ai = 0; ai < 2; ++ai)
#pragma unroll
            for (int m = 0; m < 4; ++m) { const size_t off = (size_t)(row0 + ai * HALF + m * 16) * 512 + col0, offo = (size_t)(row0 + ai * HALF + m * 16) * ldo + col0;
#pragma unroll
                for (int bj = 0; bj < 2; ++bj) { f32x4 a0, a1; unpack8(*(const u32x4*)(Ain + off + bj * HALF), a0, a1);
                    *(u32x4*)(YA + offo + bj * HALF) = pack8(a0 * sig4(acc[ai][bj][m][0] + bv[bj][0]), a1 * sig4(acc[ai][bj][m][1] + bv[bj][1])); } }
    }
};
struct EpiMerge {
    static constexpr bool PERM = true, AFTER_DRAIN = false, MID = true;
    const bf16_t* SGA; const bf16_t* SGB; bf16_t* Mo;
    __device__ __forceinline__ void mid(f32x4 (&acc)[2][2][4][2], const Unit& u, int wr, int wc, int fr, int fq) const {
        int row0_ = u.pm * BM + wr * 64 + fr, col0_ = u.pn * BM + wc * 32 + 8 * fq;
        asm volatile("" : "+v"(row0_), "+v"(col0_));
        const int row0 = row0_, col0 = col0_;
#pragma unroll
        for (int ai = 0; ai < 2; ++ai)
#pragma unroll
            for (int m = 0; m < 4; ++m) { const size_t off = (size_t)(row0 + ai * HALF + m * 16) * 1024 + col0;
#pragma unroll
                for (int bj = 0; bj < 2; ++bj) { f32x4 a0, a1, b0, b1; unpack8(*(const u32x4*)(SGA + off + bj * HALF), a0, a1); unpack8(*(const u32x4*)(SGB + off + bj * HALF), b0, b1);
#pragma unroll
                    for (int e = 0; e < 4; ++e) { acc[ai][bj][m][0][e] *= a0[e] * __builtin_amdgcn_rcpf(b0[e]); acc[ai][bj][m][1][e] *= a1[e] * __builtin_amdgcn_rcpf(b1[e]); } }
                if (m == 3) __builtin_amdgcn_sched_barrier(0); }
    }
    __device__ __forceinline__ void operator()(const f32x4 (&acc)[2][2][4][2], const Unit& u, int wr, int wc, int fr, int fq) const {
        int row0_ = u.pm * BM + wr * 64 + fr, col0_ = u.pn * BM + wc * 32 + 8 * fq;
        asm volatile("" : "+v"(row0_), "+v"(col0_));
        const int row0 = row0_, col0 = col0_;
#pragma unroll
        for (int ai = 0; ai < 2; ++ai)
#pragma unroll
            for (int m = 0; m < 4; ++m) { const size_t off = (size_t)(row0 + ai * HALF + m * 16) * 1024 + col0;
#pragma unroll
                for (int bj = 0; bj < 2; ++bj) { f32x4 b0, b1; unpack8(*(const u32x4*)(SGB + off + bj * HALF), b0, b1);
                    *(u32x4*)(Mo + off + bj * HALF) = pack8(acc[ai][bj][m][0] * b0, acc[ai][bj][m][1] * b1); } }
    }
};
struct ExpertGather { const int* idx; __device__ __forceinline__ unsigned row(int pm, int r) const { return (unsigned)((pm >> 6) * SEQ + idx[pm * BM + r]); } };
struct EpiOut {
    static constexpr bool PERM = false, AFTER_DRAIN = false, MID = false;
    const float* x; const float* mod; float* X1;
    __device__ __forceinline__ void operator()(const f32x4 (&acc)[2][2][4][2], const Unit& u, int wr, int wc, int fr, int fq) const {
        const int row0 = u.pm * BM + wr * 64 + fr, col0 = u.pn * BM + wc * 32 + 4 * fq;
        const float* g1 = mod + ((u.pm * BM) >> 13) * 6144 + 2048;
        f32x4 gv[2][2];
#pragma unroll
        for (int bj = 0; bj < 2; ++bj)
#pragma unroll
            for (int n = 0; n < 2; ++n) gv[bj][n] = *(const f32x4*)(g1 + col0 + bj * HALF + n * 16);
#pragma unroll
        for (int ai = 0; ai < 2; ++ai)
#pragma unroll
            for (int m = 0; m < 4; ++m) { const size_t off = (size_t)(row0 + ai * HALF + m * 16) * 1024 + col0;
#pragma unroll
                for (int bj = 0; bj < 2; ++bj)
#pragma unroll
                    for (int n = 0; n < 2; ++n) *(f32x4*)(X1 + off + bj * HALF + n * 16) = *(const f32x4*)(x + off + bj * HALF + n * 16) + gv[bj][n] * acc[ai][bj][m][n]; }
    }
};
struct EpiHid {
    static constexpr bool PERM = true, AFTER_DRAIN = false, MID = false;
    bf16_t* HID;
    __device__ __forceinline__ void operator()(const f32x4 (&acc)[2][2][4][2], const Unit& u, int wr, int wc, int fr, int fq) const {
        const int row0 = u.pm * BM + wr * 64 + fr, f0 = (u.pn & 7) * 128 + wc * 16 + 4 * fq;
#pragma unroll
        for (int ai = 0; ai < 2; ++ai)
#pragma unroll
            for (int m = 0; m < 4; ++m) { bf16_t* rowp = HID + (size_t)(row0 + ai * HALF + m * 16) * 1024 + f0;
#pragma unroll
                for (int bj = 0; bj < 2; ++bj) { const f32x4 g = acc[ai][bj][m][0], up = acc[ai][bj][m][1];
                    u32x2 w; w.x = cvt_pk_bf16(silu_f(g[0]) * up[0], silu_f(g[1]) * up[1]); w.y = cvt_pk_bf16(silu_f(g[2]) * up[2], silu_f(g[3]) * up[3]);
                    *(u32x2*)(rowp + bj * 64) = w; } }
    }
};
struct EpiDown {
    static constexpr bool PERM = true, AFTER_DRAIN = false, MID = false;
    const float* GSEL; bf16_t* Y;
    __device__ __forceinline__ void operator()(const f32x4 (&acc)[2][2][4][2], const Unit& u, int wr, int wc, int fr, int fq) const {
        const int row0 = u.pm * BM + wr * 64 + fr, col0 = (u.pn & 3) * BM + wc * 32 + 8 * fq;
#pragma unroll
        for (int ai = 0; ai < 2; ++ai)
#pragma unroll
            for (int m = 0; m < 4; ++m) { const int row = row0 + ai * HALF + m * 16; const float gs = GSEL[row]; bf16_t* rowp = Y + (size_t)row * 1024 + col0;
#pragma unroll
                for (int bj = 0; bj < 2; ++bj) *(u32x4*)(rowp + bj * HALF) = pack8(acc[ai][bj][m][0] * gs, acc[ai][bj][m][1] * gs); }
    }
};
template <int NT  > struct ExpertOrder {
    int G, c;
    __device__ void init(int G_, int c_) { G = G_; c = c_; }
    __device__ bool next(int i, Unit& u) const {
        constexpr int UPE = 8 * NT;
        long L = (long)i * G + c; if (L >= 16 * UPE) return false;
        if (G == 256) { const int xcd = c & 7, local = c >> 3, rpe = UPE / 32  ; L = (long)(xcd + 8 * (i / rpe)) * UPE + (i % rpe) * 32 + local; }
        const int e = (int)(L / UPE), uu = (int)(L % UPE), b = uu / (4 * NT), m = (uu / NT) & 3, j = uu % NT;
        u.pm = (b * 16 + e) * 4 + m; u.pn = e * NT + j; return true;
    }
    __device__ __forceinline__ void a_ready(const Unit&) const {}
    __device__ __forceinline__ void done(const Unit&) const {}
};
struct NoGather { __device__ __forceinline__ unsigned row(int, int r) const { return (unsigned)r; } };
template <class Epi, class Sched, bool ALIGN_EPI = false, bool GATHER = false, class Gat = NoGather>
__device__ __forceinline__ void gemm_phase(PG8_LAS unsigned char* lds, const Gemm g, const Sched& S, const Epi& E, const Gat gat = Gat()) {
    const int tid = threadIdx.x, wid = __builtin_amdgcn_readfirstlane(tid >> 6), lane = tid & 63, wr = wid >> 2, wc = wid & 3, fr = lane & 15, fq = lane >> 4;
    const int K = g.K, nt = K / BK;
    const size_t kstep = (size_t)(BK * 2);
    const size_t hstep = (size_t)HALF * K * 2;
    const size_t tstep = 2 * hstep;
    unsigned voffB[2]; int Ra[2], Ca[2];
#pragma unroll
    for (int i = 0; i < 2; ++i) { int R, C; stage_rc(tid * 16 + i * 8192, R, C); const int Rb = Epi::PERM ? ((R & ~31) + perm32(R & 31)) : R;
        Ra[i] = R; Ca[i] = C; voffB[i] = (unsigned)(Rb * K + C) * 2u; }
    unsigned vAc[2][2], vAn[2][2];
#define PG8_AOFF(dst, pm) do { _Pragma("unroll") for (int h_ = 0; h_ < 2; ++h_) _Pragma("unroll") for (int i_ = 0; i_ < 2; ++i_) \
        dst[h_][i_] = GATHER ? (gat.row((pm), h_ * HALF + Ra[i_]) * (unsigned)K + (unsigned)Ca[i_]) * 2u : (unsigned)((h_ * HALF + Ra[i_]) * K + Ca[i_]) * 2u; } while (0)
    const unsigned ldsw = (unsigned)wid * 1024u;
    const int aoff = lds_byte(wr * 64 + fr, fq * 8), boff = lds_byte(wc * 32 + fr, fq * 8);
#define PG8_SA(b, h) (((b) * 2 + (h)) * HTB)
#define PG8_SB(b, h) ((4 + (b) * 2 + (h)) * HTB)
#define PG8_STAGE(bufoff, gbase, voff) do { _Pragma("unroll") for (int _i = 0; _i < 2; ++_i) \
        __builtin_amdgcn_global_load_lds((const unsigned*)((const char*)(gbase) + (voff)[_i]), (PG8_LAS unsigned*)(lds + (bufoff) + ldsw + _i * 8192), 16, 0, 0); } while (0)
#define PG8_LDA(dst, b, h) do { _Pragma("unroll") for (int m = 0; m < 4; ++m) _Pragma("unroll") for (int k = 0; k < 2; ++k) dst[m][k] = *(const PG8_LAS bf16x8*)(lds + PG8_SA(b, h) + aoff + m * 2048 + k * 1024); } while (0)
#define PG8_LDB(dst, b, h) do { _Pragma("unroll") for (int n = 0; n < 2; ++n) _Pragma("unroll") for (int k = 0; k < 2; ++k) dst[n][k] = *(const PG8_LAS bf16x8*)(lds + PG8_SB(b, h) + boff + n * 2048 + k * 1024); } while (0)
#define PG8_MMA(ai, bj, At, Bt) do { __builtin_amdgcn_s_setprio(1); _Pragma("unroll") for (int m = 0; m < 4; ++m) _Pragma("unroll") for (int n = 0; n < 2; ++n) _Pragma("unroll") for (int k = 0; k < 2; ++k) \
        acc[ai][bj][m][n] = __builtin_amdgcn_mfma_f32_16x16x32_bf16(Bt[n][k], At[m][k], acc[ai][bj][m][n], 0, 0, 0); __builtin_amdgcn_s_setprio(0); } while (0)
#define PG8_WAIT_V(n) asm volatile("s_waitcnt vmcnt(" #n ")" ::: "memory")
#define PG8_WAIT_L(n) asm volatile("s_waitcnt lgkmcnt(" #n ")" ::: "memory")
#define PG8_BAR __builtin_amdgcn_s_barrier()
#define PG8_SCHED __builtin_amdgcn_sched_barrier(0)
    Unit cur, nxt; int ui = 0;
    if (!S.next(0, cur)) return;
    f32x4 acc[2][2][4][2];
#pragma unroll
    for (int a = 0; a < 2; ++a)
#pragma unroll
        for (int b = 0; b < 2; ++b)
#pragma unroll
            for (int m = 0; m < 4; ++m)
#pragma unroll
                for (int n = 0; n < 2; ++n) acc[a][b][m][n] = (f32x4){0.f, 0.f, 0.f, 0.f};
    bf16x8 At[4][2], B0[2][2], B1[2][2];
    const char* cA = (const char*)g.A + (GATHER ? (size_t)0 : (size_t)cur.pm * tstep); const char* cB = (const char*)g.Bt + (size_t)cur.pn * tstep;
    PG8_AOFF(vAc, cur.pm);
    S.a_ready(cur);
    PG8_STAGE(PG8_SB(0, 0), cB, voffB); PG8_STAGE(PG8_SB(0, 1), cB + hstep, voffB); PG8_STAGE(PG8_SA(0, 0), cA, vAc[0]); PG8_STAGE(PG8_SA(0, 1), cA, vAc[1]);
    if (wr == 1) PG8_BAR;
    PG8_WAIT_V(2); PG8_BAR;
    PG8_STAGE(PG8_SB(1, 0), cB + kstep, voffB); PG8_STAGE(PG8_SA(1, 0), cA + kstep, vAc[0]); PG8_STAGE(PG8_SB(1, 1), cB + hstep + kstep, voffB);
    PG8_WAIT_V(6); PG8_BAR;
    for (;;) {
        const bool has_next = S.next(ui + 1, nxt);
        const char* nA = (has_next && !GATHER) ? (const char*)g.A + (size_t)nxt.pm * tstep : cA; const char* nB = has_next ? (const char*)g.Bt + (size_t)nxt.pn * tstep : cB;
        if (has_next) PG8_AOFF(vAn, nxt.pm); else { _Pragma("unroll") for (int h_ = 0; h_ < 2; ++h_) _Pragma("unroll") for (int i_ = 0; i_ < 2; ++i_) vAn[h_][i_] = vAc[h_][i_]; }
        for (int t = 0; t < nt; t += 2) {
            const bool last = (t == nt - 2);
            const char* a1 = cA + (size_t)(t + 1) * kstep;
            const char* a2 = last ? nA : cA + (size_t)(t + 2) * kstep; const char* b2 = last ? nB : cB + (size_t)(t + 2) * kstep;
            const char* a3 = a2 + kstep; const char* b3 = b2 + kstep;
            unsigned v2[2][2];
#pragma unroll
            for (int h_ = 0; h_ < 2; ++h_)
#pragma unroll
                for (int i_ = 0; i_ < 2; ++i_) v2[h_][i_] = last ? vAn[h_][i_] : vAc[h_][i_];
            if (last && has_next) S.a_ready(nxt);
            PG8_LDB(B0, 0, 0); PG8_LDB(B1, 0, 1); PG8_SCHED; PG8_LDA(At, 0, 0); PG8_STAGE(PG8_SA(1, 1), a1, vAc[1]);
            PG8_WAIT_V(8); PG8_WAIT_L(0); PG8_BAR; PG8_MMA(0, 0, At, B0); PG8_MMA(0, 1, At, B1); PG8_BAR; PG8_SCHED;
            PG8_LDA(At, 0, 1); PG8_STAGE(PG8_SB(0, 0), b2, voffB); PG8_STAGE(PG8_SB(0, 1), b2 + hstep, voffB); PG8_STAGE(PG8_SA(0, 0), a2, v2[0]);
            PG8_WAIT_V(8); PG8_WAIT_L(0); PG8_BAR; PG8_MMA(1, 0, At, B0); PG8_MMA(1, 1, At, B1); PG8_BAR; PG8_SCHED;
            PG8_LDB(B0, 1, 0); PG8_LDB(B1, 1, 1); PG8_SCHED; PG8_LDA(At, 1, 0); PG8_STAGE(PG8_SA(0, 1), a2, v2[1]);
            PG8_WAIT_V(8); PG8_WAIT_L(0); PG8_BAR; PG8_MMA(0, 0, At, B0); PG8_MMA(0, 1, At, B1); PG8_BAR; PG8_SCHED;
            PG8_LDA(At, 1, 1); PG8_STAGE(PG8_SB(1, 0), b3, voffB); PG8_STAGE(PG8_SB(1, 1), b3 + hstep, voffB); PG8_STAGE(PG8_SA(1, 0), a3, v2[0]);
            PG8_WAIT_V(8); PG8_WAIT_L(0); PG8_BAR; PG8_MMA(1, 0, At, B0); PG8_MMA(1, 1, At, B1); PG8_BAR; PG8_SCHED;
            if constexpr (Epi::MID) { if (t == nt / 2 - 2) { E.mid(acc, cur, wr, wc, fr, fq); PG8_SCHED; } }
        }
        if constexpr (ALIGN_EPI) { if (wr == 0) PG8_BAR; }
        if constexpr (!Epi::AFTER_DRAIN) { E(acc, cur, wr, wc, fr, fq); S.done(cur); }
        if (!has_next) break;
#pragma unroll
        for (int a = 0; a < 2; ++a)
#pragma unroll
            for (int b = 0; b < 2; ++b)
#pragma unroll
                for (int m = 0; m < 4; ++m)
#pragma unroll
                    for (int n = 0; n < 2; ++n) acc[a][b][m][n] = (f32x4){0.f, 0.f, 0.f, 0.f};
        cur = nxt; cA = nA; cB = nB; ++ui;
#pragma unroll
        for (int h_ = 0; h_ < 2; ++h_)
#pragma unroll
            for (int i_ = 0; i_ < 2; ++i_) vAc[h_][i_] = vAn[h_][i_];
        if constexpr (ALIGN_EPI) { if (wr == 1) PG8_BAR; }
    }
    PG8_WAIT_V(0);
    if constexpr (!ALIGN_EPI) { if (wr == 0) PG8_BAR; }
    PG8_BAR;
    if constexpr (Epi::AFTER_DRAIN) { E.fused(acc, cur, wr, wc, fr, fq, lds, wid, lane); S.done(cur); }
#undef PG8_AOFF
#undef PG8_SA
#undef PG8_SB
#undef PG8_STAGE
#undef PG8_LDA
#undef PG8_LDB
#undef PG8_MMA
#undef PG8_WAIT_V
#undef PG8_WAIT_L
#undef PG8_BAR
#undef PG8_SCHED
}
}
#define GAS __attribute__((address_space(1)))
#define LAS __attribute__((address_space(3)))
typedef unsigned short bf16;
typedef unsigned v4u __attribute__((ext_vector_type(4)));
typedef float f32x4 __attribute__((ext_vector_type(4)));
typedef short bf16x8 __attribute__((ext_vector_type(8)));
typedef GAS unsigned gu32;
typedef GAS unsigned long long gu64;
#define RLX_AGENT __ATOMIC_RELAXED, __HIP_MEMORY_SCOPE_AGENT
#define LDS_WAIT() asm volatile("s_waitcnt lgkmcnt(0)" ::: "memory")
#define VM_WAIT() asm volatile("s_waitcnt vmcnt(0)" ::: "memory")
__device__ __forceinline__ unsigned long long rt() { return __builtin_amdgcn_s_memrealtime(); }
__device__ __forceinline__ unsigned f2bf(float f) { unsigned u = __builtin_bit_cast(unsigned, f); return (u + 0x7fffu + ((u >> 16) & 1u)) >> 16; }
__device__ __forceinline__ unsigned pk2(float lo, float hi) { return f2bf(lo) | (f2bf(hi) << 16); }

#define XB_TMO      128
#define XB_XCNT(j)  (256  + 64 * (j))
#define XB_XSUB(j)  (1280 + 64 * (j))
#define XB_XGEN(j)  (2304 + 64 * (j))
#define XB_TOP      3328
#define XB_TOPGEN   3392
#define XCD_BAR_WORDS 3456
#define XB_SPIN_CAP (1u << 18)

__device__ __forceinline__ unsigned xb_ld(unsigned* p)              { return __hip_atomic_load(p, __ATOMIC_RELAXED, __HIP_MEMORY_SCOPE_AGENT); }
__device__ __forceinline__ unsigned xb_add(unsigned* p, unsigned v) { return __hip_atomic_fetch_add(p, v, __ATOMIC_RELAXED, __HIP_MEMORY_SCOPE_AGENT); }
__device__ __forceinline__ unsigned xb_xcc_id() { return (unsigned)__builtin_amdgcn_s_getreg((3 << 11) | 20) & 0xFu; }
#define XB_SPIN(cond, bar) do { unsigned _sp = 0; while (cond) { __builtin_amdgcn_s_sleep(1); \
    if ((++_sp & 255u) == 0u) { if (xb_ld(&(bar)[XB_TMO])) break; if (_sp > XB_SPIN_CAP) { atomicAdd(&(bar)[XB_TMO], 1u); break; } } } } while (0)

struct XcdBarrier {
    unsigned* bar; unsigned x;
    volatile LAS unsigned* st;
};

__device__ __forceinline__ XcdBarrier xcd_barrier_post(unsigned* bar, volatile LAS unsigned* st) {
    XcdBarrier b; b.bar = bar; b.x = xb_xcc_id(); b.st = st;
    if (threadIdx.x == 0) (void)xb_add(&bar[XB_XCNT(b.x)], 1u);
    return b;
}
__device__ __forceinline__ void xcd_barrier_complete(unsigned* bar, unsigned x, unsigned& nloc, unsigned& nx) {
    const unsigned G = gridDim.x * gridDim.y * gridDim.z;
    unsigned sum, cnt, mine, sp = 0u;
    for (;;) {
        sum = 0u; cnt = 0u; mine = 0u;
#pragma unroll
        for (unsigned j = 0; j < 16; ++j) { const unsigned c = xb_ld(&bar[XB_XCNT(j)]); sum += c; cnt += (c > 0u) ? 1u : 0u; mine = (j == x) ? c : mine; }
        if (sum == G) break;
        __builtin_amdgcn_s_sleep(1);
        if ((++sp & 255u) == 0u) { if (xb_ld(&bar[XB_TMO])) break; if (sp > XB_SPIN_CAP) { atomicAdd(&bar[XB_TMO], 1u); break; } }
    }
    nloc = mine > 0u ? mine : 1u; nx = cnt > 0u ? cnt : 1u;
}

__device__ __forceinline__ void xcd_barrier(const XcdBarrier& b) {
    asm volatile("s_waitcnt vmcnt(0)" ::: "memory");
    __syncthreads();
    if (threadIdx.x == 0) {
        unsigned* bar = b.bar;
        __builtin_amdgcn_s_waitcnt(0);
        unsigned nloc = b.st[0], nx = b.st[1];
        if (nloc == 0u) { xcd_barrier_complete(bar, b.x, nloc, nx); b.st[0] = nloc; b.st[1] = nx; }
        const unsigned old = xb_add(&bar[XB_XSUB(b.x)], 1u);
        const unsigned gen = old / nloc;
        if (old + 1u == (gen + 1u) * nloc) {
            __builtin_amdgcn_fence(__ATOMIC_RELEASE, "agent");
            asm volatile("s_waitcnt vmcnt(0)" ::: "memory");
            const unsigned og = xb_add(&bar[XB_TOP], 1u);
            const unsigned tg = og / nx;
            if (og + 1u == (tg + 1u) * nx) xb_add(&bar[XB_TOPGEN], 1u);
            else XB_SPIN(xb_ld(&bar[XB_TOPGEN]) == tg, bar);
            __builtin_amdgcn_fence(__ATOMIC_ACQUIRE, "agent");
            xb_add(&bar[XB_XGEN(b.x)], 1u);
            asm volatile("s_waitcnt vmcnt(0)" ::: "memory");
        } else {
            XB_SPIN(xb_ld(&bar[XB_XGEN(b.x)]) == gen, bar);
            __builtin_amdgcn_fence(__ATOMIC_ACQUIRE, "agent");
            asm volatile("s_waitcnt vmcnt(0)" ::: "memory");
        }
    }
    __syncthreads();
}

#ifndef PROBE_MASK
#define PROBE_MASK 0
#endif
constexpr int NWAVES = 8;
constexpr size_t MiB = 1u << 20;
constexpr size_t WS_CTL = 0, CTL_ZERO_BYTES = 256 * 1024;
constexpr int CW_TMO = 0, CW_CODE = 1, CW_BAR = 4096;
constexpr size_t WS_MOD = 160 * 1024;
constexpr size_t WS_AFF = 1 * MiB, WS_IDX = 2 * MiB, WS_GSEL = 2 * MiB + 256 * 1024, WS_SLOT = 3 * MiB;
constexpr size_t WS_H = 4 * MiB;
constexpr size_t WS_BG = 38 * MiB;
constexpr size_t WS_U = WS_BG, WS_V = WS_BG + 17 * MiB, WS_K = WS_BG + 34 * MiB, WS_Q = WS_BG + 51 * MiB, WS_SGA = WS_BG + 68 * MiB, WS_SGB = WS_BG + 100 * MiB;
constexpr size_t WS_YS = WS_BG + 132 * MiB, WS_YAB = WS_BG + 156 * MiB;
constexpr size_t WS_M = WS_BG;
constexpr size_t WS_XE = WS_BG, WS_WGU = WS_SGA, WS_HID = WS_BG + 132 * MiB;
constexpr size_t WS_WIN = 226 * MiB, WS_WGLU = 234 * MiB, WS_WPA = 235 * MiB, WS_WOUT = 237 * MiB;
constexpr size_t WS_WD = 239 * MiB, WS_END = 271 * MiB;
static_assert(WS_YAB + 32 * MiB <= WS_WIN && WS_HID + 64 * MiB <= WS_WD && WS_XE + 64 * MiB <= WS_WGU && WS_WGU + 64 * MiB <= WS_HID && WS_WOUT + 2 * MiB <= WS_WD, "d_ws map");
static_assert(CW_BAR * 4 + 8 * XCD_BAR_WORDS * 4 <= (int)WS_MOD && WS_MOD + 3 * 6144 * 4 <= CTL_ZERO_BYTES, "control region");

constexpr int RING_OFF = 0, RING_BYTES = 131072;
constexpr int LDSCTL_OFF = RING_BYTES, MISC_OFF = LDSCTL_OFF + 320;
constexpr int LDS_BYTES = 147456;

__device__ __forceinline__ float wave_sum(float v) {
#pragma unroll
    for (int o = 1; o < 64; o <<= 1) v += __shfl_xor(v, o);
    return v;
}
template <int MODE> __device__ __forceinline__ int wrow(int n) {
    if (MODE == 1) { const int t = n >> 8, cl = n & 255; return (t >= 2 && t < 6) ? (t * 256 + 128 * ((cl >> 5) & 1) + 32 * (cl >> 6) + (cl & 31)) : n; }
    if (MODE == 2) return (n >> 2) * 8 + (n & 3);
    if (MODE == 3) return (n >> 2) * 8 + 4 + (n & 3);
    return n;
}
template <int MODE> __device__ __forceinline__ void transpose_item(const float* W, int K, int N, bf16* WT, int ldw, LAS float* scr, int item, int lane) {
    const int nblk = N / 32, kb = item / nblk, nb = item % nblk, k0 = 64 * kb, n0 = 32 * nb;
    f32x4 ld[8];
#pragma unroll
    for (int i = 0; i < 8; ++i) ld[i] = *(const f32x4*)(W + (size_t)(k0 + 8 * i + (lane >> 3)) * N + n0 + 4 * (lane & 7));
#pragma unroll
    for (int i = 0; i < 8; ++i) { LAS float* d = scr + (8 * i + (lane >> 3)) * 33 + 4 * (lane & 7); d[0] = ld[i][0]; d[1] = ld[i][1]; d[2] = ld[i][2]; d[3] = ld[i][3]; }
    LDS_WAIT(); asm volatile("" ::: "memory");
    const int c = lane & 7;
#pragma unroll
    for (int j = 0; j < 4; ++j) { const int n = (lane >> 3) + 8 * j; const LAS float* s = scr + (8 * c) * 33 + n;
        v4u o; o.x = pk2(s[0 * 33], s[1 * 33]); o.y = pk2(s[2 * 33], s[3 * 33]); o.z = pk2(s[4 * 33], s[5 * 33]); o.w = pk2(s[6 * 33], s[7 * 33]);
        *(GAS v4u*)(WT + (size_t)wrow<MODE>(n0 + n) * ldw + k0 + 8 * c) = o; }
    LDS_WAIT(); asm volatile("" ::: "memory");
}

__device__ __forceinline__ void norm1_rows(const float* src0, bf16* dst0, int nrow, const float* gwt, const float* md, int lane) {
    f32x4 ca[4], cb[4];
#pragma unroll
    for (int j = 0; j < 4; ++j) { const int col = j * 256 + lane * 4; ca[j] = *(const f32x4*)(gwt + col) * (*(const f32x4*)(md + 1024 + col) + 1.f); cb[j] = *(const f32x4*)(md + col); }
    for (int rr = 0; rr < nrow; rr += 2) {
        const int rb_ = (rr + 1 < nrow) ? rr + 1 : rr;
        const float* sa = src0 + (size_t)rr * D; const float* sb = src0 + (size_t)rb_ * D;
        f32x4 va[4], vb[4]; float ssa = 0.f, ssb = 0.f;
#pragma unroll
        for (int j = 0; j < 4; ++j) { va[j] = *(const f32x4*)(sa + j * 256 + lane * 4); vb[j] = *(const f32x4*)(sb + j * 256 + lane * 4); }
#pragma unroll
        for (int j = 0; j < 4; ++j) { ssa += (va[j][0] * va[j][0] + va[j][1] * va[j][1]) + (va[j][2] * va[j][2] + va[j][3] * va[j][3]); ssb += (vb[j][0] * vb[j][0] + vb[j][1] * vb[j][1]) + (vb[j][2] * vb[j][2] + vb[j][3] * vb[j][3]); }
        const float ra = rsqrtf(wave_sum(ssa) * (1.f / D) + EPS), rb = rsqrtf(wave_sum(ssb) * (1.f / D) + EPS);
#pragma unroll
        for (int j = 0; j < 4; ++j) {
            const int col = j * 256 + lane * 4;
            const f32x4 oa = va[j] * ra * ca[j] + cb[j], ob = vb[j] * rb * ca[j] + cb[j];
            pg8::u32x2 w; w.x = pk2(oa[0], oa[1]); w.y = pk2(oa[2], oa[3]); *(pg8::u32x2*)(dst0 + (size_t)rr * D + col) = w;
            w.x = pk2(ob[0], ob[1]); w.y = pk2(ob[2], ob[3]); *(pg8::u32x2*)(dst0 + (size_t)rb_ * D + col) = w;
        }
    }
}

struct Args { const float* in[29]; float* out; unsigned char* ws; int ph_lo, ph_hi, li, pad; };
enum { I_X = 0, I_C, I_CTX, I_CCTX, I_WADA, I_BADA, I_NMIX, I_NFFN, I_WIN, I_LRE, I_LIM, I_LDT, I_BRE, I_BIM, I_CRE, I_CIM, I_SD, I_WGLU, I_BGLU, I_QN, I_KN, I_RPB, I_WPA, I_WPB, I_WOUT, I_WR, I_WEG, I_WEU, I_WED };

typedef float f32x16 __attribute__((ext_vector_type(16)));
constexpr int S5_CH = 64, S5_NCH = 132, S5_NST = S5_CH / 16, S5_NPAIR = S5_NCH / 2, S5_NLAT = SEQ / S5_CH, S5_NCC = NCTX / S5_CH;
constexpr size_t WS_LAM = 512 * 1024, WS_LAMP = 512 * 1024 + 32768;
constexpr size_t WS_S5B = 2 * MiB + 512 * 1024, WS_S5C = 2 * MiB + 768 * 1024;
constexpr size_t WS_SEND = WS_YS, WS_HIN = WS_YS + 12 * MiB;

__device__ __forceinline__ void s5_prep(const Args& args, unsigned char* ws, int dg, int lane) {
    const float* lam_re = args.in[I_LRE]; const float* lam_im = args.in[I_LIM]; const float* b_re = args.in[I_BRE]; const float* b_im = args.in[I_BIM];
    const float* c_re = args.in[I_CRE]; const float* c_im = args.in[I_CIM];
    const float dt = expf(args.in[I_LDT][dg]);
    {
        const int p = lane; const float lre = lam_re[dg * 64 + p], lim = lam_im[dg * 64 + p];
        const float er = expf(lre * dt); float xr = er * cosf(lim * dt), xi = er * sinf(lim * dt);
        float* L = (float*)(ws + WS_LAM) + (dg * 64 + p) * 2; L[0] = xr; L[1] = xi;
#pragma unroll
        for (int s = 0; s < 6; ++s) { const float nr = xr * xr - xi * xi, ni = 2.f * xr * xi; xr = nr; xi = ni; }
        float* LP = (float*)(ws + WS_LAMP) + (dg * 64 + p) * 2; LP[0] = xr; LP[1] = xi;
    }
    const int r = lane & 31, h = lane >> 5;
#pragma unroll
    for (int q = 0; q < 4; ++q) {
        const int p = 2 * r + (q >> 1); const float lre = lam_re[dg * 64 + p], lim = lam_im[dg * 64 + p];
        const float er = expf(lre * dt), lbr = er * cosf(lim * dt), lbi = er * sinf(lim * dt);
        const float nr = lbr - 1.f, ni = lbi, den = lre * lre + lim * lim, cr = (nr * lre + ni * lim) / den, ci = (ni * lre - nr * lim) / den;
        unsigned w[4];
#pragma unroll
        for (int jj = 0; jj < 8; jj += 2) {
            float v[2];
#pragma unroll
            for (int e = 0; e < 2; ++e) { const int c = 8 * h + jj + e; const float br = b_re[(dg * 64 + p) * 16 + c], bi = b_im[(dg * 64 + p) * 16 + c]; v[e] = (q & 1) ? (cr * bi + ci * br) : (cr * br - ci * bi); }
            w[jj >> 1] = pk2(v[0], v[1]);
        }
        *(v4u*)(ws + WS_S5B + ((size_t)(dg * 4 + q) * 64 + lane) * 16) = (v4u){w[0], w[1], w[2], w[3]};
    }
    const int ch = lane & 15, fq = lane >> 4;
#pragma unroll
    for (int ks = 0; ks < 4; ++ks) {
        unsigned w[4];
#pragma unroll
        for (int jj = 0; jj < 8; jj += 2) { const int st = (32 * ks + 8 * fq + jj) >> 1;
            w[jj >> 1] = pk2(c_re[(dg * 16 + ch) * 64 + st], -c_im[(dg * 16 + ch) * 64 + st]); }
        *(v4u*)(ws + WS_S5C + ((size_t)(dg * 4 + ks) * 64 + lane) * 16) = (v4u){w[0], w[1], w[2], w[3]};
    }
}
__device__ __forceinline__ int s5_row(int b, int dir, int pos) {
    if (pos < NCTX) return MLAT + b * NCTX + (dir ? NCTX - 1 - pos : pos);
    const int t = pos - NCTX; return b * SEQ + (dir ? SEQ - 1 - t : t);
}
#define S5_SCAN16(D0, D1, D2, D3) do { _Pragma("unroll") for (int r_ = 0; r_ < 16; ++r_) { \
        const float n0r = fmaf(lm[0], x[0], fmaf(-lm[1], x[1], D0[r_])), n0i = fmaf(lm[0], x[1], fmaf(lm[1], x[0], D1[r_])); \
        const float n1r = fmaf(lm[2], x[2], fmaf(-lm[3], x[3], D2[r_])), n1i = fmaf(lm[2], x[3], fmaf(lm[3], x[2], D3[r_])); \
        x[0] = n0r; x[1] = n0i; x[2] = n1r; x[3] = n1i; D0[r_] = n0r; D1[r_] = n0i; D2[r_] = n1r; D3[r_] = n1i; } } while (0)

#define S5_SCAN16_ONE(Dr, Di, LR, LI, XR, XI) do { _Pragma("unroll") for (int r_ = 0; r_ < 16; ++r_) { \
        const float nr_ = fmaf(LR, XR, fmaf(-(LI), XI, Dr[r_])), ni_ = fmaf(LR, XI, fmaf(LI, XR, Di[r_])); XR = nr_; XI = ni_; Dr[r_] = nr_; Di[r_] = ni_; } } while (0)
__device__ __forceinline__ void s5_pass1(unsigned char* ws, int task, int lane) {
    const int chain = task / S5_NPAIR, w = task % S5_NPAIR, g = chain & 31, dir = (chain >> 5) & 1, b = chain >> 6, dg = dir * 32 + g;
    const bf16* U = (const bf16*)(ws + WS_U);
    bf16x8 Bf[4];
#pragma unroll
    for (int q = 0; q < 4; ++q) Bf[q] = *(const bf16x8*)(ws + WS_S5B + ((size_t)(dg * 4 + q) * 64 + lane) * 16);
    const f32x4 lm = *(const f32x4*)((const float*)(ws + WS_LAM) + (dg * 64 + 2 * (lane & 31)) * 2);
    const int i = lane & 31, hhA = (i >> 2) & 1, ti = (i & 3) + 4 * (i >> 3), h = lane >> 5;
    float x[4] = {0.f, 0.f, 0.f, 0.f};
    const f32x16 z = {0.f, 0.f, 0.f, 0.f, 0.f, 0.f, 0.f, 0.f, 0.f, 0.f, 0.f, 0.f, 0.f, 0.f, 0.f, 0.f};
#pragma unroll 1
    for (int step = 0; step < S5_NST; ++step) {
        const int row = s5_row(b, dir, (2 * w + hhA) * S5_CH + step * 16 + ti);
        const bf16x8 a = *(const bf16x8*)(U + (size_t)row * 512 + g * 16 + 8 * h);
        f32x16 D0 = __builtin_amdgcn_mfma_f32_32x32x16_bf16(a, Bf[0], z, 0, 0, 0), D1 = __builtin_amdgcn_mfma_f32_32x32x16_bf16(a, Bf[1], z, 0, 0, 0);
        f32x16 D2 = __builtin_amdgcn_mfma_f32_32x32x16_bf16(a, Bf[2], z, 0, 0, 0), D3 = __builtin_amdgcn_mfma_f32_32x32x16_bf16(a, Bf[3], z, 0, 0, 0);
        S5_SCAN16(D0, D1, D2, D3);
    }
    float* S = (float*)(ws + WS_SEND) + ((size_t)chain * S5_NCH + 2 * w + h) * 128 + 4 * (lane & 31);
    *(f32x4*)S = (f32x4){x[0], x[1], x[2], x[3]};
}
__device__ __forceinline__ void s5_pass2(unsigned char* ws, int gid) {
    const int chain = gid >> 6, p = gid & 63, dg = chain & 63;
    const float lr = ((const float*)(ws + WS_LAMP))[(dg * 64 + p) * 2], li = ((const float*)(ws + WS_LAMP))[(dg * 64 + p) * 2 + 1];
    const float* S = (const float*)(ws + WS_SEND) + (size_t)chain * S5_NCH * 128 + 2 * p; float* H = (float*)(ws + WS_HIN) + (size_t)chain * S5_NCH * 128 + 2 * p;
    float xr = 0.f, xi = 0.f;
    for (int q0 = 0; q0 < S5_NCH; q0 += 6) {
        float sr[6], si[6];
#pragma unroll
        for (int e = 0; e < 6; ++e) { sr[e] = S[(q0 + e) * 128]; si[e] = S[(q0 + e) * 128 + 1]; }
#pragma unroll
        for (int e = 0; e < 6; ++e) { H[(q0 + e) * 128] = xr; H[(q0 + e) * 128 + 1] = xi;
            const float nr = fmaf(lr, xr, fmaf(-li, xi, sr[e])), ni = fmaf(lr, xi, fmaf(li, xr, si[e])); xr = nr; xi = ni; }
    }
}
__device__ __forceinline__ void s5_pass3(const Args& args, unsigned char* ws, LAS unsigned char* xt  , int task, int lane) {
    const int w = task & 63, g = (task >> 6) & 31, b = task >> 11;
    const bf16* U = (const bf16*)(ws + WS_U); bf16* Ao = (bf16*)(ws + WS_H);
    const int i = lane & 31, hhA = (i >> 2) & 1, ti = (i & 3) + 4 * (i >> 3), h = lane >> 5, j = lane & 31, fq = lane >> 4, ch = lane & 15;
    f32x4 yacc[S5_NST][2];
    const f32x16 z = {0.f, 0.f, 0.f, 0.f, 0.f, 0.f, 0.f, 0.f, 0.f, 0.f, 0.f, 0.f, 0.f, 0.f, 0.f, 0.f};
#pragma unroll
    for (int dir = 0; dir < 2; ++dir) {
        const int dg = dir * 32 + g, chain = (b * 2 + dir) * 32 + g;
        bf16x8 Bf[4], Cf[4];
#pragma unroll
        for (int q = 0; q < 4; ++q) { Bf[q] = *(const bf16x8*)(ws + WS_S5B + ((size_t)(dg * 4 + q) * 64 + lane) * 16); Cf[q] = *(const bf16x8*)(ws + WS_S5C + ((size_t)(dg * 4 + q) * 64 + lane) * 16); }
        const f32x4 lm = *(const f32x4*)((const float*)(ws + WS_LAM) + (dg * 64 + 2 * j) * 2);
        const int cl = 2 * w + h, qc = dir ? (S5_NCC + S5_NLAT - 1 - cl) : (cl + S5_NCC);
        const f32x4 x0 = *(const f32x4*)((const float*)(ws + WS_HIN) + ((size_t)chain * S5_NCH + qc) * 128 + 4 * j);
        float x[4] = {x0[0], x0[1], x0[2], x0[3]};
#pragma unroll
        for (int step = 0; step < S5_NST; ++step) {
            const int n = step * 16 + ti, t = (2 * w + hhA) * S5_CH + (dir ? S5_CH - 1 - n : n);
            const bf16x8 a = *(const bf16x8*)(U + ((size_t)b * SEQ + t) * 512 + g * 16 + 8 * h);
            {   f32x16 D0 = __builtin_amdgcn_mfma_f32_32x32x16_bf16(a, Bf[0], z, 0, 0, 0), D1 = __builtin_amdgcn_mfma_f32_32x32x16_bf16(a, Bf[1], z, 0, 0, 0);
                S5_SCAN16_ONE(D0, D1, lm[0], lm[1], x[0], x[1]);
#pragma unroll
                for (int r = 0; r < 16; ++r) *(LAS unsigned*)(xt + (h * 16 + r) * 272 + 8 * j) = pg8::cvt_pk_bf16(D0[r], D1[r]); }
            {   f32x16 D2 = __builtin_amdgcn_mfma_f32_32x32x16_bf16(a, Bf[2], z, 0, 0, 0), D3 = __builtin_amdgcn_mfma_f32_32x32x16_bf16(a, Bf[3], z, 0, 0, 0);
                S5_SCAN16_ONE(D2, D3, lm[2], lm[3], x[2], x[3]);
#pragma unroll
                for (int r = 0; r < 16; ++r) *(LAS unsigned*)(xt + (h * 16 + r) * 272 + 8 * j + 4) = pg8::cvt_pk_bf16(D2[r], D3[r]); }
            asm volatile("s_waitcnt lgkmcnt(0)" ::: "memory");
            const int rs = dir ? 15 - ch : ch;
#pragma unroll
            for (int hr = 0; hr < 2; ++hr) {
                f32x4 acc = {0.f, 0.f, 0.f, 0.f};
#pragma unroll
                for (int ks = 0; ks < 4; ++ks) { const bf16x8 af = *(const LAS bf16x8*)(xt + (hr * 16 + rs) * 272 + ks * 64 + 16 * fq);
                    acc = __builtin_amdgcn_mfma_f32_16x16x32_bf16(af, Cf[ks], acc, 0, 0, 0); }
                if (dir == 0) yacc[step][hr] = acc; else yacc[S5_NST - 1 - step][hr] += acc;
            }
            asm volatile("s_waitcnt lgkmcnt(0)" ::: "memory");
            __builtin_amdgcn_sched_barrier(0);
        }
    }
    const float dsk = args.in[I_SD][g * 16 + ch];
#pragma unroll
    for (int s = 0; s < S5_NST; ++s)
#pragma unroll
        for (int hr = 0; hr < 2; ++hr)
#pragma unroll
            for (int e = 0; e < 4; ++e) { const size_t o = ((size_t)b * SEQ + (2 * w + hr) * S5_CH + 16 * s + 4 * fq + e) * 512 + g * 16 + ch;
                Ao[o] = (bf16)f2bf(gelu_tanh(yacc[s][hr][e] + bf2f(U[o]) * dsk)); }
}
__device__ __forceinline__ int block_incl_scan(int v, int* scr, int lane, int wave, int& total) {
    int x = v;
#pragma unroll
    for (int o = 1; o < 64; o <<= 1) { const int y = __shfl_up(x, o); if (lane >= o) x += y; }
    if (lane == 63) scr[wave] = x;
    __syncthreads();
    int base = 0, tot = 0;
#pragma unroll
    for (int w = 0; w < 8; ++w) { const int s = scr[w]; if (w < wave) base += s; tot += s; }
    __syncthreads();
    total = tot; return x + base;
}
__device__ __forceinline__ void topk_select(unsigned char* ws, unsigned char* lds_g, int be, int tid, int lane, int wave) {
    unsigned* vals = (unsigned*)lds_g; int* hist = (int*)(lds_g + 32768); int* scr = (int*)(lds_g + 49152);
    const int b = be >> 4, e = be & 15;
    const float* AFF = (const float*)(ws + WS_AFF); int* IDX = (int*)(ws + WS_IDX); float* GSEL = (float*)(ws + WS_GSEL); int* SLOT = (int*)(ws + WS_SLOT);
    for (int i = tid; i < 8192; i += 512) vals[i] = __float_as_uint(AFF[((size_t)b * SEQ + i) * 16 + e]);
    __syncthreads();
    unsigned long long prefix = 0ull; int krem = 1024;
#pragma unroll
    for (int pass = 0; pass < 4; ++pass) {
        const int wdt = pass == 3 ? 12 : 11, shift = pass == 0 ? 34 : (pass == 1 ? 23 : (pass == 2 ? 12 : 0)), nb = 1 << wdt, B = nb / 512;
        for (int i = tid; i < nb; i += 512) hist[i] = 0;
        __syncthreads();
        for (int k = 0; k < 16; ++k) { const int i = tid + 512 * k; const unsigned long long key = ((unsigned long long)vals[i] << 13) | (unsigned)(8191 - i);
            if ((key >> (shift + wdt)) == prefix) atomicAdd(&hist[(int)(key >> shift) & (nb - 1)], 1); }
        __syncthreads();
        int cnt = 0;
        for (int d = 0; d < B; ++d) cnt += hist[tid * B + d];
        int total; const int incl = block_incl_scan(cnt, scr, lane, wave, total);
        int running = total - incl;
        for (int d = tid * B + B - 1; d >= tid * B; --d) { const int hh = hist[d]; if (running < krem && running + hh >= krem) { scr[16] = d; scr[17] = krem - running; } running += hh; }
        __syncthreads();
        const int dstar = scr[16]; krem = scr[17]; prefix = (prefix << wdt) | (unsigned long long)dstar;
        __syncthreads();
    }
    int cnt = 0;
    for (int k = 0; k < 16; ++k) { const int i = tid + 512 * k; const unsigned long long key = ((unsigned long long)vals[i] << 13) | (unsigned)(8191 - i); cnt += key >= prefix ? 1 : 0; }
    int total; int slot = block_incl_scan(cnt, scr, lane, wave, total) - cnt;
    for (int k = 0; k < 16; ++k) { const int i = tid + 512 * k; const unsigned long long key = ((unsigned long long)vals[i] << 13) | (unsigned)(8191 - i);
        if (key >= prefix) { if (slot < 1024) { IDX[be * 1024 + slot] = i; GSEL[be * 1024 + slot] = __uint_as_float(vals[i]); SLOT[be * 8192 + i] = slot; } else SLOT[be * 8192 + i] = -1; ++slot; }
        else SLOT[be * 8192 + i] = -1; }
    __syncthreads();
}
typedef short s16x4 __attribute__((ext_vector_type(4)));
constexpr int AT_ROW = 144;
constexpr int AT_KC = 0, AT_VC = 256 * AT_ROW, AT_RING = 2 * 256 * AT_ROW, AT_RBUF = 2 * 64 * AT_ROW, AT_BIAS = AT_RING + 2 * AT_RBUF;
static_assert(AT_BIAS + 2048 <= RING_BYTES, "attention LDS map");
constexpr float LOG2E = 1.4426950408889634f;

template <bool NB> __device__ __forceinline__ void attn_tile32(const LAS unsigned char* K32, const LAS unsigned char* V32, const bf16x8 q0, const bf16x8 q1, f32x4 (&O)[4], float& lsum,
                                                             int lane, const LAS float* brow, int kc0, int q_cs, float shiftl) {
    const int r16 = lane & 15, fq = lane >> 4;
    f32x4 st[2];
#pragma unroll
    for (int tt = 0; tt < 2; ++tt) {
        const LAS unsigned char* kp = K32 + (16 * tt + r16) * AT_ROW + 16 * fq;
        const bf16x8 k0 = *(const LAS bf16x8*)kp, k1 = *(const LAS bf16x8*)(kp + 64);
        st[tt] = __builtin_amdgcn_mfma_f32_16x16x32_bf16(k0, q0, (f32x4){0.f, 0.f, 0.f, 0.f}, 0, 0, 0);
        st[tt] = __builtin_amdgcn_mfma_f32_16x16x32_bf16(k1, q1, st[tt], 0, 0, 0);
    }
    float p[2][4];
#pragma unroll
    for (int tt = 0; tt < 2; ++tt)
#pragma unroll
        for (int e = 0; e < 4; ++e) {
            float v;
            if (NB) { const int ko = 16 * tt + 4 * fq + e, kc = kc0 + ko; v = __builtin_amdgcn_exp2f(fmaf(st[tt][e], LOG2E, brow[ko])); v = (kc >= q_cs && kc < q_cs + 16) ? v : 0.f; }
            else v = __builtin_amdgcn_exp2f(fmaf(st[tt][e], LOG2E, shiftl));
            p[tt][e] = v; lsum += v;
        }
    bf16x8 Pf; { pg8::u32x4 w; w.x = pg8::cvt_pk_bf16(p[0][0], p[0][1]); w.y = pg8::cvt_pk_bf16(p[0][2], p[0][3]); w.z = pg8::cvt_pk_bf16(p[1][0], p[1][1]); w.w = pg8::cvt_pk_bf16(p[1][2], p[1][3]); Pf = __builtin_bit_cast(bf16x8, w); }
    const LAS unsigned char* vp = V32 + (4 * fq + (r16 >> 2)) * AT_ROW + 8 * (r16 & 3);
#pragma unroll
    for (int dt = 0; dt < 4; ++dt) {
        const s16x4 lo = __builtin_amdgcn_ds_read_tr16_b64_v4i16((LAS s16x4*)(vp + 32 * dt)), hi = __builtin_amdgcn_ds_read_tr16_b64_v4i16((LAS s16x4*)(vp + 32 * dt + 16 * AT_ROW));
        const bf16x8 Vf = __builtin_shufflevector(lo, hi, 0, 1, 2, 3, 4, 5, 6, 7);
        O[dt] = __builtin_amdgcn_mfma_f32_16x16x32_bf16(Vf, Pf, O[dt], 0, 0, 0);
    }
}

__device__ __forceinline__ void attn_unit(const Args& args, unsigned char* ws, LAS unsigned char* lds, int unit, int tid, int lane, int wave) {
    const int b = unit >> 7, head = (unit >> 4) & 7, r0 = (unit & 15) * 8, r = r0 + wave;
    const bf16* Q = (const bf16*)(ws + WS_Q); const bf16* Kg = (const bf16*)(ws + WS_K); const bf16* Vg = (const bf16*)(ws + WS_V); bf16* YB = (bf16*)(ws + WS_YAB) + 512;
    const int r16 = lane & 15, fq = lane >> 4;
    float mq = fabsf(args.in[I_QN][lane]), mk = fabsf(args.in[I_KN][lane]);
#pragma unroll
    for (int o = 1; o < 64; o <<= 1) { mq = fmaxf(mq, __shfl_xor(mq, o)); mk = fmaxf(mk, __shfl_xor(mk, o)); }
    const float shiftl = -8.f * mq * mk * LOG2E;
    __syncthreads();
    {
        const bf16* kc = Kg + ((size_t)MLAT + b * NCTX) * 512 + head * 64; const bf16* vc = Vg + ((size_t)MLAT + b * NCTX) * 512 + head * 64;
#pragma unroll
        for (int i = 0; i < 4; ++i) { const int idx = tid + 512 * i, row = idx >> 3, c = idx & 7;
            const v4u kv = *(const v4u*)(kc + (size_t)row * 512 + c * 8), vv = *(const v4u*)(vc + (size_t)row * 512 + c * 8);
            *(LAS v4u*)(lds + AT_KC + row * AT_ROW + c * 16) = kv; *(LAS v4u*)(lds + AT_VC + row * AT_ROW + c * 16) = vv; }
        LAS float* bl = (LAS float*)(lds + AT_BIAS);
        if (tid < 512) bl[tid] = tid < 465 ? fmaf(args.in[I_RPB][head * 465 + tid], LOG2E, shiftl) : 0.f;
    }
    const int kr_lo = min(max(r0 - 4, 0), 120), kr_hi = min(max(r0 + 3, 0), 120) + 7;
    const int lcol = tid >> 3, lc = tid & 7;
    {   const size_t g0 = ((size_t)b * SEQ + kr_lo * 64 + lcol) * 512 + head * 64 + lc * 8;
        const v4u kv = *(const v4u*)(Kg + g0), vv = *(const v4u*)(Vg + g0);
        *(LAS v4u*)(lds + AT_RING + lcol * AT_ROW + lc * 16) = kv; *(LAS v4u*)(lds + AT_RING + 64 * AT_ROW + lcol * AT_ROW + lc * 16) = vv; }
    bf16x8 Qf[4][2];
#pragma unroll
    for (int j = 0; j < 4; ++j) { const bf16* qp = Q + ((size_t)b * SEQ + r * 64 + 16 * j + r16) * 512 + head * 64 + 8 * fq; Qf[j][0] = *(const bf16x8*)qp; Qf[j][1] = *(const bf16x8*)(qp + 32); }
    f32x4 O[4][4]; float lsum[4];
#pragma unroll
    for (int j = 0; j < 4; ++j) { lsum[j] = 0.f;
#pragma unroll
        for (int dt = 0; dt < 4; ++dt) O[j][dt] = (f32x4){0.f, 0.f, 0.f, 0.f}; }
    __syncthreads();
#pragma unroll 1
    for (int grp = 0; grp < 8; ++grp) {
#pragma unroll
        for (int j = 0; j < 4; ++j) attn_tile32<false>(lds + AT_KC + 32 * grp * AT_ROW, lds + AT_VC + 32 * grp * AT_ROW, Qf[j][0], Qf[j][1], O[j], lsum[j], lane, nullptr, 0, 0, shiftl);
    }
    const int rs = min(max(r - 4, 0), 120);
#pragma unroll 1
    for (int kr = kr_lo; kr <= kr_hi; ++kr) {
        const int buf = (kr - kr_lo) & 1; v4u kv, vv;
        if (kr < kr_hi) { const size_t g0 = ((size_t)b * SEQ + (kr + 1) * 64 + lcol) * 512 + head * 64 + lc * 8; kv = *(const v4u*)(Kg + g0); vv = *(const v4u*)(Vg + g0); }
        if (kr >= rs && kr < rs + 8) {
            const LAS unsigned char* kb = lds + AT_RING + buf * AT_RBUF; const LAS unsigned char* vb = kb + 64 * AT_ROW;
            const LAS float* bl = (const LAS float*)(lds + AT_BIAS) + (kr - r + 7) * 31 + 15;
#pragma unroll
            for (int j = 0; j < 4; ++j) { const int cs = j == 0 ? 0 : (j == 3 ? 32 : 16 * j - 8), qc = 16 * j + r16, q_cs = min(max(qc - 8, 0), 48);
                attn_tile32<true>(kb + cs * AT_ROW, vb + cs * AT_ROW, Qf[j][0], Qf[j][1], O[j], lsum[j], lane, bl + cs - qc, cs, q_cs, shiftl); }
        }
        if (kr < kr_hi) { LAS unsigned char* nb = lds + AT_RING + (buf ^ 1) * AT_RBUF; *(LAS v4u*)(nb + lcol * AT_ROW + lc * 16) = kv; *(LAS v4u*)(nb + 64 * AT_ROW + lcol * AT_ROW + lc * 16) = vv; }
        __syncthreads();
    }
#pragma unroll
    for (int j = 0; j < 4; ++j) {
        float l = lsum[j]; l += __shfl_xor(l, 16); l += __shfl_xor(l, 32);
        const float inv = 1.f / l;
        bf16* op = YB + ((size_t)b * SEQ + r * 64 + 16 * j + r16) * 1024 + head * 64 + 4 * fq;
#pragma unroll
        for (int dt = 0; dt < 4; ++dt) { pg8::u32x2 w; w.x = pg8::cvt_pk_bf16(O[j][dt][0] * inv, O[j][dt][1] * inv); w.y = pg8::cvt_pk_bf16(O[j][dt][2] * inv, O[j][dt][3] * inv); *(pg8::u32x2*)(op + 16 * dt) = w; }
    }
}
__global__ void __launch_bounds__(NWAVES * 64, 2) mega(Args args) {
    extern __shared__ __attribute__((aligned(16))) unsigned char lds_raw[];
    LAS unsigned char* lds = (LAS unsigned char*)lds_raw;
    volatile LAS unsigned* MISC = (volatile LAS unsigned*)(lds + MISC_OFF);
    const int tid = threadIdx.x, lane = tid & 63, wave = __builtin_amdgcn_readfirstlane(tid >> 6);
    const int G = gridDim.x; const int bx = blockIdx.x; const int vcu = (G % 8 == 0) ? (bx % 8) * (G / 8) + bx / 8 : bx;
    const int gw = vcu * NWAVES + wave, NGW = G * NWAVES;
    unsigned char* ws = args.ws;
    gu32* ctl = (gu32*)(ws + WS_CTL);
    for (int u = tid; u < (LDS_BYTES - LDSCTL_OFF) / 4; u += NWAVES * 64) ((LAS unsigned*)(lds + LDSCTL_OFF))[u] = 0u;
    __syncthreads();
    XcdBarrier bar = xcd_barrier_post((unsigned*)(ctl + CW_BAR) + args.li * XCD_BAR_WORDS, MISC + 8);
    const int lo = args.ph_lo, hi = args.ph_hi;
#define IN(k) (lo <= (k) && (k) < hi)
#define BOTH(k) (IN(k) && IN((k) + 1))
#if defined(TIME_MASK)
    unsigned long long tacc_ = 0ull, tbeg_ = 0ull;
#define TBEG(k) do { if ((TIME_MASK >> (k)) & 1) tbeg_ = __builtin_amdgcn_s_memrealtime(); } while (0)
#define TEND(k) do { if ((TIME_MASK >> (k)) & 1) tacc_ += __builtin_amdgcn_s_memrealtime() - tbeg_; } while (0)
#else
#define TBEG(k) do {} while (0)
#define TEND(k) do {} while (0)
#endif
    float* mod = (float*)(ws + WS_MOD);
    bf16* Hb = (bf16*)(ws + WS_H);

    TBEG(0);
    if (IN(0)) for (int rep_ = 0; rep_ <= ((PROBE_MASK >> 0) & 1); ++rep_) {
        const float* c = args.in[I_C]; const float* cctx = args.in[I_CCTX]; const float* w_ada = args.in[I_WADA]; const float* b_ada = args.in[I_BADA];
        if (args.li == 0) for (int it = gw; it < 24 * 64; it += NGW) {
            const int cc = it % 24, ks = it / 24, col = cc * 256 + lane * 4;
            f32x4 a0 = {0.f, 0.f, 0.f, 0.f}, a1 = a0, a2 = a0;
#pragma unroll
            for (int k = ks * 16; k < ks * 16 + 16; ++k) {
                const f32x4 w = *(const f32x4*)(w_ada + (size_t)k * 6144 + col);
                const float s0 = silu_f(c[k]), s1 = silu_f(c[1024 + k]), s2 = silu_f(cctx[k]);
                a0 += w * s0; a1 += w * s1; a2 += w * s2;
            }
            if (ks == 0) { const f32x4 bb = *(const f32x4*)(b_ada + col); a0 += bb; a1 += bb; a2 += bb; }
#pragma unroll
            for (int i = 0; i < 4; ++i) { atomicAdd(mod + col + i, a0[i]); atomicAdd(mod + 6144 + col + i, a1[i]); atomicAdd(mod + 2 * 6144 + col + i, a2[i]); }
        }
        LAS float* scr = (LAS float*)(lds + RING_OFF + wave * 16384);
        constexpr int I_IN = 16 * 128, I_GLU = 8 * 16, I_PA = 8 * 32, I_OUT = 16 * 32, NIT = I_IN + I_GLU + 2 * I_PA + I_OUT;
        for (int it = gw; it < NIT; it += NGW) {
            int r = it;
            if (r < I_IN) { transpose_item<1>(args.in[I_WIN], 1024, 4096, (bf16*)(ws + WS_WIN), 1024, scr, r, lane); continue; } r -= I_IN;
            if (r < I_GLU) { transpose_item<0>(args.in[I_WGLU], 512, 512, (bf16*)(ws + WS_WGLU), 512, scr, r, lane); continue; } r -= I_GLU;
            if (r < I_PA) { transpose_item<0>(args.in[I_WPA], 512, 1024, (bf16*)(ws + WS_WPA), 1024, scr, r, lane); continue; } r -= I_PA;
            if (r < I_PA) { transpose_item<0>(args.in[I_WPB], 512, 1024, (bf16*)(ws + WS_WPA) + 512, 1024, scr, r, lane); continue; } r -= I_PA;
            transpose_item<0>(args.in[I_WOUT], 1024, 1024, (bf16*)(ws + WS_WOUT), 1024, scr, r, lane);
        }
        for (int dg = gw; dg < 64; dg += NGW) s5_prep(args, ws, dg, lane);
        if (BOTH(0)) xcd_barrier(bar);
    }
    TEND(0);
    TBEG(1);
    if (IN(1)) for (int rep_ = 0; rep_ <= ((PROBE_MASK >> 1) & 1); ++rep_) {
        const float* x = args.in[I_X]; const float* ctx = args.in[I_CTX]; const float* gwt = args.in[I_NMIX];
        for (int blk = gw; blk < MLAT / 8 + MCTX / 2; blk += NGW) {
            if (blk < MLAT / 8) norm1_rows(x + (size_t)blk * 8 * D, Hb + (size_t)blk * 8 * D, 8, gwt, mod + ((blk * 8) >> 13) * 6144, lane);
            else { const int r = (blk - MLAT / 8) * 2; norm1_rows(ctx + (size_t)r * D, Hb + (size_t)(MLAT + r) * D, 2, gwt, mod + 2 * 6144, lane); }
        }
        if (BOTH(1)) xcd_barrier(bar);
    }
    TEND(1);
    TBEG(2);
    if (IN(2)) for (int rep_ = 0; rep_ <= ((PROBE_MASK >> 2) & 1); ++rep_) {
        pg8::Gemm g{Hb, (const bf16*)(ws + WS_WIN), MALL, 4096, 1024};
        pg8::InprojOrder S; S.init(G, bx, true);
        pg8::EpiInproj E{(bf16*)(ws + WS_U), (bf16*)(ws + WS_Q), (bf16*)(ws + WS_K), (bf16*)(ws + WS_V), (bf16*)(ws + WS_SGA), (bf16*)(ws + WS_SGB), args.in[I_QN], args.in[I_KN]};
        pg8::gemm_phase<pg8::EpiInproj, pg8::InprojOrder, true>(lds + RING_OFF, g, S, E);
        {
            const int maxun = (1036 + G - 1) / G, heavy = 1036 - (maxun - 1) * G, light = heavy < G ? G - heavy : G;
            if (light == G || bx >= heavy) {
                LAS float* scr = (LAS float*)(lds + RING_OFF + wave * 16384);
                for (int it = (light == G ? bx : bx - heavy) * NWAVES + wave; it < 16 * 512; it += light * NWAVES)
                    transpose_item<0>(args.in[I_WED] + (size_t)(it >> 9) * 1048576, 1024, 1024, (bf16*)(ws + WS_WD) + (size_t)(it >> 9) * 1048576, 1024, scr, it & 511, lane);
            }
        }
        if (BOTH(2)) xcd_barrier(bar);
    }
    TEND(2);
#if defined(EXTRA_BARRIERS)
    if (IN(3)) for (int xb_ = 0; xb_ < EXTRA_BARRIERS; ++xb_) xcd_barrier(bar);
#endif
    TBEG(3);
    if (IN(3)) for (int rep_ = 0; rep_ <= ((PROBE_MASK >> 3) & 1); ++rep_) {
        for (int task = gw; task < 128 * S5_NPAIR; task += NGW) s5_pass1(ws, task, lane);
        if (BOTH(3)) xcd_barrier(bar);
    }
    TEND(3);
    TBEG(4);
    if (IN(4)) for (int rep_ = 0; rep_ <= ((PROBE_MASK >> 4) & 1); ++rep_) {
        { const int gid = gw * 64 + lane; if (gid < 8192) s5_pass2(ws, gid); }
        for (int unit = bx; unit < 256; unit += G) attn_unit(args, ws, lds + RING_OFF, unit, tid, lane, wave);
        if (BOTH(4)) xcd_barrier(bar);
    }
    TEND(4);
    TBEG(5);
    if (IN(5)) for (int rep_ = 0; rep_ <= ((PROBE_MASK >> 5) & 1); ++rep_) {
        for (int task = gw; task < 4096; task += NGW) s5_pass3(args, ws, lds + RING_OFF + wave * 16384, task, lane);
        if (BOTH(5)) xcd_barrier(bar);
    }
    TEND(5);
    TBEG(6);
    if (IN(6)) for (int rep_ = 0; rep_ <= ((PROBE_MASK >> 6) & 1); ++rep_) {
        pg8::Gemm g{(const bf16*)(ws + WS_H), (const bf16*)(ws + WS_WGLU), MLAT, 512, 512};
        pg8::StaticOrder S; S.init(MLAT, 512, G, bx);
        pg8::EpiGlu E{(const bf16*)(ws + WS_H), args.in[I_BGLU], (bf16*)(ws + WS_YAB), 1024};
        pg8::gemm_phase<pg8::EpiGlu, pg8::StaticOrder, true>(lds + RING_OFF, g, S, E);
        if (BOTH(6)) xcd_barrier(bar);
    }
    TEND(6);
    TBEG(7);
    if (IN(7)) for (int rep_ = 0; rep_ <= ((PROBE_MASK >> 7) & 1); ++rep_) {
        pg8::Gemm g{(const bf16*)(ws + WS_YAB), (const bf16*)(ws + WS_WPA), MLAT, 1024, 1024};
        pg8::StaticOrder S; S.init(MLAT, 1024, G, bx);
        pg8::EpiMerge E{(const bf16*)(ws + WS_SGA), (const bf16*)(ws + WS_SGB), (bf16*)(ws + WS_M)};
        pg8::gemm_phase<pg8::EpiMerge, pg8::StaticOrder, true>(lds + RING_OFF, g, S, E);
        if (BOTH(7)) xcd_barrier(bar);
    }
    TEND(7);
    TBEG(8);
    if (IN(8)) for (int rep_ = 0; rep_ <= ((PROBE_MASK >> 8) & 1); ++rep_) {
        pg8::Gemm g{(const bf16*)(ws + WS_M), (const bf16*)(ws + WS_WOUT), MLAT, 1024, 1024};
        pg8::StaticOrder S; S.init(MLAT, 1024, G, bx);
        pg8::EpiOut E{args.in[I_X], mod, args.out};
        pg8::gemm_phase<pg8::EpiOut, pg8::StaticOrder, true>(lds + RING_OFF, g, S, E);
        if (BOTH(8)) xcd_barrier(bar);
    }
    TEND(8);
    TBEG(9);
    if (IN(9)) for (int rep_ = 0; rep_ <= ((PROBE_MASK >> 9) & 1); ++rep_) {
        const float* gwt = args.in[I_NFFN]; const float* w_router = args.in[I_WR]; float* AFF = (float*)(ws + WS_AFF);
        __syncthreads();
#pragma unroll
        for (int k = 0; k < 8; ++k) { const int idx4 = tid + 512 * k, c = idx4 >> 2, e4 = idx4 & 3;
            *(LAS f32x4*)(lds + RING_OFF + (((c >> 8) * 4 + (c & 3)) * 64 + ((c & 255) >> 2)) * 80 + e4 * 16) = *(const f32x4*)(w_router + (size_t)c * 16 + e4 * 4); }
        __syncthreads();
        for (int blk = gw; blk < MLAT / 8; blk += NGW) {
            const int row0 = blk * 8; const float* md = mod + (row0 >> 13) * 6144;
            f32x4 ca[4], cb[4];
#pragma unroll
            for (int j = 0; j < 4; ++j) { const int col = j * 256 + lane * 4; ca[j] = *(const f32x4*)(gwt + col) * (*(const f32x4*)(md + 4096 + col) + 1.f); cb[j] = *(const f32x4*)(md + 3072 + col); }
#pragma unroll 1
            for (int rr = 0; rr < 8; rr += 2) {
                const int rowa = row0 + rr, rowb = rowa + 1;
                const float* sa = args.out + (size_t)rowa * D; const float* sb = sa + D;
                f32x4 va[4], vb[4]; float ssa = 0.f, ssb = 0.f;
#pragma unroll
                for (int j = 0; j < 4; ++j) { va[j] = *(const f32x4*)(sa + j * 256 + lane * 4); vb[j] = *(const f32x4*)(sb + j * 256 + lane * 4); }
#pragma unroll
                for (int j = 0; j < 4; ++j) { ssa += (va[j][0] * va[j][0] + va[j][1] * va[j][1]) + (va[j][2] * va[j][2] + va[j][3] * va[j][3]); ssb += (vb[j][0] * vb[j][0] + vb[j][1] * vb[j][1]) + (vb[j][2] * vb[j][2] + vb[j][3] * vb[j][3]); }
                const float ra = rsqrtf(wave_sum(ssa) * (1.f / D) + EPS), rb = rsqrtf(wave_sum(ssb) * (1.f / D) + EPS);
                float la[16], lb[16];
#pragma unroll
                for (int e = 0; e < 16; ++e) { la[e] = 0.f; lb[e] = 0.f; }
#pragma unroll
                for (int j = 0; j < 4; ++j) {
                    const int col = j * 256 + lane * 4;
                    const f32x4 oa = va[j] * ra * ca[j] + cb[j], ob = vb[j] * rb * ca[j] + cb[j];
                    pg8::u32x2 w; w.x = pk2(oa[0], oa[1]); w.y = pk2(oa[2], oa[3]); *(pg8::u32x2*)(Hb + (size_t)rowa * D + col) = w;
                    w.x = pk2(ob[0], ob[1]); w.y = pk2(ob[2], ob[3]); *(pg8::u32x2*)(Hb + (size_t)rowb * D + col) = w;
#pragma unroll
                    for (int i = 0; i < 4; ++i) {
                        const LAS f32x4* wr = (const LAS f32x4*)(lds + RING_OFF + ((j * 4 + i) * 64 + lane) * 80);
#pragma unroll
                        for (int e4 = 0; e4 < 4; ++e4) { const f32x4 wv = wr[e4];
#pragma unroll
                            for (int e = 0; e < 4; ++e) { la[e4 * 4 + e] = fmaf(oa[i], wv[e], la[e4 * 4 + e]); lb[e4 * 4 + e] = fmaf(ob[i], wv[e], lb[e4 * 4 + e]); } }
                        __builtin_amdgcn_sched_barrier(0);
                    }
                }
#define FOLD_STEP(arr, n, mask) do { const bool hi_ = (lane & (mask)) != 0; _Pragma("unroll") for (int k_ = 0; k_ < (n); ++k_) { \
            const float send_ = hi_ ? arr[k_] : arr[(n) + k_], keep_ = hi_ ? arr[(n) + k_] : arr[k_]; arr[k_] = keep_ + __shfl_xor(send_, (mask)); } } while (0)
                FOLD_STEP(la, 8, 32); FOLD_STEP(lb, 8, 32); FOLD_STEP(la, 4, 16); FOLD_STEP(lb, 4, 16); FOLD_STEP(la, 2, 8); FOLD_STEP(lb, 2, 8); FOLD_STEP(la, 1, 4); FOLD_STEP(lb, 1, 4);
#undef FOLD_STEP
                float xa = la[0], xb = lb[0];
                xa += __shfl_xor(xa, 2); xb += __shfl_xor(xb, 2); xa += __shfl_xor(xa, 1); xb += __shfl_xor(xb, 1);
                float ma = xa, mb = xb;
#pragma unroll
                for (int o = 4; o < 64; o <<= 1) { ma = fmaxf(ma, __shfl_xor(ma, o)); mb = fmaxf(mb, __shfl_xor(mb, o)); }
                const float ea = expf(xa - ma), eb = expf(xb - mb); float sua = ea, sub = eb;
#pragma unroll
                for (int o = 4; o < 64; o <<= 1) { sua += __shfl_xor(sua, o); sub += __shfl_xor(sub, o); }
                if ((lane & 3) == 0) { const int e = ((lane >> 5) & 1) * 8 + ((lane >> 4) & 1) * 4 + ((lane >> 3) & 1) * 2 + ((lane >> 2) & 1);
                    AFF[(size_t)rowa * 16 + e] = ea / sua; AFF[(size_t)rowb * 16 + e] = eb / sub; }
            }
        }
        if (BOTH(9)) xcd_barrier(bar);
    }
    TEND(9);
    TBEG(10);
    if (IN(10)) for (int rep_ = 0; rep_ <= ((PROBE_MASK >> 10) & 1); ++rep_) {
        const bool split = G >= 64;
        if (!split || bx >= 32) {
            const int w2 = split ? (bx - 32) * NWAVES + wave : bx * NWAVES + wave, NW2 = (split ? G - 32 : G) * NWAVES;
            LAS float* scr = (LAS float*)(lds + RING_OFF + wave * 16384);
            for (int it = w2; it < 16 * 2 * 512; it += NW2) {
                const int e = it >> 10, which = (it >> 9) & 1, item = it & 511;
                if (which == 0) transpose_item<2>(args.in[I_WEG] + (size_t)e * 1048576, 1024, 1024, (bf16*)(ws + WS_WGU) + (size_t)e * 2097152, 1024, scr, item, lane);
                else transpose_item<3>(args.in[I_WEU] + (size_t)e * 1048576, 1024, 1024, (bf16*)(ws + WS_WGU) + (size_t)e * 2097152, 1024, scr, item, lane);
            }
        }
        if (split) { if (bx < 32) topk_select(ws, lds_raw, bx, tid, lane, wave); }
        else { __syncthreads(); for (int be = bx; be < 32; be += G) topk_select(ws, lds_raw, be, tid, lane, wave); }
        if (BOTH(10)) xcd_barrier(bar);
    }
    TEND(10);
    TBEG(12);
    if (IN(12)) for (int rep_ = 0; rep_ <= ((PROBE_MASK >> 12) & 1); ++rep_) {
        pg8::Gemm g{Hb, (const bf16*)(ws + WS_WGU), 32768, 2048, 1024};
        pg8::ExpertOrder<8> S; S.init(G, bx);
        pg8::EpiHid E{(bf16*)(ws + WS_HID)};
        pg8::gemm_phase<pg8::EpiHid, pg8::ExpertOrder<8>, true, true, pg8::ExpertGather>(lds + RING_OFF, g, S, E, pg8::ExpertGather{(const int*)(ws + WS_IDX)});
        if (BOTH(12)) xcd_barrier(bar);
    }
    TEND(12);
    TBEG(13);
    if (IN(13)) for (int rep_ = 0; rep_ <= ((PROBE_MASK >> 13) & 1); ++rep_) {
        pg8::Gemm g{(const bf16*)(ws + WS_HID), (const bf16*)(ws + WS_WD), 32768, 1024, 1024};
        pg8::ExpertOrder<4> S; S.init(G, bx);
        pg8::EpiDown E{(const float*)(ws + WS_GSEL), (bf16*)(ws + WS_XE)};
        pg8::gemm_phase<pg8::EpiDown, pg8::ExpertOrder<4>, true>(lds + RING_OFF, g, S, E);
        if (BOTH(13)) xcd_barrier(bar);
    }
    TEND(13);
    TBEG(14);
    if (IN(14)) for (int rep_ = 0; rep_ <= ((PROBE_MASK >> 14) & 1); ++rep_) {
        const int* SLOT = (const int*)(ws + WS_SLOT); const bf16* Y = (const bf16*)(ws + WS_XE);
        for (int blk = gw; blk < MLAT / 8; blk += NGW) {
            const int row0 = blk * 8, b = row0 >> 13, t0 = row0 & 8191;
            const int sv0 = SLOT[(b * 16 + (lane & 15)) * 8192 + t0 + (lane >> 4)], sv1 = SLOT[(b * 16 + (lane & 15)) * 8192 + t0 + 4 + (lane >> 4)];
            f32x4 cg[4];
#pragma unroll
            for (int j = 0; j < 4; ++j) cg[j] = *(const f32x4*)(mod + b * 6144 + 5120 + j * 256 + lane * 4);
#pragma unroll 1
            for (int rp = 0; rp < 4; ++rp) {
                const int sv = rp < 2 ? sv0 : sv1, lbase = (rp & 1) * 32;
                unsigned mask = (unsigned)__builtin_amdgcn_readfirstlane((int)(unsigned)(__ballot(sv >= 0) >> lbase));
                float* oa = args.out + (size_t)(row0 + 2 * rp) * D + lane * 4; float* ob = oa + D;
                f32x4 xa[4], xb[4], aa[4], ab[4];
#pragma unroll
                for (int j = 0; j < 4; ++j) { xa[j] = *(const f32x4*)(oa + j * 256); xb[j] = *(const f32x4*)(ob + j * 256); aa[j] = (f32x4){0.f, 0.f, 0.f, 0.f}; ab[j] = aa[j]; }
                for (;;) {
                    const bf16* p[4]; float fa[4], fb[4];
#pragma unroll
                    for (int q = 0; q < 4; ++q) {
                        if (mask) { const int bit = __builtin_ctz(mask); mask &= mask - 1u; const int s = __builtin_amdgcn_readlane(sv, lbase + bit), e = bit & 15;
                            p[q] = Y + ((size_t)(b * 16 + e) * 1024 + s) * D; fa[q] = bit < 16 ? 1.f : 0.f; fb[q] = 1.f - fa[q]; }
                        else { p[q] = Y; fa[q] = 0.f; fb[q] = 0.f; }
                    }
                    pg8::u32x2 w[4][4];
#pragma unroll
                    for (int q = 0; q < 4; ++q)
#pragma unroll
                        for (int j = 0; j < 4; ++j) w[q][j] = *(const pg8::u32x2*)(p[q] + j * 256 + lane * 4);
#pragma unroll
                    for (int q = 0; q < 4; ++q)
#pragma unroll
                        for (int j = 0; j < 4; ++j) { const f32x4 v = {__uint_as_float(w[q][j].x << 16), __uint_as_float(w[q][j].x & 0xffff0000u), __uint_as_float(w[q][j].y << 16), __uint_as_float(w[q][j].y & 0xffff0000u)};
                            aa[j] += v * fa[q]; ab[j] += v * fb[q]; }
                    if (!mask) break;
                }
#pragma unroll
                for (int j = 0; j < 4; ++j) { *(f32x4*)(oa + j * 256) = xa[j] + cg[j] * aa[j]; *(f32x4*)(ob + j * 256) = xb[j] + cg[j] * ab[j]; }
            }
        }
    }
    TEND(14);
#if defined(TIME_MASK)
    if (bx == 0 && tid == 0) { const unsigned long long te_ = __builtin_amdgcn_s_memrealtime(); while (__builtin_amdgcn_s_memrealtime() - te_ < tacc_) __builtin_amdgcn_s_sleep(4); }
#endif
#undef IN
#undef BOTH
}
extern "C" void kernel_launch(void* const* d_in, const int* in_sizes, int n_in, void* d_out, int out_size, void* d_ws, size_t ws_size, hipStream_t stream) {
    static int grid = 0;
    if (grid == 0) {
        if (n_in != 29 || ws_size < WS_END) { fprintf(stderr, "kernel_launch: bad arguments (n_in %d, ws %zu)\n", n_in, ws_size); grid = -1; return; }
        int dev = 0, cus = 0;
        if (hipGetDevice(&dev) != hipSuccess || hipDeviceGetAttribute(&cus, hipDeviceAttributeMultiprocessorCount, dev) != hipSuccess) { grid = -1; return; }
        if (hipFuncSetAttribute((const void*)mega, hipFuncAttributeMaxDynamicSharedMemorySize, LDS_BYTES) != hipSuccess) { fprintf(stderr, "kernel_launch: hipFuncSetAttribute failed\n"); grid = -1; return; }
        (void)hipGetLastError();
        grid = cus;
    }
    if (grid < 0) return;
    float* out = (float*)d_out; unsigned char* ws = (unsigned char*)d_ws;
    (void)hipMemsetAsync(ws + WS_CTL, 0, CTL_ZERO_BYTES, stream);
    Args a{};
    for (int i = 0; i < 29; ++i) a.in[i] = (const float*)d_in[i];
    a.out = out; a.ws = ws;
#if defined(PROBE_LO)
    a.ph_lo = 0; a.ph_hi = PROBE_HI; a.li = 0;
    hipLaunchKernelGGL(mega, dim3(grid), dim3(NWAVES * 64), LDS_BYTES, stream, a);
    a.ph_lo = PROBE_LO; a.ph_hi = PROBE_HI; a.li = 1;
    hipLaunchKernelGGL(mega, dim3(grid), dim3(NWAVES * 64), LDS_BYTES, stream, a);
    a.ph_lo = PROBE_HI; a.ph_hi = 15; a.li = 2;
    hipLaunchKernelGGL(mega, dim3(grid), dim3(NWAVES * 64), LDS_BYTES, stream, a);
#elif defined(PER_PHASE)
    for (int k = 0; k < 15; ++k) { if (k == 11) continue; a.ph_lo = k; a.ph_hi = k + 1; a.li = 0; hipLaunchKernelGGL(mega, dim3(grid), dim3(NWAVES * 64), LDS_BYTES, stream, a); }
#else
    a.ph_lo = 0; a.ph_hi = 15; a.li = 0;
    hipLaunchKernelGGL(mega, dim3(grid), dim3(NWAVES * 64), LDS_BYTES, stream, a);
#endif
}
```

```cpp
#include <hip/hip_runtime.h>
#include <cstdio>
#include <cstdint>
#include <stdint.h>

__device__ __forceinline__ float bf2f(unsigned short v) { return __uint_as_float(((unsigned)v) << 16); }
__device__ __forceinline__ float silu_f(float x) { return x / (1.f + __expf(-x)); }
__device__ __forceinline__ float sigmoid_f(float x) { return 1.f / (1.f + __expf(-x)); }
__device__ __forceinline__ float gelu_tanh(float y) { return 0.5f * y * (1.f + tanhf(0.7978845608028654f * (y + 0.044715f * y * y * y))); }

constexpr int D = 1024, SEQ = 8192, MLAT = 16384, NCTX = 256, MCTX = 512, MALL = MLAT + MCTX;
constexpr float EPS = 1e-6f;
namespace pg8 {
#define PG8_LAS __attribute__((address_space(3)))
typedef unsigned short bf16_t;
typedef short bf16x8 __attribute__((ext_vector_type(8)));
typedef float f32x4 __attribute__((ext_vector_type(4)));
typedef unsigned u32x4 __attribute__((ext_vector_type(4)));
constexpr int BM = 256, BK = 64, HALF = 128, HTB = HALF * BK * 2  , STAGE_BYTES = 8 * HTB, NXCD = 8, WGM = 8;

__host__ __device__ __forceinline__ int lds_byte(int r, int c) { const int st = (r >> 4) * 2 + (c >> 5), rr = r & 15, cc = c & 31, ob = rr * 64 + cc * 2; return st * 1024 + (ob ^ (((ob >> 9) & 1) << 5)); }
__host__ __device__ __forceinline__ void stage_rc(int b, int& R, int& C) { const int st = b / 1024, sb = b % 1024, swz = sb ^ (((sb >> 9) & 1) << 5); R = (st >> 1) * 16 + swz / 64; C = (st & 1) * 32 + (swz % 64) / 2; }
__host__ __device__ __forceinline__ int perm32(int rho) { const int n = rho >> 4, i = rho & 15; return 8 * (i >> 2) + 4 * n + (i & 3); }

struct Unit { int pm, pn; };
struct Gemm { const bf16_t* A; const bf16_t* Bt; int M, N, K; };

struct StaticOrder {
    int nM, nN, nwg, G, c;
    __host__ __device__ void init(int M, int N, int G_, int c_) { nM = M / BM; nN = N / BM; nwg = nM * nN; G = G_; c = c_; }
    __host__ __device__ bool next(int i, Unit& u) const {
        const long L = (long)i * G + c; if (L >= nwg) return false;
        int wgid = (int)L; { const int q = nwg / NXCD, r = nwg % NXCD, xcd = wgid % NXCD, off = wgid / NXCD; wgid = (xcd < r ? xcd * (q + 1) : r * (q + 1) + (xcd - r) * q) + off; }
        const int nig = WGM * nN, gid = wgid / nig, fm = gid * WGM, gsz = (nM - fm) < WGM ? (nM - fm) : WGM;
        u.pm = fm + ((wgid % nig) % gsz); u.pn = (wgid % nig) / gsz; return true;
    }
    __device__ __forceinline__ void a_ready(const Unit&) const {}
    __device__ __forceinline__ void done(const Unit&) const {}
};

__device__ __forceinline__ unsigned cvt_pk_bf16(float lo, float hi) { unsigned r; asm volatile("v_cvt_pk_bf16_f32 %0, %1, %2" : "=v"(r) : "v"(lo), "v"(hi)); return r; }
typedef float f32x2 __attribute__((ext_vector_type(2)));
typedef unsigned u32x2 __attribute__((ext_vector_type(2)));
__device__ __forceinline__ u32x4 pack8(const f32x4 a, const f32x4 b) { u32x4 w; w.x = cvt_pk_bf16(a[0], a[1]); w.y = cvt_pk_bf16(a[2], a[3]); w.z = cvt_pk_bf16(b[0], b[1]); w.w = cvt_pk_bf16(b[2], b[3]); return w; }
__device__ __forceinline__ f32x4 sig4(const f32x4 v) { f32x4 r; r[0] = sigmoid_f(v[0]); r[1] = sigmoid_f(v[1]); r[2] = sigmoid_f(v[2]); r[3] = sigmoid_f(v[3]); return r; }
__device__ __forceinline__ void unpack8(const u32x4 w, f32x4& a, f32x4& b) {
    a[0] = __uint_as_float(w.x << 16); a[1] = __uint_as_float(w.x & 0xffff0000u); a[2] = __uint_as_float(w.y << 16); a[3] = __uint_as_float(w.y & 0xffff0000u);
    b[0] = __uint_as_float(w.z << 16); b[1] = __uint_as_float(w.z & 0xffff0000u); b[2] = __uint_as_float(w.w << 16); b[3] = __uint_as_float(w.w & 0xffff0000u); }

struct OneUnit {
    int pm, pn;
    __device__ bool next(int i, Unit& u) const { u.pm = pm; u.pn = pn; return i == 0; }
    __device__ __forceinline__ void a_ready(const Unit&) const {}
    __device__ __forceinline__ void done(const Unit&) const {}
};
struct InprojOrder {
    StaticOrder so; int G, c; bool with_ctx;
    __device__ void init(int G_, int c_, bool wc_) { so.init(MLAT, 4096, G_, c_); G = G_; c = c_; with_ctx = wc_; }
    __device__ bool next(int i, Unit& u) const {
        const long L = (long)i * G + c; if (L < 1024) return so.next(i, u);
        const int r = (int)(L - 1024); if (r >= 12 || !with_ctx) return false;
        const int j = r % 6; u.pm = 64 + r / 6; u.pn = j < 2 ? j : j + 2; return true;
    }
    __device__ __forceinline__ void a_ready(const Unit&) const {}
    __device__ __forceinline__ void done(const Unit&) const {}
};
struct EpiInproj {
    static constexpr bool PERM = true, AFTER_DRAIN = false, MID = false;
    bf16_t *U, *Q, *K, *V, *SGA, *SGB; const float *qn, *kn;
    __device__ __forceinline__ void operator()(const f32x4 (&acc)[2][2][4][2], const Unit& u, int wr, int wc, int fr, int fq) const {
        const int row0 = u.pm * BM + wr * 64 + fr, pn = u.pn;
        if (pn < 2 || pn == 6 || pn == 7) {
            bf16_t* base = (pn < 2 ? U : V) + (pn & 1) * 256 + wc * 32 + 8 * fq;
#pragma unroll
            for (int ai = 0; ai < 2; ++ai)
#pragma unroll
                for (int m = 0; m < 4; ++m) { bf16_t* rowp = base + (size_t)(row0 + ai * HALF + m * 16) * 512;
#pragma unroll
                    for (int bj = 0; bj < 2; ++bj) *(u32x4*)(rowp + bj * HALF) = pack8(acc[ai][bj][m][0], acc[ai][bj][m][1]); }
        } else if (pn < 6) {
            const bool isq = pn < 4; const float* wn = isq ? qn : kn; const float sc = isq ? 0.125f * 1.4426950408889634f : 1.f;
            bf16_t* base = (isq ? Q : K) + ((pn & 1) * 4 + wc) * 64 + 8 * fq;
            f32x4 wv[2][2];
#pragma unroll
            for (int bj = 0; bj < 2; ++bj)
#pragma unroll
                for (int n = 0; n < 2; ++n) wv[bj][n] = *(const f32x4*)(wn + 32 * bj + 8 * fq + 4 * n);
#pragma unroll
            for (int ai = 0; ai < 2; ++ai)
#pragma unroll
                for (int m = 0; m < 4; ++m) {
                    float ss = 0.f;
#pragma unroll
                    for (int bj = 0; bj < 2; ++bj)
#pragma unroll
                        for (int n = 0; n < 2; ++n) { const f32x4 x = acc[ai][bj][m][n]; ss += (x[0] * x[0] + x[1] * x[1]) + (x[2] * x[2] + x[3] * x[3]); }
                    ss += __shfl_xor(ss, 16); ss += __shfl_xor(ss, 32);
                    const float r = rsqrtf(ss * (1.f / 64.f) + EPS) * sc;
                    bf16_t* rowp = base + (size_t)(row0 + ai * HALF + m * 16) * 512;
#pragma unroll
                    for (int bj = 0; bj < 2; ++bj) *(u32x4*)(rowp + bj * 32) = pack8(acc[ai][bj][m][0] * r * wv[bj][0], acc[ai][bj][m][1] * r * wv[bj][1]);
                }
        } else {
            bf16_t* base = (pn < 12 ? SGA : SGB) + ((pn - 8) & 3) * 256 + wc * 32 + 8 * fq;
#pragma unroll
            for (int ai = 0; ai < 2; ++ai)
#pragma unroll
                for (int m = 0; m < 4; ++m) { bf16_t* rowp = base + (size_t)(row0 + ai * HALF + m * 16) * 1024;
#pragma unroll
                    for (int bj = 0; bj < 2; ++bj) *(u32x4*)(rowp + bj * HALF) = pack8(sig4(acc[ai][bj][m][0]), sig4(acc[ai][bj][m][1])); }
        }
    }
};
struct EpiGlu {
    static constexpr bool PERM = true, AFTER_DRAIN = false, MID = false;
    const bf16_t* Ain; const float* bglu; bf16_t* YA; int ldo;
    __device__ __forceinline__ void operator()(const f32x4 (&acc)[2][2][4][2], const Unit& u, int wr, int wc, int fr, int fq) const {
        const int row0 = u.pm * BM + wr * 64 + fr, col0 = u.pn * BM + wc * 32 + 8 * fq;
        f32x4 bv[2][2];
#pragma unroll
        for (int bj = 0; bj < 2; ++bj)
#pragma unroll
            for (int n = 0; n < 2; ++n) bv[bj][n] = *(const f32x4*)(bglu + col0 + bj * HALF + 4 * n);
#pragma unroll
        for (int ai = 0; ai < 2; ++ai)
#pragma unroll
            for (int m = 0; m < 4; ++m) { const size_t off = (size_t)(row0 + ai * HALF + m * 16) * 512 + col0, offo = (size_t)(row0 + ai * HALF + m * 16) * ldo + col0;
#pragma unroll
                for (int bj = 0; bj < 2; ++bj) { f32x4 a0, a1; unpack8(*(const u32x4*)(Ain + off + bj * HALF), a0, a1);
                    *(u32x4*)(YA + offo + bj * HALF) = pack8(a0 * sig4(acc[ai][bj][m][0] + bv[bj][0]), a1 * sig4(acc[ai][bj][m][1] + bv[bj][1])); } }
    }
};
struct EpiMerge {
    static constexpr bool PERM = true, AFTER_DRAIN = false, MID = true;
    const bf16_t* SGA; const bf16_t* SGB; bf16_t* Mo;
    __device__ __forceinline__ void mid(f32x4 (&acc)[2][2][4][2], const Unit& u, int wr, int wc, int fr, int fq) const {
        int row0_ = u.pm * BM + wr * 64 + fr, col0_ = u.pn * BM + wc * 32 + 8 * fq;
        asm volatile("" : "+v"(row0_), "+v"(col0_));
        const int row0 = row0_, col0 = col0_;
#pragma unroll
        for (int ai = 0; ai < 2; ++ai)
#pragma unroll
            for (int m = 0; m < 4; ++m) { const size_t off = (size_t)(row0 + ai * HALF + m * 16) * 1024 + col0;
#pragma unroll
                for (int bj = 0; bj < 2; ++bj) { f32x4 a0, a1, b0, b1; unpack8(*(const u32x4*)(SGA + off + bj * HALF), a0, a1); unpack8(*(const u32x4*)(SGB + off + bj * HALF), b0, b1);
#pragma unroll
                    for (int e = 0; e < 4; ++e) { acc[ai][bj][m][0][e] *= a0[e] * __builtin_amdgcn_rcpf(b0[e]); acc[ai][bj][m][1][e] *= a1[e] * __builtin_amdgcn_rcpf(b1[e]); } }
                if (m == 3) __builtin_amdgcn_sched_barrier(0); }
    }
    __device__ __forceinline__ void operator()(const f32x4 (&acc)[2][2][4][2], const Unit& u, int wr, int wc, int fr, int fq) const {
        int row0_ = u.pm * BM + wr * 64 + fr, col0_ = u.pn * BM + wc * 32 + 8 * fq;
        asm volatile("" : "+v"(row0_), "+v"(col0_));
        const int row0 = row0_, col0 = col0_;
#pragma unroll
        for (int ai = 0; ai < 2; ++ai)
#pragma unroll
            for (int m = 0; m < 4; ++m) { const size_t off = (size_t)(row0 + ai * HALF + m * 16) * 1024 + col0;
#pragma unroll
                for (int bj = 0; bj < 2; ++bj) { f32x4 b0, b1; unpack8(*(const u32x4*)(SGB + off + bj * HALF), b0, b1);
                    *(u32x4*)(Mo + off + bj * HALF) = pack8(acc[ai][bj][m][0] * b0, acc[ai][bj][m][1] * b1); } }
    }
};
struct ExpertGather { const int* idx; __device__ __forceinline__ unsigned row(int pm, int r) const { return (unsigned)((pm >> 6) * SEQ + idx[pm * BM + r]); } };
struct EpiOut {
    static constexpr bool PERM = false, AFTER_DRAIN = false, MID = false;
    const float* x; const float* mod; float* X1;
    __device__ __forceinline__ void operator()(const f32x4 (&acc)[2][2][4][2], const Unit& u, int wr, int wc, int fr, int fq) const {
        const int row0 = u.pm * BM + wr * 64 + fr, col0 = u.pn * BM + wc * 32 + 4 * fq;
        const float* g1 = mod + ((u.pm * BM) >> 13) * 6144 + 2048;
        f32x4 gv[2][2];
#pragma unroll
        for (int bj = 0; bj < 2; ++bj)
#pragma unroll
            for (int n = 0; n < 2; ++n) gv[bj][n] = *(const f32x4*)(g1 + col0 + bj * HALF + n * 16);
#pragma unroll
        for (int ai = 0; ai < 2; ++ai)
#pragma unroll
            for (int m = 0; m < 4; ++m) { const size_t off = (size_t)(row0 + ai * HALF + m * 16) * 1024 + col0;
#pragma unroll
                for (int bj = 0; bj < 2; ++bj)
#pragma unroll
                    for (int n = 0; n < 2; ++n) *(f32x4*)(X1 + off + bj * HALF + n * 16) = *(const f32x4*)(x + off + bj * HALF + n * 16) + gv[bj][n] * acc[ai][bj][m][n]; }
    }
};
struct EpiHid {
    static constexpr bool PERM = true, AFTER_DRAIN = false, MID = false;
    bf16_t* HID;
    __device__ __forceinline__ void operator()(const f32x4 (&acc)[2][2][4][2], const Unit& u, int wr, int wc, int fr, int fq) const {
        const int row0 = u.pm * BM + wr * 64 + fr, f0 = (u.pn & 7) * 128 + wc * 16 + 4 * fq;
#pragma unroll
        for (int ai = 0; ai < 2; ++ai)
#pragma unroll
            for (int m = 0; m < 4; ++m) { bf16_t* rowp = HID + (size_t)(row0 + ai * HALF + m * 16) * 1024 + f0;
#pragma unroll
                for (int bj = 0; bj < 2; ++bj) { const f32x4 g = acc[ai][bj][m][0], up = acc[ai][bj][m][1];
                    u32x2 w; w.x = cvt_pk_bf16(silu_f(g[0]) * up[0], silu_f(g[1]) * up[1]); w.y = cvt_pk_bf16(silu_f(g[2]) * up[2], silu_f(g[3]) * up[3]);
                    *(u32x2*)(rowp + bj * 64) = w; } }
    }
};
struct EpiDown {
    static constexpr bool PERM = true, AFTER_DRAIN = false, MID = false;
    const float* GSEL; bf16_t* Y;
    __device__ __forceinline__ void operator()(const f32x4 (&acc)[2][2][4][2], const Unit& u, int wr, int wc, int fr, int fq) const {
        const int row0 = u.pm * BM + wr * 64 + fr, col0 = (u.pn & 3) * BM + wc * 32 + 8 * fq;
#pragma unroll
        for (int ai = 0; ai < 2; ++ai)
#pragma unroll
            for (int m = 0; m < 4; ++m) { const int row = row0 + ai * HALF + m * 16; const float gs = GSEL[row]; bf16_t* rowp = Y + (size_t)row * 1024 + col0;
#pragma unroll
                for (int bj = 0; bj < 2; ++bj) *(u32x4*)(rowp + bj * HALF) = pack8(acc[ai][bj][m][0] * gs, acc[ai][bj][m][1] * gs); }
    }
};
template <int NT  > struct ExpertOrder {
    int G, c;
    __device__ void init(int G_, int c_) { G = G_; c = c_; }
    __device__ bool next(int i, Unit& u) const {
        constexpr int UPE = 8 * NT;
        long L = (long)i * G + c; if (L >= 16 * UPE) return false;
        if (G == 256) { const int xcd = c & 7, local = c >> 3, rpe = UPE / 32  ; L = (long)(xcd + 8 * (i / rpe)) * UPE + (i % rpe) * 32 + local; }
        const int e = (int)(L / UPE), uu = (int)(L % UPE), b = uu / (4 * NT), m = (uu / NT) & 3, j = uu % NT;
        u.pm = (b * 16 + e) * 4 + m; u.pn = e * NT + j; return true;
    }
    __device__ __forceinline__ void a_ready(const Unit&) const {}
    __device__ __forceinline__ void done(const Unit&) const {}
};
struct NoGather { __device__ __forceinline__ unsigned row(int, int r) const { return (unsigned)r; } };
template <class Epi, class Sched, bool ALIGN_EPI = false, bool GATHER = false, class Gat = NoGather>
__device__ __forceinline__ void gemm_phase(PG8_LAS unsigned char* lds, const Gemm g, const Sched& S, const Epi& E, const Gat gat = Gat()) {
    const int tid = threadIdx.x, wid = __builtin_amdgcn_readfirstlane(tid >> 6), lane = tid & 63, wr = wid >> 2, wc = wid & 3, fr = lane & 15, fq = lane >> 4;
    const int K = g.K, nt = K / BK;
    const size_t kstep = (size_t)(BK * 2);
    const size_t hstep = (size_t)HALF * K * 2;
    const size_t tstep = 2 * hstep;
    unsigned voffB[2]; int Ra[2], Ca[2];
#pragma unroll
    for (int i = 0; i < 2; ++i) { int R, C; stage_rc(tid * 16 + i * 8192, R, C); const int Rb = Epi::PERM ? ((R & ~31) + perm32(R & 31)) : R;
        Ra[i] = R; Ca[i] = C; voffB[i] = (unsigned)(Rb * K + C) * 2u; }
    unsigned vAc[2][2], vAn[2][2];
#define PG8_AOFF(dst, pm) do { _Pragma("unroll") for (int h_ = 0; h_ < 2; ++h_) _Pragma("unroll") for (int i_ = 0; i_ < 2; ++i_) \
        dst[h_][i_] = GATHER ? (gat.row((pm), h_ * HALF + Ra[i_]) * (unsigned)K + (unsigned)Ca[i_]) * 2u : (unsigned)((h_ * HALF + Ra[i_]) * K + Ca[i_]) * 2u; } while (0)
    const unsigned ldsw = (unsigned)wid * 1024u;
    const int aoff = lds_byte(wr * 64 + fr, fq * 8), boff = lds_byte(wc * 32 + fr, fq * 8);
#define PG8_SA(b, h) (((b) * 2 + (h)) * HTB)
#define PG8_SB(b, h) ((4 + (b) * 2 + (h)) * HTB)
#define PG8_STAGE(bufoff, gbase, voff) do { _Pragma("unroll") for (int _i = 0; _i < 2; ++_i) \
        __builtin_amdgcn_global_load_lds((const unsigned*)((const char*)(gbase) + (voff)[_i]), (PG8_LAS unsigned*)(lds + (bufoff) + ldsw + _i * 8192), 16, 0, 0); } while (0)
#define PG8_LDA(dst, b, h) do { _Pragma("unroll") for (int m = 0; m < 4; ++m) _Pragma("unroll") for (int k = 0; k < 2; ++k) dst[m][k] = *(const PG8_LAS bf16x8*)(lds + PG8_SA(b, h) + aoff + m * 2048 + k * 1024); } while (0)
#define PG8_LDB(dst, b, h) do { _Pragma("unroll") for (int n = 0; n < 2; ++n) _Pragma("unroll") for (int k = 0; k < 2; ++k) dst[n][k] = *(const PG8_LAS bf16x8*)(lds + PG8_SB(b, h) + boff + n * 2048 + k * 1024); } while (0)
#define PG8_MMA(ai, bj, At, Bt) do { __builtin_amdgcn_s_setprio(1); _Pragma("unroll") for (int m = 0; m < 4; ++m) _Pragma("unroll") for (int n = 0; n < 2; ++n) _Pragma("unroll") for (int k = 0; k < 2; ++k) \
        acc[ai][bj][m][n] = __builtin_amdgcn_mfma_f32_16x16x32_bf16(Bt[n][k], At[m][k], acc[ai][bj][m][n], 0, 0, 0); __builtin_amdgcn_s_setprio(0); } while (0)
#define PG8_WAIT_V(n) asm volatile("s_waitcnt vmcnt(" #n ")" ::: "memory")
#define PG8_WAIT_L(n) asm volatile("s_waitcnt lgkmcnt(" #n ")" ::: "memory")
#define PG8_BAR __builtin_amdgcn_s_barrier()
#define PG8_SCHED __builtin_amdgcn_sched_barrier(0)
    Unit cur, nxt; int ui = 0;
    if (!S.next(0, cur)) return;
    f32x4 acc[2][2][4][2];
#pragma unroll
    for (int a = 0; a < 2; ++a)
#pragma unroll
        for (int b = 0; b < 2; ++b)
#pragma unroll
            for (int m = 0; m < 4; ++m)
#pragma unroll
                for (int n = 0; n < 2; ++n) acc[a][b][m][n] = (f32x4){0.f, 0.f, 0.f, 0.f};
    bf16x8 At[4][2], B0[2][2], B1[2][2];
    const char* cA = (const char*)g.A + (GATHER ? (size_t)0 : (size_t)cur.pm * tstep); const char* cB = (const char*)g.Bt + (size_t)cur.pn * tstep;
    PG8_AOFF(vAc, cur.pm);
    S.a_ready(cur);
    PG8_STAGE(PG8_SB(0, 0), cB, voffB); PG8_STAGE(PG8_SB(0, 1), cB + hstep, voffB); PG8_STAGE(PG8_SA(0, 0), cA, vAc[0]); PG8_STAGE(PG8_SA(0, 1), cA, vAc[1]);
    if (wr == 1) PG8_BAR;
    PG8_WAIT_V(2); PG8_BAR;
    PG8_STAGE(PG8_SB(1, 0), cB + kstep, voffB); PG8_STAGE(PG8_SA(1, 0), cA + kstep, vAc[0]); PG8_STAGE(PG8_SB(1, 1), cB + hstep + kstep, voffB);
    PG8_WAIT_V(6); PG8_BAR;
    for (;;) {
        const bool has_next = S.next(ui + 1, nxt);
        const char* nA = (has_next && !GATHER) ? (const char*)g.A + (size_t)nxt.pm * tstep : cA; const char* nB = has_next ? (const char*)g.Bt + (size_t)nxt.pn * tstep : cB;
        if (has_next) PG8_AOFF(vAn, nxt.pm); else { _Pragma("unroll") for (int h_ = 0; h_ < 2; ++h_) _Pragma("unroll") for (int i_ = 0; i_ < 2; ++i_) vAn[h_][i_] = vAc[h_][i_]; }
        for (int t = 0; t < nt; t += 2) {
            const bool last = (t == nt - 2);
            const char* a1 = cA + (size_t)(t + 1) * kstep;
            const char* a2 = last ? nA : cA + (size_t)(t + 2) * kstep; const char* b2 = last ? nB : cB + (size_t)(t + 2) * kstep;
            const char* a3 = a2 + kstep; const char* b3 = b2 + kstep;
            unsigned v2[2][2];
#pragma unroll
            for (int h_ = 0; h_ < 2; ++h_)
#pragma unroll
                for (int i_ = 0; i_ < 2; ++i_) v2[h_][i_] = last ? vAn[h_][i_] : vAc[h_][i_];
            if (last && has_next) S.a_ready(nxt);
            PG8_LDB(B0, 0, 0); PG8_LDB(B1, 0, 1); PG8_SCHED; PG8_LDA(At, 0, 0); PG8_STAGE(PG8_SA(1, 1), a1, vAc[1]);
            PG8_WAIT_V(8); PG8_WAIT_L(0); PG8_BAR; PG8_MMA(0, 0, At, B0); PG8_MMA(0, 1, At, B1); PG8_BAR; PG8_SCHED;
            PG8_LDA(At, 0, 1); PG8_STAGE(PG8_SB(0, 0), b2, voffB); PG8_STAGE(PG8_SB(0, 1), b2 + hstep, voffB); PG8_STAGE(PG8_SA(0, 0), a2, v2[0]);
            PG8_WAIT_V(8); PG8_WAIT_L(0); PG8_BAR; PG8_MMA(1, 0, At, B0); PG8_MMA(1, 1, At, B1); PG8_BAR; PG8_SCHED;
            PG8_LDB(B0, 1, 0); PG8_LDB(B1, 1, 1); PG8_SCHED; PG8_LDA(At, 1, 0); PG8_STAGE(PG8_SA(0, 1), a2, v2[1]);
            PG8_WAIT_V(8); PG8_WAIT_L(0); PG8_BAR; PG8_MMA(0, 0, At, B0); PG8_MMA(0, 1, At, B1); PG8_BAR; PG8_SCHED;
            PG8_LDA(At, 1, 1); PG8_STAGE(PG8_SB(1, 0), b3, voffB); PG8_STAGE(PG8_SB(1, 1), b3 + hstep, voffB); PG8_STAGE(PG8_SA(1, 0), a3, v2[0]);
            PG8_WAIT_V(8); PG8_WAIT_L(0); PG8_BAR; PG8_MMA(1, 0, At, B0); PG8_MMA(1, 1, At, B1); PG8_BAR; PG8_SCHED;
            if constexpr (Epi::MID) { if (t == nt / 2 - 2) { E.mid(acc, cur, wr, wc, fr, fq); PG8_SCHED; } }
        }
        if constexpr (ALIGN_EPI) { if (wr == 0) PG8_BAR; }
        if constexpr (!Epi::AFTER_DRAIN) { E(acc, cur, wr, wc, fr, fq); S.done(cur); }
        if (!has_next) break;
#pragma unroll
        for (int a = 0; a < 2; ++a)
#pragma unroll
            for (int b = 0; b < 2; ++b)
#pragma unroll
                for (int m = 0; m < 4; ++m)
#pragma unroll
                    for (int n = 0; n < 2; ++n) acc[a][b][m][n] = (f32x4){0.f, 0.f, 0.f, 0.f};
        cur = nxt; cA = nA; cB = nB; ++ui;
#pragma unroll
        for (int h_ = 0; h_ < 2; ++h_)
#pragma unroll
            for (int i_ = 0; i_ < 2; ++i_) vAc[h_][i_] = vAn[h_][i_];
        if constexpr (ALIGN_EPI) { if (wr == 1) PG8_BAR; }
    }
    PG8_WAIT_V(0);
    if constexpr (!ALIGN_EPI) { if (wr == 0) PG8_BAR; }
    PG8_BAR;
    if constexpr (Epi::AFTER_DRAIN) { E.fused(acc, cur, wr, wc, fr, fq, lds, wid, lane); S.done(cur); }
#undef PG8_AOFF
#undef PG8_SA
#undef PG8_SB
#undef PG8_STAGE
#undef PG8_LDA
#undef PG8_LDB
#undef PG8_MMA
#undef PG8_WAIT_V
#undef PG8_WAIT_L
#undef PG8_BAR
#undef PG8_SCHED
}
}
#define GAS __attribute__((address_space(1)))
#define LAS __attribute__((address_space(3)))
typedef unsigned short bf16;
typedef unsigned v4u __attribute__((ext_vector_type(4)));
typedef float f32x4 __attribute__((ext_vector_type(4)));
typedef short bf16x8 __attribute__((ext_vector_type(8)));
typedef GAS unsigned gu32;
typedef GAS unsigned long long gu64;
#define RLX_AGENT __ATOMIC_RELAXED, __HIP_MEMORY_SCOPE_AGENT
#define LDS_WAIT() asm volatile("s_waitcnt lgkmcnt(0)" ::: "memory")
#define VM_WAIT() asm volatile("s_waitcnt vmcnt(0)" ::: "memory")
__device__ __forceinline__ unsigned long long rt() { return __builtin_amdgcn_s_memrealtime(); }
__device__ __forceinline__ unsigned f2bf(float f) { unsigned u = __builtin_bit_cast(unsigned, f); return (u + 0x7fffu + ((u >> 16) & 1u)) >> 16; }
__device__ __forceinline__ unsigned pk2(float lo, float hi) { return f2bf(lo) | (f2bf(hi) << 16); }

#define XB_TMO      128
#define XB_XCNT(j)  (256  + 64 * (j))
#define XB_XSUB(j)  (1280 + 64 * (j))
#define XB_XGEN(j)  (2304 + 64 * (j))
#define XB_TOP      3328
#define XB_TOPGEN   3392
#define XCD_BAR_WORDS 3456
#define XB_SPIN_CAP (1u << 18)

__device__ __forceinline__ unsigned xb_ld(unsigned* p)              { return __hip_atomic_load(p, __ATOMIC_RELAXED, __HIP_MEMORY_SCOPE_AGENT); }
__device__ __forceinline__ unsigned xb_add(unsigned* p, unsigned v) { return __hip_atomic_fetch_add(p, v, __ATOMIC_RELAXED, __HIP_MEMORY_SCOPE_AGENT); }
__device__ __forceinline__ unsigned xb_xcc_id() { return (unsigned)__builtin_amdgcn_s_getreg((3 << 11) | 20) & 0xFu; }
#define XB_SPIN(cond, bar) do { unsigned _sp = 0; while (cond) { __builtin_amdgcn_s_sleep(1); \
    if ((++_sp & 255u) == 0u) { if (xb_ld(&(bar)[XB_TMO])) break; if (_sp > XB_SPIN_CAP) { atomicAdd(&(bar)[XB_TMO], 1u); break; } } } } while (0)

struct XcdBarrier {
    unsigned* bar; unsigned x;
    volatile LAS unsigned* st;
};

__device__ __forceinline__ XcdBarrier xcd_barrier_post(unsigned* bar, volatile LAS unsigned* st) {
    XcdBarrier b; b.bar = bar; b.x = xb_xcc_id(); b.st = st;
    if (threadIdx.x == 0) (void)xb_add(&bar[XB_XCNT(b.x)], 1u);
    return b;
}
__device__ __forceinline__ void xcd_barrier_complete(unsigned* bar, unsigned x, unsigned& nloc, unsigned& nx) {
    const unsigned G = gridDim.x * gridDim.y * gridDim.z;
    unsigned sum, cnt, mine, sp = 0u;
    for (;;) {
        sum = 0u; cnt = 0u; mine = 0u;
#pragma unroll
        for (unsigned j = 0; j < 16; ++j) { const unsigned c = xb_ld(&bar[XB_XCNT(j)]); sum += c; cnt += (c > 0u) ? 1u : 0u; mine = (j == x) ? c : mine; }
        if (sum == G) break;
        __builtin_amdgcn_s_sleep(1);
        if ((++sp & 255u) == 0u) { if (xb_ld(&bar[XB_TMO])) break; if (sp > XB_SPIN_CAP) { atomicAdd(&bar[XB_TMO], 1u); break; } }
    }
    nloc = mine > 0u ? mine : 1u; nx = cnt > 0u ? cnt : 1u;
}

__device__ __forceinline__ void xcd_barrier(const XcdBarrier& b) {
    asm volatile("s_waitcnt vmcnt(0)" ::: "memory");
    __syncthreads();
    if (threadIdx.x == 0) {
        unsigned* bar = b.bar;
        __builtin_amdgcn_s_waitcnt(0);
        unsigned nloc = b.st[0], nx = b.st[1];
        if (nloc == 0u) { xcd_barrier_complete(bar, b.x, nloc, nx); b.st[0] = nloc; b.st[1] = nx; }
        const unsigned old = xb_add(&bar[XB_XSUB(b.x)], 1u);
        const unsigned gen = old / nloc;
        if (old + 1u == (gen + 1u) * nloc) {
            __builtin_amdgcn_fence(__ATOMIC_RELEASE, "agent");
            asm volatile("s_waitcnt vmcnt(0)" ::: "memory");
            const unsigned og = xb_add(&bar[XB_TOP], 1u);
            const unsigned tg = og / nx;
            if (og + 1u == (tg + 1u) * nx) xb_add(&bar[XB_TOPGEN], 1u);
            else XB_SPIN(xb_ld(&bar[XB_TOPGEN]) == tg, bar);
            __builtin_amdgcn_fence(__ATOMIC_ACQUIRE, "agent");
            xb_add(&bar[XB_XGEN(b.x)], 1u);
            asm volatile("s_waitcnt vmcnt(0)" ::: "memory");
        } else {
            XB_SPIN(xb_ld(&bar[XB_XGEN(b.x)]) == gen, bar);
            __builtin_amdgcn_fence(__ATOMIC_ACQUIRE, "agent");
            asm volatile("s_waitcnt vmcnt(0)" ::: "memory");
        }
    }
    __syncthreads();
}

#ifndef PROBE_MASK
#define PROBE_MASK 0
#endif
#ifndef PROBE_VARIANT
#define PROBE_VARIANT 7
#endif
#ifndef PROBE_REPS
#define PROBE_REPS 4
#endif
constexpr int NWAVES = 8;
constexpr size_t MiB = 1u << 20;
constexpr size_t WS_CTL = 0, CTL_ZERO_BYTES = 256 * 1024;
constexpr int CW_TMO = 0, CW_CODE = 1, CW_BAR = 4096;
constexpr size_t WS_MOD = 160 * 1024;
constexpr size_t WS_AFF = 1 * MiB, WS_IDX = 2 * MiB, WS_GSEL = 2 * MiB + 256 * 1024, WS_SLOT = 3 * MiB;
constexpr size_t WS_H = 4 * MiB;
constexpr size_t WS_BG = 38 * MiB;
constexpr size_t WS_U = WS_BG, WS_V = WS_BG + 17 * MiB, WS_K = WS_BG + 34 * MiB, WS_Q = WS_BG + 51 * MiB, WS_SGA = WS_BG + 68 * MiB, WS_SGB = WS_BG + 100 * MiB;
constexpr size_t WS_YS = WS_BG + 132 * MiB, WS_YAB = WS_BG + 156 * MiB;
constexpr size_t WS_M = WS_BG;
constexpr size_t WS_XE = WS_BG, WS_WGU = WS_SGA, WS_HID = WS_BG + 132 * MiB;
constexpr size_t WS_WIN = 226 * MiB, WS_WGLU = 234 * MiB, WS_WPA = 235 * MiB, WS_WOUT = 237 * MiB;
constexpr size_t WS_WD = 239 * MiB, WS_END = 271 * MiB;
static_assert(WS_YAB + 32 * MiB <= WS_WIN && WS_HID + 64 * MiB <= WS_WD && WS_XE + 64 * MiB <= WS_WGU && WS_WGU + 64 * MiB <= WS_HID && WS_WOUT + 2 * MiB <= WS_WD, "d_ws map");
static_assert(CW_BAR * 4 + 8 * XCD_BAR_WORDS * 4 <= (int)WS_MOD && WS_MOD + 3 * 6144 * 4 <= CTL_ZERO_BYTES, "control region");

constexpr int RING_OFF = 0, RING_BYTES = 131072;
constexpr int LDSCTL_OFF = RING_BYTES, MISC_OFF = LDSCTL_OFF + 320;
constexpr int LDS_BYTES = 147456;

__device__ __forceinline__ float wave_sum(float v) {
#pragma unroll
    for (int o = 1; o < 64; o <<= 1) v += __shfl_xor(v, o);
    return v;
}
template <int MODE> __device__ __forceinline__ int wrow(int n) {
    if (MODE == 1) { const int t = n >> 8, cl = n & 255; return (t >= 2 && t < 6) ? (t * 256 + 128 * ((cl >> 5) & 1) + 32 * (cl >> 6) + (cl & 31)) : n; }
    if (MODE == 2) return (n >> 2) * 8 + (n & 3);
    if (MODE == 3) return (n >> 2) * 8 + 4 + (n & 3);
    return n;
}
template <int MODE> __device__ __forceinline__ void transpose_item(const float* W, int K, int N, bf16* WT, int ldw, LAS float* scr, int item, int lane) {
    const int nblk = N / 32, kb = item / nblk, nb = item % nblk, k0 = 64 * kb, n0 = 32 * nb;
    f32x4 ld[8];
#pragma unroll
    for (int i = 0; i < 8; ++i) ld[i] = *(const f32x4*)(W + (size_t)(k0 + 8 * i + (lane >> 3)) * N + n0 + 4 * (lane & 7));
#pragma unroll
    for (int i = 0; i < 8; ++i) { LAS float* d = scr + (8 * i + (lane >> 3)) * 33 + 4 * (lane & 7); d[0] = ld[i][0]; d[1] = ld[i][1]; d[2] = ld[i][2]; d[3] = ld[i][3]; }
    LDS_WAIT(); asm volatile("" ::: "memory");
    const int c = lane & 7;
#pragma unroll
    for (int j = 0; j < 4; ++j) { const int n = (lane >> 3) + 8 * j; const LAS float* s = scr + (8 * c) * 33 + n;
        v4u o; o.x = pk2(s[0 * 33], s[1 * 33]); o.y = pk2(s[2 * 33], s[3 * 33]); o.z = pk2(s[4 * 33], s[5 * 33]); o.w = pk2(s[6 * 33], s[7 * 33]);
        *(GAS v4u*)(WT + (size_t)wrow<MODE>(n0 + n) * ldw + k0 + 8 * c) = o; }
    LDS_WAIT(); asm volatile("" ::: "memory");
}

__device__ __forceinline__ void norm1_rows(const float* src0, bf16* dst0, int nrow, const float* gwt, const float* md, int lane) {
    f32x4 ca[4], cb[4];
#pragma unroll
    for (int j = 0; j < 4; ++j) { const int col = j * 256 + lane * 4; ca[j] = *(const f32x4*)(gwt + col) * (*(const f32x4*)(md + 1024 + col) + 1.f); cb[j] = *(const f32x4*)(md + col); }
    for (int rr = 0; rr < nrow; rr += 2) {
        const int rb_ = (rr + 1 < nrow) ? rr + 1 : rr;
        const float* sa = src0 + (size_t)rr * D; const float* sb = src0 + (size_t)rb_ * D;
        f32x4 va[4], vb[4]; float ssa = 0.f, ssb = 0.f;
#pragma unroll
        for (int j = 0; j < 4; ++j) { va[j] = *(const f32x4*)(sa + j * 256 + lane * 4); vb[j] = *(const f32x4*)(sb + j * 256 + lane * 4); }
#pragma unroll
        for (int j = 0; j < 4; ++j) { ssa += (va[j][0] * va[j][0] + va[j][1] * va[j][1]) + (va[j][2] * va[j][2] + va[j][3] * va[j][3]); ssb += (vb[j][0] * vb[j][0] + vb[j][1] * vb[j][1]) + (vb[j][2] * vb[j][2] + vb[j][3] * vb[j][3]); }
        const float ra = rsqrtf(wave_sum(ssa) * (1.f / D) + EPS), rb = rsqrtf(wave_sum(ssb) * (1.f / D) + EPS);
#pragma unroll
        for (int j = 0; j < 4; ++j) {
            const int col = j * 256 + lane * 4;
            const f32x4 oa = va[j] * ra * ca[j] + cb[j], ob = vb[j] * rb * ca[j] + cb[j];
            pg8::u32x2 w; w.x = pk2(oa[0], oa[1]); w.y = pk2(oa[2], oa[3]); *(pg8::u32x2*)(dst0 + (size_t)rr * D + col) = w;
            w.x = pk2(ob[0], ob[1]); w.y = pk2(ob[2], ob[3]); *(pg8::u32x2*)(dst0 + (size_t)rb_ * D + col) = w;
        }
    }
}

struct Args { const float* in[29]; float* out; unsigned char* ws; int ph_lo, ph_hi, li, pad; };
enum { I_X = 0, I_C, I_CTX, I_CCTX, I_WADA, I_BADA, I_NMIX, I_NFFN, I_WIN, I_LRE, I_LIM, I_LDT, I_BRE, I_BIM, I_CRE, I_CIM, I_SD, I_WGLU, I_BGLU, I_QN, I_KN, I_RPB, I_WPA, I_WPB, I_WOUT, I_WR, I_WEG, I_WEU, I_WED };

typedef float f32x16 __attribute__((ext_vector_type(16)));
constexpr int S5_CH = 64, S5_NCH = 132, S5_NST = S5_CH / 16, S5_NPAIR = S5_NCH / 2, S5_NLAT = SEQ / S5_CH, S5_NCC = NCTX / S5_CH;
constexpr size_t WS_LAM = 512 * 1024, WS_LAMP = 512 * 1024 + 32768;
constexpr size_t WS_S5B = 2 * MiB + 512 * 1024, WS_S5C = 2 * MiB + 768 * 1024;
constexpr size_t WS_SEND = WS_YS, WS_HIN = WS_YS + 12 * MiB;

__device__ __forceinline__ void s5_prep(const Args& args, unsigned char* ws, int dg, int lane) {
    const float* lam_re = args.in[I_LRE]; const float* lam_im = args.in[I_LIM]; const float* b_re = args.in[I_BRE]; const float* b_im = args.in[I_BIM];
    const float* c_re = args.in[I_CRE]; const float* c_im = args.in[I_CIM];
    const float dt = expf(args.in[I_LDT][dg]);
    {
        const int p = lane; const float lre = lam_re[dg * 64 + p], lim = lam_im[dg * 64 + p];
        const float er = expf(lre * dt); float xr = er * cosf(lim * dt), xi = er * sinf(lim * dt);
        float* L = (float*)(ws + WS_LAM) + (dg * 64 + p) * 2; L[0] = xr; L[1] = xi;
#pragma unroll
        for (int s = 0; s < 6; ++s) { const float nr = xr * xr - xi * xi, ni = 2.f * xr * xi; xr = nr; xi = ni; }
        float* LP = (float*)(ws + WS_LAMP) + (dg * 64 + p) * 2; LP[0] = xr; LP[1] = xi;
    }
    const int r = lane & 31, h = lane >> 5;
#pragma unroll
    for (int q = 0; q < 4; ++q) {
        const int p = 2 * r + (q >> 1); const float lre = lam_re[dg * 64 + p], lim = lam_im[dg * 64 + p];
        const float er = expf(lre * dt), lbr = er * cosf(lim * dt), lbi = er * sinf(lim * dt);
        const float nr = lbr - 1.f, ni = lbi, den = lre * lre + lim * lim, cr = (nr * lre + ni * lim) / den, ci = (ni * lre - nr * lim) / den;
        unsigned w[4];
#pragma unroll
        for (int jj = 0; jj < 8; jj += 2) {
            float v[2];
#pragma unroll
            for (int e = 0; e < 2; ++e) { const int c = 8 * h + jj + e; const float br = b_re[(dg * 64 + p) * 16 + c], bi = b_im[(dg * 64 + p) * 16 + c]; v[e] = (q & 1) ? (cr * bi + ci * br) : (cr * br - ci * bi); }
            w[jj >> 1] = pk2(v[0], v[1]);
        }
        *(v4u*)(ws + WS_S5B + ((size_t)(dg * 4 + q) * 64 + lane) * 16) = (v4u){w[0], w[1], w[2], w[3]};
    }
    const int ch = lane & 15, fq = lane >> 4;
#pragma unroll
    for (int ks = 0; ks < 4; ++ks) {
        unsigned w[4];
#pragma unroll
        for (int jj = 0; jj < 8; jj += 2) { const int st = (32 * ks + 8 * fq + jj) >> 1;
            w[jj >> 1] = pk2(c_re[(dg * 16 + ch) * 64 + st], -c_im[(dg * 16 + ch) * 64 + st]); }
        *(v4u*)(ws + WS_S5C + ((size_t)(dg * 4 + ks) * 64 + lane) * 16) = (v4u){w[0], w[1], w[2], w[3]};
    }
}
__device__ __forceinline__ int s5_row(int b, int dir, int pos) {
    if (pos < NCTX) return MLAT + b * NCTX + (dir ? NCTX - 1 - pos : pos);
    const int t = pos - NCTX; return b * SEQ + (dir ? SEQ - 1 - t : t);
}
#define S5_SCAN16(D0, D1, D2, D3) do { _Pragma("unroll") for (int r_ = 0; r_ < 16; ++r_) { \
        const float n0r = fmaf(lm[0], x[0], fmaf(-lm[1], x[1], D0[r_])), n0i = fmaf(lm[0], x[1], fmaf(lm[1], x[0], D1[r_])); \
        const float n1r = fmaf(lm[2], x[2], fmaf(-lm[3], x[3], D2[r_])), n1i = fmaf(lm[2], x[3], fmaf(lm[3], x[2], D3[r_])); \
        x[0] = n0r; x[1] = n0i; x[2] = n1r; x[3] = n1i; D0[r_] = n0r; D1[r_] = n0i; D2[r_] = n1r; D3[r_] = n1i; } } while (0)

#define S5_SCAN16_ONE(Dr, Di, LR, LI, XR, XI) do { _Pragma("unroll") for (int r_ = 0; r_ < 16; ++r_) { \
        const float nr_ = fmaf(LR, XR, fmaf(-(LI), XI, Dr[r_])), ni_ = fmaf(LR, XI, fmaf(LI, XR, Di[r_])); XR = nr_; XI = ni_; Dr[r_] = nr_; Di[r_] = ni_; } } while (0)
__device__ __forceinline__ void s5_pass1(unsigned char* ws, int task, int lane) {
    const int chain = task / S5_NPAIR, w = task % S5_NPAIR, g = chain & 31, dir = (chain >> 5) & 1, b = chain >> 6, dg = dir * 32 + g;
    const bf16* U = (const bf16*)(ws + WS_U);
    bf16x8 Bf[4];
#pragma unroll
    for (int q = 0; q < 4; ++q) Bf[q] = *(const bf16x8*)(ws + WS_S5B + ((size_t)(dg * 4 + q) * 64 + lane) * 16);
    const f32x4 lm = *(const f32x4*)((const float*)(ws + WS_LAM) + (dg * 64 + 2 * (lane & 31)) * 2);
    const int i = lane & 31, hhA = (i >> 2) & 1, ti = (i & 3) + 4 * (i >> 3), h = lane >> 5;
    float x[4] = {0.f, 0.f, 0.f, 0.f};
    const f32x16 z = {0.f, 0.f, 0.f, 0.f, 0.f, 0.f, 0.f, 0.f, 0.f, 0.f, 0.f, 0.f, 0.f, 0.f, 0.f, 0.f};
    bf16x8 an = *(const bf16x8*)(U + (size_t)s5_row(b, dir, (2 * w + hhA) * S5_CH + ti) * 512 + g * 16 + 8 * h);
#pragma unroll 1
    for (int step = 0; step < S5_NST; ++step) {
        const bf16x8 a = an;
        if (step + 1 < S5_NST) an = *(const bf16x8*)(U + (size_t)s5_row(b, dir, (2 * w + hhA) * S5_CH + (step + 1) * 16 + ti) * 512 + g * 16 + 8 * h);
        f32x16 D0 = __builtin_amdgcn_mfma_f32_32x32x16_bf16(a, Bf[0], z, 0, 0, 0), D1 = __builtin_amdgcn_mfma_f32_32x32x16_bf16(a, Bf[1], z, 0, 0, 0);
        f32x16 D2 = __builtin_amdgcn_mfma_f32_32x32x16_bf16(a, Bf[2], z, 0, 0, 0), D3 = __builtin_amdgcn_mfma_f32_32x32x16_bf16(a, Bf[3], z, 0, 0, 0);
        S5_SCAN16(D0, D1, D2, D3);
    }
    float* S = (float*)(ws + WS_SEND) + ((size_t)chain * S5_NCH + 2 * w + h) * 128 + 4 * (lane & 31);
    *(f32x4*)S = (f32x4){x[0], x[1], x[2], x[3]};
}
static_assert(S5_NCH % 6 == 0, "pass 2 batches");
__device__ __forceinline__ void s5_pass2(unsigned char* ws, int gid) {
    const int chain = gid >> 6, p = gid & 63, dg = chain & 63;
    const float lr = ((const float*)(ws + WS_LAMP))[(dg * 64 + p) * 2], li = ((const float*)(ws + WS_LAMP))[(dg * 64 + p) * 2 + 1];
    const float* S = (const float*)(ws + WS_SEND) + (size_t)chain * S5_NCH * 128 + 2 * p; float* H = (float*)(ws + WS_HIN) + (size_t)chain * S5_NCH * 128 + 2 * p;
    float xr = 0.f, xi = 0.f;
#pragma unroll 1
    for (int q0 = 0; q0 < S5_NCH; q0 += 6) {
        float sr[6], si[6];
#pragma unroll
        for (int e = 0; e < 6; ++e) { sr[e] = S[(q0 + e) * 128]; si[e] = S[(q0 + e) * 128 + 1]; }
#pragma unroll
        for (int e = 0; e < 6; ++e) { H[(q0 + e) * 128] = xr; H[(q0 + e) * 128 + 1] = xi;
            const float nr = fmaf(lr, xr, fmaf(-li, xi, sr[e])), ni = fmaf(lr, xi, fmaf(li, xr, si[e])); xr = nr; xi = ni; }
    }
}
__device__ __forceinline__ void s5_pass3(const Args& args, unsigned char* ws, LAS unsigned char* xt  , int task, int lane) {
    const int w = task & 63, g = (task >> 6) & 31, b = task >> 11;
    const bf16* U = (const bf16*)(ws + WS_U); bf16* Ao = (bf16*)(ws + WS_H);
    const int i = lane & 31, hhA = (i >> 2) & 1, ti = (i & 3) + 4 * (i >> 3), h = lane >> 5, j = lane & 31, fq = lane >> 4, ch = lane & 15;
    f32x4 yacc[S5_NST][2];
    const f32x16 z = {0.f, 0.f, 0.f, 0.f, 0.f, 0.f, 0.f, 0.f, 0.f, 0.f, 0.f, 0.f, 0.f, 0.f, 0.f, 0.f};
#pragma unroll
    for (int dir = 0; dir < 2; ++dir) {
        const int dg = dir * 32 + g, chain = (b * 2 + dir) * 32 + g;
        bf16x8 Bf[4], Cf[4];
#pragma unroll
        for (int q = 0; q < 4; ++q) { Bf[q] = *(const bf16x8*)(ws + WS_S5B + ((size_t)(dg * 4 + q) * 64 + lane) * 16); Cf[q] = *(const bf16x8*)(ws + WS_S5C + ((size_t)(dg * 4 + q) * 64 + lane) * 16); }
        const f32x4 lm = *(const f32x4*)((const float*)(ws + WS_LAM) + (dg * 64 + 2 * j) * 2);
        const int cl = 2 * w + h, qc = dir ? (S5_NCC + S5_NLAT - 1 - cl) : (cl + S5_NCC);
        const f32x4 x0 = *(const f32x4*)((const float*)(ws + WS_HIN) + ((size_t)chain * S5_NCH + qc) * 128 + 4 * j);
        float x[4] = {x0[0], x0[1], x0[2], x0[3]};
        bf16x8 an = *(const bf16x8*)(U + ((size_t)b * SEQ + (2 * w + hhA) * S5_CH + (dir ? S5_CH - 1 - ti : ti)) * 512 + g * 16 + 8 * h);
#pragma unroll
        for (int step = 0; step < S5_NST; ++step) {
            const bf16x8 a = an;
            if (step + 1 < S5_NST) { const int n = (step + 1) * 16 + ti, t = (2 * w + hhA) * S5_CH + (dir ? S5_CH - 1 - n : n); an = *(const bf16x8*)(U + ((size_t)b * SEQ + t) * 512 + g * 16 + 8 * h); }
            {   f32x16 D0 = __builtin_amdgcn_mfma_f32_32x32x16_bf16(a, Bf[0], z, 0, 0, 0), D1 = __builtin_amdgcn_mfma_f32_32x32x16_bf16(a, Bf[1], z, 0, 0, 0);
                S5_SCAN16_ONE(D0, D1, lm[0], lm[1], x[0], x[1]);
#pragma unroll
                for (int r = 0; r < 16; ++r) *(LAS unsigned*)(xt + (h * 16 + r) * 272 + 8 * j) = pg8::cvt_pk_bf16(D0[r], D1[r]); }
            {   f32x16 D2 = __builtin_amdgcn_mfma_f32_32x32x16_bf16(a, Bf[2], z, 0, 0, 0), D3 = __builtin_amdgcn_mfma_f32_32x32x16_bf16(a, Bf[3], z, 0, 0, 0);
                S5_SCAN16_ONE(D2, D3, lm[2], lm[3], x[2], x[3]);
#pragma unroll
                for (int r = 0; r < 16; ++r) *(LAS unsigned*)(xt + (h * 16 + r) * 272 + 8 * j + 4) = pg8::cvt_pk_bf16(D2[r], D3[r]); }
            asm volatile("s_waitcnt lgkmcnt(0)" ::: "memory");
            const int rs = dir ? 15 - ch : ch;
#pragma unroll
            for (int hr = 0; hr < 2; ++hr) {
                f32x4 acc = {0.f, 0.f, 0.f, 0.f};
#pragma unroll
                for (int ks = 0; ks < 4; ++ks) { const bf16x8 af = *(const LAS bf16x8*)(xt + (hr * 16 + rs) * 272 + ks * 64 + 16 * fq);
                    acc = __builtin_amdgcn_mfma_f32_16x16x32_bf16(af, Cf[ks], acc, 0, 0, 0); }
                if (dir == 0) yacc[step][hr] = acc; else yacc[S5_NST - 1 - step][hr] += acc;
            }
            asm volatile("s_waitcnt lgkmcnt(0)" ::: "memory");
            __builtin_amdgcn_sched_barrier(0);
        }
    }
    const float dsk = args.in[I_SD][g * 16 + ch];
#pragma unroll
    for (int s = 0; s < S5_NST; ++s)
#pragma unroll
        for (int hr = 0; hr < 2; ++hr)
#pragma unroll
            for (int e = 0; e < 4; ++e) { const size_t o = ((size_t)b * SEQ + (2 * w + hr) * S5_CH + 16 * s + 4 * fq + e) * 512 + g * 16 + ch;
                Ao[o] = (bf16)f2bf(gelu_tanh(yacc[s][hr][e] + bf2f(U[o]) * dsk)); }
}
__device__ __forceinline__ int block_incl_scan(int v, int* scr, int lane, int wave, int& total) {
    int x = v;
#pragma unroll
    for (int o = 1; o < 64; o <<= 1) { const int y = __shfl_up(x, o); if (lane >= o) x += y; }
    if (lane == 63) scr[wave] = x;
    __syncthreads();
    int base = 0, tot = 0;
#pragma unroll
    for (int w = 0; w < 8; ++w) { const int s = scr[w]; if (w < wave) base += s; tot += s; }
    __syncthreads();
    total = tot; return x + base;
}
__device__ __forceinline__ void topk_select(unsigned char* ws, unsigned char* lds_g, int be, int tid, int lane, int wave) {
    unsigned* vals = (unsigned*)lds_g; int* hist = (int*)(lds_g + 32768); int* scr = (int*)(lds_g + 49152);
    const int b = be >> 4, e = be & 15;
    const float* AFF = (const float*)(ws + WS_AFF); int* IDX = (int*)(ws + WS_IDX); float* GSEL = (float*)(ws + WS_GSEL); int* SLOT = (int*)(ws + WS_SLOT);
    for (int i = tid; i < 8192; i += 512) vals[i] = __float_as_uint(AFF[((size_t)b * SEQ + i) * 16 + e]);
    __syncthreads();
    unsigned long long prefix = 0ull; int krem = 1024;
#pragma unroll
    for (int pass = 0; pass < 4; ++pass) {
        const int wdt = pass == 3 ? 12 : 11, shift = pass == 0 ? 34 : (pass == 1 ? 23 : (pass == 2 ? 12 : 0)), nb = 1 << wdt, B = nb / 512;
        for (int i = tid; i < nb; i += 512) hist[i] = 0;
        __syncthreads();
        for (int k = 0; k < 16; ++k) { const int i = tid + 512 * k; const unsigned long long key = ((unsigned long long)vals[i] << 13) | (unsigned)(8191 - i);
            if ((key >> (shift + wdt)) == prefix) atomicAdd(&hist[(int)(key >> shift) & (nb - 1)], 1); }
        __syncthreads();
        int cnt = 0;
        for (int d = 0; d < B; ++d) cnt += hist[tid * B + d];
        int total; const int incl = block_incl_scan(cnt, scr, lane, wave, total);
        int running = total - incl;
        for (int d = tid * B + B - 1; d >= tid * B; --d) { const int hh = hist[d]; if (running < krem && running + hh >= krem) { scr[16] = d; scr[17] = krem - running; } running += hh; }
        __syncthreads();
        const int dstar = scr[16]; krem = scr[17]; prefix = (prefix << wdt) | (unsigned long long)dstar;
        __syncthreads();
    }
    int cnt = 0;
    for (int k = 0; k < 16; ++k) { const int i = tid + 512 * k; const unsigned long long key = ((unsigned long long)vals[i] << 13) | (unsigned)(8191 - i); cnt += key >= prefix ? 1 : 0; }
    int total; int slot = block_incl_scan(cnt, scr, lane, wave, total) - cnt;
    for (int k = 0; k < 16; ++k) { const int i = tid + 512 * k; const unsigned long long key = ((unsigned long long)vals[i] << 13) | (unsigned)(8191 - i);
        if (key >= prefix) { if (slot < 1024) { IDX[be * 1024 + slot] = i; GSEL[be * 1024 + slot] = __uint_as_float(vals[i]); SLOT[be * 8192 + i] = slot; } else SLOT[be * 8192 + i] = -1; ++slot; }
        else SLOT[be * 8192 + i] = -1; }
    __syncthreads();
}
typedef short s16x4 __attribute__((ext_vector_type(4)));
constexpr int AT_ROW = 144;
constexpr int AT_KC = 0, AT_VC = 256 * AT_ROW, AT_RING = 2 * 256 * AT_ROW, AT_RBUF = 2 * 64 * AT_ROW, AT_BIAS = 132096;
static_assert(AT_RING + 3 * AT_RBUF <= RING_BYTES && AT_BIAS >= MISC_OFF + 128 && AT_BIAS + (512 + 640) * 4 <= LDS_BYTES, "attention LDS map");
constexpr float LOG2E = 1.4426950408889634f;

template <int MODE> __device__ __forceinline__ void attn_tile32(const LAS unsigned char* K32, const LAS unsigned char* V32, const bf16x8 q0, const bf16x8 q1, f32x4 (&O)[4], float& lsum,
                                                              int lane, const LAS float* brow, int kc0, int q_cs, float shiftl) {
    const int r16 = lane & 15, fq = lane >> 4;
    f32x4 st[2];
#pragma unroll
    for (int tt = 0; tt < 2; ++tt) {
        const LAS unsigned char* kp = K32 + (16 * tt + r16) * AT_ROW + 16 * fq;
        const bf16x8 k0 = *(const LAS bf16x8*)kp, k1 = *(const LAS bf16x8*)(kp + 64);
        f32x4 c0;
        if (MODE == 0) c0 = (f32x4){shiftl, shiftl, shiftl, shiftl};
        else { const LAS float* bp = brow + 16 * tt + 4 * fq; c0 = (f32x4){bp[0], bp[1], bp[2], bp[3]}; }
        st[tt] = __builtin_amdgcn_mfma_f32_16x16x32_bf16(k0, q0, c0, 0, 0, 0);
        st[tt] = __builtin_amdgcn_mfma_f32_16x16x32_bf16(k1, q1, st[tt], 0, 0, 0);
    }
    float p[2][4];
#pragma unroll
    for (int tt = 0; tt < 2; ++tt)
#pragma unroll
        for (int e = 0; e < 4; ++e) {
            float v = __builtin_amdgcn_exp2f(st[tt][e]);
            if (MODE == 2) { const int kc = kc0 + 16 * tt + 4 * fq + e; v = (kc >= q_cs && kc < q_cs + 16) ? v : 0.f; }
            p[tt][e] = v; lsum += v;
        }
    bf16x8 Pf; { pg8::u32x4 w; w.x = pg8::cvt_pk_bf16(p[0][0], p[0][1]); w.y = pg8::cvt_pk_bf16(p[0][2], p[0][3]); w.z = pg8::cvt_pk_bf16(p[1][0], p[1][1]); w.w = pg8::cvt_pk_bf16(p[1][2], p[1][3]); Pf = __builtin_bit_cast(bf16x8, w); }
    const LAS unsigned char* vp = V32 + (4 * fq + (r16 >> 2)) * AT_ROW + 8 * (r16 & 3);
#pragma unroll
    for (int dt = 0; dt < 4; ++dt) {
        const s16x4 lo = __builtin_amdgcn_ds_read_tr16_b64_v4i16((LAS s16x4*)(vp + 32 * dt)), hi = __builtin_amdgcn_ds_read_tr16_b64_v4i16((LAS s16x4*)(vp + 32 * dt + 16 * AT_ROW));
        const bf16x8 Vf = __builtin_shufflevector(lo, hi, 0, 1, 2, 3, 4, 5, 6, 7);
        O[dt] = __builtin_amdgcn_mfma_f32_16x16x32_bf16(Vf, Pf, O[dt], 0, 0, 0);
    }
}

__device__ __forceinline__ void attn_unit(const Args& args, unsigned char* ws, LAS unsigned char* lds, int unit, int tid, int lane, int wave, int mode  ) {
    const int b = unit >> 7, head = (unit >> 4) & 7, r0 = (unit & 15) * 8, r = r0 + wave;
    const bf16* Q = (const bf16*)(ws + WS_Q); const bf16* Kg = (const bf16*)(ws + WS_K); const bf16* Vg = (const bf16*)(ws + WS_V); bf16* YB = (bf16*)(ws + WS_YAB) + 512;
    const int r16 = lane & 15, fq = lane >> 4;
    float mq = fabsf(args.in[I_QN][lane]), mk = fabsf(args.in[I_KN][lane]);
#pragma unroll
    for (int o = 1; o < 64; o <<= 1) { mq = fmaxf(mq, __shfl_xor(mq, o)); mk = fmaxf(mk, __shfl_xor(mk, o)); }
    const float shiftl = -8.f * mq * mk * LOG2E;
    __syncthreads();
    {
        const bf16* kc = Kg + ((size_t)MLAT + b * NCTX) * 512 + head * 64; const bf16* vc = Vg + ((size_t)MLAT + b * NCTX) * 512 + head * 64;
#pragma unroll
        for (int i = 0; i < 4; ++i) { const int idx = tid + 512 * i, row = idx >> 3, c = idx & 7;
            const v4u kv = *(const v4u*)(kc + (size_t)row * 512 + c * 8), vv = *(const v4u*)(vc + (size_t)row * 512 + c * 8);
            *(LAS v4u*)(lds + AT_KC + row * AT_ROW + c * 16) = kv; *(LAS v4u*)(lds + AT_VC + row * AT_ROW + c * 16) = vv; }
        LAS float* bl = (LAS float*)(lds + AT_BIAS);
        {
            bl[tid] = tid < 465 ? fmaf(args.in[I_RPB][head * 465 + tid], LOG2E, shiftl) : 0.f;
            for (int i = tid; i < 640; i += 512) { const int dr = i / 40, dc = i % 40 - 8; bl[512 + i] = (dr < 15 && dc >= 7 && dc < 23) ? fmaf(args.in[I_RPB][head * 465 + dr * 31 + dc], LOG2E, shiftl) : -30000.f; }
        }
    }
    const int kr_lo = min(max(r0 - 4, 0), 120), kr_hi = min(max(r0 + 3, 0), 120) + 7;
    const int lcol = tid >> 3, lc = tid & 7;
    v4u kv, vv;
    {   const size_t g0 = ((size_t)b * SEQ + kr_lo * 64 + lcol) * 512 + head * 64 + lc * 8;
        const v4u k0 = *(const v4u*)(Kg + g0), v0 = *(const v4u*)(Vg + g0);
        *(LAS v4u*)(lds + AT_RING + lcol * AT_ROW + lc * 16) = k0; *(LAS v4u*)(lds + AT_RING + 64 * AT_ROW + lcol * AT_ROW + lc * 16) = v0;
        kv = *(const v4u*)(Kg + g0 + 64 * 512); vv = *(const v4u*)(Vg + g0 + 64 * 512); }
    bf16x8 Qf[4][2];
#pragma unroll
    for (int j = 0; j < 4; ++j) { const bf16* qp = Q + ((size_t)b * SEQ + r * 64 + 16 * j + r16) * 512 + head * 64 + 8 * fq; Qf[j][0] = *(const bf16x8*)qp; Qf[j][1] = *(const bf16x8*)(qp + 32); }
    f32x4 O[4][4]; float lsum[4];
#pragma unroll
    for (int j = 0; j < 4; ++j) { lsum[j] = 0.f;
#pragma unroll
        for (int dt = 0; dt < 4; ++dt) O[j][dt] = (f32x4){0.f, 0.f, 0.f, 0.f}; }
    __syncthreads();
#pragma unroll 1
    for (int grp = 0; grp < ((mode & 1) ? 8 : 0); ++grp) {
#pragma unroll
        for (int j = 0; j < 4; ++j) attn_tile32<0>(lds + AT_KC + 32 * grp * AT_ROW, lds + AT_VC + 32 * grp * AT_ROW, Qf[j][0], Qf[j][1], O[j], lsum[j], lane, nullptr, 0, 0, shiftl);
    }
    const int rs = min(max(r - 4, 0), 120);
    int buf = 0;
#pragma unroll 1
    for (int kr = kr_lo; kr <= ((mode & 2) ? kr_hi : kr_lo - 1); ++kr) {
        if (kr + 1 <= kr_hi) { const int nbuf = buf == 2 ? 0 : buf + 1; LAS unsigned char* nb = lds + AT_RING + nbuf * AT_RBUF;
            *(LAS v4u*)(nb + lcol * AT_ROW + lc * 16) = kv; *(LAS v4u*)(nb + 64 * AT_ROW + lcol * AT_ROW + lc * 16) = vv; }
        if (kr + 2 <= kr_hi) { const size_t g0 = ((size_t)b * SEQ + (kr + 2) * 64 + lcol) * 512 + head * 64 + lc * 8; kv = *(const v4u*)(Kg + g0); vv = *(const v4u*)(Vg + g0); }
        if (kr >= rs && kr < rs + 8 && (mode & 4)) {
            const LAS unsigned char* kb = lds + AT_RING + buf * AT_RBUF; const LAS unsigned char* vb = kb + 64 * AT_ROW;
            const LAS float* bl = (const LAS float*)(lds + AT_BIAS) + (kr - r + 7) * 31 + 15; const LAS float* bl1 = (const LAS float*)(lds + AT_BIAS) + 512 + (kr - r + 7) * 40 + 8 + 15;
#pragma unroll
            for (int j = 0; j < 4; ++j) { const int cs = j == 0 ? 0 : (j == 3 ? 32 : 16 * j - 8), qc = 16 * j + r16, q_cs = min(max(qc - 8, 0), 48);
                if (j == 0 || j == 3) attn_tile32<2>(kb + cs * AT_ROW, vb + cs * AT_ROW, Qf[j][0], Qf[j][1], O[j], lsum[j], lane, bl + cs - qc, cs, q_cs, shiftl);
                else attn_tile32<1>(kb + cs * AT_ROW, vb + cs * AT_ROW, Qf[j][0], Qf[j][1], O[j], lsum[j], lane, bl1 + cs - qc, cs, q_cs, shiftl); }
        }
        __syncthreads();
        buf = buf == 2 ? 0 : buf + 1;
    }
#pragma unroll
    for (int j = 0; j < 4; ++j) {
        float l = lsum[j]; l += __shfl_xor(l, 16); l += __shfl_xor(l, 32);
        const float inv = 1.f / l;
        bf16* op = YB + ((size_t)b * SEQ + r * 64 + 16 * j + r16) * 1024 + head * 64 + 4 * fq;
#pragma unroll
        for (int dt = 0; dt < 4; ++dt) { pg8::u32x2 w; w.x = pg8::cvt_pk_bf16(O[j][dt][0] * inv, O[j][dt][1] * inv); w.y = pg8::cvt_pk_bf16(O[j][dt][2] * inv, O[j][dt][3] * inv); *(pg8::u32x2*)(op + 16 * dt) = w; }
    }
}
__global__ void __launch_bounds__(NWAVES * 64, 2) mega(Args args) {
    extern __shared__ __attribute__((aligned(16))) unsigned char lds_raw[];
    LAS unsigned char* lds = (LAS unsigned char*)lds_raw;
    volatile LAS unsigned* MISC = (volatile LAS unsigned*)(lds + MISC_OFF);
    const int tid = threadIdx.x, lane = tid & 63, wave = __builtin_amdgcn_readfirstlane(tid >> 6);
    const int G = gridDim.x; const int bx = blockIdx.x; const int vcu = (G % 8 == 0) ? (bx % 8) * (G / 8) + bx / 8 : bx;
    const int gw = vcu * NWAVES + wave, NGW = G * NWAVES;
    unsigned char* ws = args.ws;
    gu32* ctl = (gu32*)(ws + WS_CTL);
    for (int u = tid; u < (LDS_BYTES - LDSCTL_OFF) / 4; u += NWAVES * 64) ((LAS unsigned*)(lds + LDSCTL_OFF))[u] = 0u;
    __syncthreads();
    XcdBarrier bar = xcd_barrier_post((unsigned*)(ctl + CW_BAR) + args.li * XCD_BAR_WORDS, MISC + 8);
    const int lo = args.ph_lo, hi = args.ph_hi;
#define IN(k) (lo <= (k) && (k) < hi)
#define BOTH(k) (IN(k) && IN((k) + 1))
#if defined(TIME_MASK)
    unsigned long long tacc_ = 0ull, tbeg_ = 0ull;
#define TBEG(k) do { if ((TIME_MASK >> (k)) & 1) tbeg_ = __builtin_amdgcn_s_memrealtime(); } while (0)
#define TEND(k) do { if ((TIME_MASK >> (k)) & 1) tacc_ += __builtin_amdgcn_s_memrealtime() - tbeg_; } while (0)
#else
#define TBEG(k) do {} while (0)
#define TEND(k) do {} while (0)
#endif
    float* mod = (float*)(ws + WS_MOD);
    bf16* Hb = (bf16*)(ws + WS_H);

    TBEG(0);
    if (IN(0)) for (int rep_ = 0; rep_ <= ((PROBE_MASK >> 0) & 1) * PROBE_REPS; ++rep_) {
        const float* c = args.in[I_C]; const float* cctx = args.in[I_CCTX]; const float* w_ada = args.in[I_WADA]; const float* b_ada = args.in[I_BADA];
        if (args.li == 0) for (int it = gw; it < 24 * 16; it += NGW) {
            const int cc = it % 24, ks = it / 24, col = cc * 256 + lane * 4;
            f32x4 a0 = {0.f, 0.f, 0.f, 0.f}, a1 = a0, a2 = a0;
#pragma unroll 1
            for (int k0 = ks * 64; k0 < ks * 64 + 64; k0 += 16) {
                f32x4 w[16];
#pragma unroll
                for (int i = 0; i < 16; ++i) w[i] = *(const f32x4*)(w_ada + (size_t)(k0 + i) * 6144 + col);
#pragma unroll
                for (int i = 0; i < 16; ++i) { const float s0 = silu_f(c[k0 + i]), s1 = silu_f(c[1024 + k0 + i]), s2 = silu_f(cctx[k0 + i]); a0 += w[i] * s0; a1 += w[i] * s1; a2 += w[i] * s2; }
            }
            if (ks == 0) { const f32x4 bb = *(const f32x4*)(b_ada + col); a0 += bb; a1 += bb; a2 += bb; }
#pragma unroll
            for (int i = 0; i < 4; ++i) { atomicAdd(mod + col + i, a0[i]); atomicAdd(mod + 6144 + col + i, a1[i]); atomicAdd(mod + 2 * 6144 + col + i, a2[i]); }
        }
        LAS float* scr = (LAS float*)(lds + RING_OFF + wave * 16384);
        constexpr int I_IN = 16 * 128, I_GLU = 8 * 16, I_PA = 8 * 32, I_OUT = 16 * 32, NIT = I_IN + I_GLU + 2 * I_PA + I_OUT;
        for (int it = gw; it < NIT; it += NGW) {
            int r = it;
            if (r < I_IN) { transpose_item<1>(args.in[I_WIN], 1024, 4096, (bf16*)(ws + WS_WIN), 1024, scr, r, lane); continue; } r -= I_IN;
            if (r < I_GLU) { transpose_item<0>(args.in[I_WGLU], 512, 512, (bf16*)(ws + WS_WGLU), 512, scr, r, lane); continue; } r -= I_GLU;
            if (r < I_PA) { transpose_item<0>(args.in[I_WPA], 512, 1024, (bf16*)(ws + WS_WPA), 1024, scr, r, lane); continue; } r -= I_PA;
            if (r < I_PA) { transpose_item<0>(args.in[I_WPB], 512, 1024, (bf16*)(ws + WS_WPA) + 512, 1024, scr, r, lane); continue; } r -= I_PA;
            transpose_item<0>(args.in[I_WOUT], 1024, 1024, (bf16*)(ws + WS_WOUT), 1024, scr, r, lane);
        }
        for (int dg = gw; dg < 64; dg += NGW) s5_prep(args, ws, dg, lane);
        if (BOTH(0)) xcd_barrier(bar);
    }
    TEND(0);
    TBEG(1);
    if (IN(1)) for (int rep_ = 0; rep_ <= ((PROBE_MASK >> 1) & 1) * PROBE_REPS; ++rep_) {
        const float* x = args.in[I_X]; const float* ctx = args.in[I_CTX]; const float* gwt = args.in[I_NMIX];
        for (int blk = gw; blk < MLAT / 8 + MCTX / 2; blk += NGW) {
            if (blk < MLAT / 8) norm1_rows(x + (size_t)blk * 8 * D, Hb + (size_t)blk * 8 * D, 8, gwt, mod + ((blk * 8) >> 13) * 6144, lane);
            else { const int r = (blk - MLAT / 8) * 2; norm1_rows(ctx + (size_t)r * D, Hb + (size_t)(MLAT + r) * D, 2, gwt, mod + 2 * 6144, lane); }
        }
        if (BOTH(1)) xcd_barrier(bar);
    }
    TEND(1);
    TBEG(2);
    if (IN(2)) for (int rep_ = 0; rep_ <= ((PROBE_MASK >> 2) & 1) * PROBE_REPS; ++rep_) {
        pg8::Gemm g{Hb, (const bf16*)(ws + WS_WIN), MALL, 4096, 1024};
        pg8::InprojOrder S; S.init(G, bx, true);
        pg8::EpiInproj E{(bf16*)(ws + WS_U), (bf16*)(ws + WS_Q), (bf16*)(ws + WS_K), (bf16*)(ws + WS_V), (bf16*)(ws + WS_SGA), (bf16*)(ws + WS_SGB), args.in[I_QN], args.in[I_KN]};
        pg8::gemm_phase<pg8::EpiInproj, pg8::InprojOrder, true>(lds + RING_OFF, g, S, E);
        {
            const int maxun = (1036 + G - 1) / G, heavy = 1036 - (maxun - 1) * G, light = heavy < G ? G - heavy : G;
            if (light == G || bx >= heavy) {
                LAS float* scr = (LAS float*)(lds + RING_OFF + wave * 16384);
                for (int it = (light == G ? bx : bx - heavy) * NWAVES + wave; it < 16 * 512; it += light * NWAVES)
                    transpose_item<0>(args.in[I_WED] + (size_t)(it >> 9) * 1048576, 1024, 1024, (bf16*)(ws + WS_WD) + (size_t)(it >> 9) * 1048576, 1024, scr, it & 511, lane);
            }
        }
        if (BOTH(2)) xcd_barrier(bar);
    }
    TEND(2);
#if defined(EXTRA_BARRIERS)
    if (IN(3)) for (int xb_ = 0; xb_ < EXTRA_BARRIERS; ++xb_) xcd_barrier(bar);
#endif
    TBEG(3);
    if (IN(3)) for (int rep_ = 0; rep_ <= ((PROBE_MASK >> 3) & 1) * PROBE_REPS; ++rep_) {
        for (int task = gw; task < 128 * S5_NPAIR; task += NGW) s5_pass1(ws, task, lane);
        if (BOTH(3)) xcd_barrier(bar);
    }
    TEND(3);
    TBEG(4);
    if (IN(4)) for (int rep_ = 0; rep_ <= ((PROBE_MASK >> 4) & 1) * PROBE_REPS; ++rep_) {
        { const int gid = gw * 64 + lane; if (gid < 8192 && (PROBE_VARIANT != 0 || rep_ == ((PROBE_MASK >> 4) & 1) * PROBE_REPS)) s5_pass2(ws, gid); }
        for (int unit = bx; unit < 256; unit += G) attn_unit(args, ws, lds + RING_OFF, unit, tid, lane, wave, rep_ < ((PROBE_MASK >> 4) & 1) * PROBE_REPS ? PROBE_VARIANT : 7);
        if (BOTH(4)) xcd_barrier(bar);
    }
    TEND(4);
    TBEG(5);
    if (IN(5)) for (int rep_ = 0; rep_ <= ((PROBE_MASK >> 5) & 1) * PROBE_REPS; ++rep_) {
        for (int task = gw; task < 4096; task += NGW) s5_pass3(args, ws, lds + RING_OFF + wave * 16384, task, lane);
        if (BOTH(5)) xcd_barrier(bar);
    }
    TEND(5);
    TBEG(6);
    if (IN(6)) for (int rep_ = 0; rep_ <= ((PROBE_MASK >> 6) & 1) * PROBE_REPS; ++rep_) {
        pg8::Gemm g{(const bf16*)(ws + WS_H), (const bf16*)(ws + WS_WGLU), MLAT, 512, 512};
        pg8::StaticOrder S; S.init(MLAT, 512, G, bx);
        pg8::EpiGlu E{(const bf16*)(ws + WS_H), args.in[I_BGLU], (bf16*)(ws + WS_YAB), 1024};
        pg8::gemm_phase<pg8::EpiGlu, pg8::StaticOrder, true>(lds + RING_OFF, g, S, E);
        if (BOTH(6)) xcd_barrier(bar);
    }
    TEND(6);
    TBEG(7);
    if (IN(7)) for (int rep_ = 0; rep_ <= ((PROBE_MASK >> 7) & 1) * PROBE_REPS; ++rep_) {
        pg8::Gemm g{(const bf16*)(ws + WS_YAB), (const bf16*)(ws + WS_WPA), MLAT, 1024, 1024};
        pg8::StaticOrder S; S.init(MLAT, 1024, G, bx);
        pg8::EpiMerge E{(const bf16*)(ws + WS_SGA), (const bf16*)(ws + WS_SGB), (bf16*)(ws + WS_M)};
        pg8::gemm_phase<pg8::EpiMerge, pg8::StaticOrder, true>(lds + RING_OFF, g, S, E);
        if (BOTH(7)) xcd_barrier(bar);
    }
    TEND(7);
    TBEG(8);
    if (IN(8)) for (int rep_ = 0; rep_ <= ((PROBE_MASK >> 8) & 1) * PROBE_REPS; ++rep_) {
        pg8::Gemm g{(const bf16*)(ws + WS_M), (const bf16*)(ws + WS_WOUT), MLAT, 1024, 1024};
        pg8::StaticOrder S; S.init(MLAT, 1024, G, bx);
        pg8::EpiOut E{args.in[I_X], mod, args.out};
        pg8::gemm_phase<pg8::EpiOut, pg8::StaticOrder, true>(lds + RING_OFF, g, S, E);
        if (BOTH(8)) xcd_barrier(bar);
    }
    TEND(8);
    TBEG(9);
    if (IN(9)) for (int rep_ = 0; rep_ <= ((PROBE_MASK >> 9) & 1) * PROBE_REPS; ++rep_) {
        const float* gwt = args.in[I_NFFN]; const float* w_router = args.in[I_WR]; float* AFF = (float*)(ws + WS_AFF);
        __syncthreads();
#pragma unroll
        for (int k = 0; k < 8; ++k) { const int idx4 = tid + 512 * k, c = idx4 >> 2, e4 = idx4 & 3;
            *(LAS f32x4*)(lds + RING_OFF + (((c >> 8) * 4 + (c & 3)) * 64 + ((c & 255) >> 2)) * 80 + e4 * 16) = *(const f32x4*)(w_router + (size_t)c * 16 + e4 * 4); }
        __syncthreads();
        for (int blk = gw; blk < MLAT / 8; blk += NGW) {
            const int row0 = blk * 8; const float* md = mod + (row0 >> 13) * 6144;
            f32x4 ca[4], cb[4];
#pragma unroll
            for (int j = 0; j < 4; ++j) { const int col = j * 256 + lane * 4; ca[j] = *(const f32x4*)(gwt + col) * (*(const f32x4*)(md + 4096 + col) + 1.f); cb[j] = *(const f32x4*)(md + 3072 + col); }
#pragma unroll 1
            for (int rr = 0; rr < 8; rr += 2) {
                const int rowa = row0 + rr, rowb = rowa + 1;
                const float* sa = args.out + (size_t)rowa * D; const float* sb = sa + D;
                f32x4 va[4], vb[4]; float ssa = 0.f, ssb = 0.f;
#pragma unroll
                for (int j = 0; j < 4; ++j) { va[j] = *(const f32x4*)(sa + j * 256 + lane * 4); vb[j] = *(const f32x4*)(sb + j * 256 + lane * 4); }
#pragma unroll
                for (int j = 0; j < 4; ++j) { ssa += (va[j][0] * va[j][0] + va[j][1] * va[j][1]) + (va[j][2] * va[j][2] + va[j][3] * va[j][3]); ssb += (vb[j][0] * vb[j][0] + vb[j][1] * vb[j][1]) + (vb[j][2] * vb[j][2] + vb[j][3] * vb[j][3]); }
                const float ra = rsqrtf(wave_sum(ssa) * (1.f / D) + EPS), rb = rsqrtf(wave_sum(ssb) * (1.f / D) + EPS);
                float la[16], lb[16];
#pragma unroll
                for (int e = 0; e < 16; ++e) { la[e] = 0.f; lb[e] = 0.f; }
#pragma unroll
                for (int j = 0; j < 4; ++j) {
                    const int col = j * 256 + lane * 4;
                    const f32x4 oa = va[j] * ra * ca[j] + cb[j], ob = vb[j] * rb * ca[j] + cb[j];
                    pg8::u32x2 w; w.x = pk2(oa[0], oa[1]); w.y = pk2(oa[2], oa[3]); *(pg8::u32x2*)(Hb + (size_t)rowa * D + col) = w;
                    w.x = pk2(ob[0], ob[1]); w.y = pk2(ob[2], ob[3]); *(pg8::u32x2*)(Hb + (size_t)rowb * D + col) = w;
#pragma unroll
                    for (int i = 0; i < 4; ++i) {
                        const LAS f32x4* wr = (const LAS f32x4*)(lds + RING_OFF + ((j * 4 + i) * 64 + lane) * 80);
#pragma unroll
                        for (int e4 = 0; e4 < 4; ++e4) { const f32x4 wv = wr[e4];
#pragma unroll
                            for (int e = 0; e < 4; ++e) { la[e4 * 4 + e] = fmaf(oa[i], wv[e], la[e4 * 4 + e]); lb[e4 * 4 + e] = fmaf(ob[i], wv[e], lb[e4 * 4 + e]); } }
                        __builtin_amdgcn_sched_barrier(0);
                    }
                }
#define FOLD_STEP(arr, n, mask) do { const bool hi_ = (lane & (mask)) != 0; _Pragma("unroll") for (int k_ = 0; k_ < (n); ++k_) { \
            const float send_ = hi_ ? arr[k_] : arr[(n) + k_], keep_ = hi_ ? arr[(n) + k_] : arr[k_]; arr[k_] = keep_ + __shfl_xor(send_, (mask)); } } while (0)
                FOLD_STEP(la, 8, 32); FOLD_STEP(lb, 8, 32); FOLD_STEP(la, 4, 16); FOLD_STEP(lb, 4, 16); FOLD_STEP(la, 2, 8); FOLD_STEP(lb, 2, 8); FOLD_STEP(la, 1, 4); FOLD_STEP(lb, 1, 4);
#undef FOLD_STEP
                float xa = la[0], xb = lb[0];
                xa += __shfl_xor(xa, 2); xb += __shfl_xor(xb, 2); xa += __shfl_xor(xa, 1); xb += __shfl_xor(xb, 1);
                float ma = xa, mb = xb;
#pragma unroll
                for (int o = 4; o < 64; o <<= 1) { ma = fmaxf(ma, __shfl_xor(ma, o)); mb = fmaxf(mb, __shfl_xor(mb, o)); }
                const float ea = expf(xa - ma), eb = expf(xb - mb); float sua = ea, sub = eb;
#pragma unroll
                for (int o = 4; o < 64; o <<= 1) { sua += __shfl_xor(sua, o); sub += __shfl_xor(sub, o); }
                if ((lane & 3) == 0) { const int e = ((lane >> 5) & 1) * 8 + ((lane >> 4) & 1) * 4 + ((lane >> 3) & 1) * 2 + ((lane >> 2) & 1);
                    AFF[(size_t)rowa * 16 + e] = ea / sua; AFF[(size_t)rowb * 16 + e] = eb / sub; }
            }
        }
        if (BOTH(9)) xcd_barrier(bar);
    }
    TEND(9);
    TBEG(10);
    if (IN(10)) for (int rep_ = 0; rep_ <= ((PROBE_MASK >> 10) & 1) * PROBE_REPS; ++rep_) {
        const bool split = G >= 64;
        if (!split || bx >= 32) {
            const int w2 = split ? (bx - 32) * NWAVES + wave : bx * NWAVES + wave, NW2 = (split ? G - 32 : G) * NWAVES;
            LAS float* scr = (LAS float*)(lds + RING_OFF + wave * 16384);
            for (int it = w2; it < 16 * 2 * 512; it += NW2) {
                const int e = it >> 10, which = (it >> 9) & 1, item = it & 511;
                if (which == 0) transpose_item<2>(args.in[I_WEG] + (size_t)e * 1048576, 1024, 1024, (bf16*)(ws + WS_WGU) + (size_t)e * 2097152, 1024, scr, item, lane);
                else transpose_item<3>(args.in[I_WEU] + (size_t)e * 1048576, 1024, 1024, (bf16*)(ws + WS_WGU) + (size_t)e * 2097152, 1024, scr, item, lane);
            }
        }
        if (split) { if (bx < 32) topk_select(ws, lds_raw, bx, tid, lane, wave); }
        else { __syncthreads(); for (int be = bx; be < 32; be += G) topk_select(ws, lds_raw, be, tid, lane, wave); }
        if (BOTH(10)) xcd_barrier(bar);
    }
    TEND(10);
    TBEG(12);
    if (IN(12)) for (int rep_ = 0; rep_ <= ((PROBE_MASK >> 12) & 1) * PROBE_REPS; ++rep_) {
        pg8::Gemm g{Hb, (const bf16*)(ws + WS_WGU), 32768, 2048, 1024};
        pg8::ExpertOrder<8> S; S.init(G, bx);
        pg8::EpiHid E{(bf16*)(ws + WS_HID)};
        pg8::gemm_phase<pg8::EpiHid, pg8::ExpertOrder<8>, true, true, pg8::ExpertGather>(lds + RING_OFF, g, S, E, pg8::ExpertGather{(const int*)(ws + WS_IDX)});
        if (BOTH(12)) xcd_barrier(bar);
    }
    TEND(12);
    TBEG(13);
    if (IN(13)) for (int rep_ = 0; rep_ <= ((PROBE_MASK >> 13) & 1) * PROBE_REPS; ++rep_) {
        pg8::Gemm g{(const bf16*)(ws + WS_HID), (const bf16*)(ws + WS_WD), 32768, 1024, 1024};
        pg8::ExpertOrder<4> S; S.init(G, bx);
        pg8::EpiDown E{(const float*)(ws + WS_GSEL), (bf16*)(ws + WS_XE)};
        pg8::gemm_phase<pg8::EpiDown, pg8::ExpertOrder<4>, true>(lds + RING_OFF, g, S, E);
        if (BOTH(13)) xcd_barrier(bar);
    }
    TEND(13);
    TBEG(14);
    if (IN(14)) for (int rep_ = 0; rep_ <= ((PROBE_MASK >> 14) & 1) * PROBE_REPS; ++rep_) {
        const int* SLOT = (const int*)(ws + WS_SLOT); const bf16* Y = (const bf16*)(ws + WS_XE);
        for (int blk = gw; blk < MLAT / 8; blk += NGW) {
            const int row0 = blk * 8, b = row0 >> 13, t0 = row0 & 8191;
            const int sv0 = SLOT[(b * 16 + (lane & 15)) * 8192 + t0 + (lane >> 4)], sv1 = SLOT[(b * 16 + (lane & 15)) * 8192 + t0 + 4 + (lane >> 4)];
            f32x4 cg[4];
#pragma unroll
            for (int j = 0; j < 4; ++j) cg[j] = *(const f32x4*)(mod + b * 6144 + 5120 + j * 256 + lane * 4);
#pragma unroll 1
            for (int rp = 0; rp < 4; ++rp) {
                const int sv = rp < 2 ? sv0 : sv1, lbase = (rp & 1) * 32;
                unsigned mask = (unsigned)__builtin_amdgcn_readfirstlane((int)(unsigned)(__ballot(sv >= 0) >> lbase));
                float* oa = args.out + (size_t)(row0 + 2 * rp) * D + lane * 4; float* ob = oa + D;
                f32x4 xa[4], xb[4], aa[4], ab[4];
#pragma unroll
                for (int j = 0; j < 4; ++j) { xa[j] = *(const f32x4*)(oa + j * 256); xb[j] = *(const f32x4*)(ob + j * 256); aa[j] = (f32x4){0.f, 0.f, 0.f, 0.f}; ab[j] = aa[j]; }
                for (;;) {
                    const bf16* p[4]; float fa[4], fb[4];
#pragma unroll
                    for (int q = 0; q < 4; ++q) {
                        if (mask) { const int bit = __builtin_ctz(mask); mask &= mask - 1u; const int s = __builtin_amdgcn_readlane(sv, lbase + bit), e = bit & 15;
                            p[q] = Y + ((size_t)(b * 16 + e) * 1024 + s) * D; fa[q] = bit < 16 ? 1.f : 0.f; fb[q] = 1.f - fa[q]; }
                        else { p[q] = Y; fa[q] = 0.f; fb[q] = 0.f; }
                    }
                    pg8::u32x2 w[4][4];
#pragma unroll
                    for (int q = 0; q < 4; ++q)
#pragma unroll
                        for (int j = 0; j < 4; ++j) w[q][j] = *(const pg8::u32x2*)(p[q] + j * 256 + lane * 4);
#pragma unroll
                    for (int q = 0; q < 4; ++q)
#pragma unroll
                        for (int j = 0; j < 4; ++j) { const f32x4 v = {__uint_as_float(w[q][j].x << 16), __uint_as_float(w[q][j].x & 0xffff0000u), __uint_as_float(w[q][j].y << 16), __uint_as_float(w[q][j].y & 0xffff0000u)};
                            aa[j] += v * fa[q]; ab[j] += v * fb[q]; }
                    if (!mask) break;
                }
#pragma unroll
                for (int j = 0; j < 4; ++j) { *(f32x4*)(oa + j * 256) = xa[j] + cg[j] * aa[j]; *(f32x4*)(ob + j * 256) = xb[j] + cg[j] * ab[j]; }
            }
        }
    }
    TEND(14);
#if defined(TIME_MASK)
    if (bx == 0 && tid == 0) { const unsigned long long te_ = __builtin_amdgcn_s_memrealtime(); while (__builtin_amdgcn_s_memrealtime() - te_ < tacc_) __builtin_amdgcn_s_sleep(4); }
#endif
#undef IN
#undef BOTH
}
extern "C" void kernel_launch(void* const* d_in, const int* in_sizes, int n_in, void* d_out, int out_size, void* d_ws, size_t ws_size, hipStream_t stream) {
    static int grid = 0;
    if (grid == 0) {
        if (n_in != 29 || ws_size < WS_END) { fprintf(stderr, "kernel_launch: bad arguments (n_in %d, ws %zu)\n", n_in, ws_size); grid = -1; return; }
        int dev = 0, cus = 0;
        if (hipGetDevice(&dev) != hipSuccess || hipDeviceGetAttribute(&cus, hipDeviceAttributeMultiprocessorCount, dev) != hipSuccess) { grid = -1; return; }
        if (hipFuncSetAttribute((const void*)mega, hipFuncAttributeMaxDynamicSharedMemorySize, LDS_BYTES) != hipSuccess) { fprintf(stderr, "kernel_launch: hipFuncSetAttribute failed\n"); grid = -1; return; }
        (void)hipGetLastError();
        grid = cus;
    }
    if (grid < 0) return;
    float* out = (float*)d_out; unsigned char* ws = (unsigned char*)d_ws;
    (void)hipMemsetAsync(ws + WS_CTL, 0, CTL_ZERO_BYTES, stream);
    Args a{};
    for (int i = 0; i < 29; ++i) a.in[i] = (const float*)d_in[i];
    a.out = out; a.ws = ws;
#if defined(PROBE_LO)
    a.ph_lo = 0; a.ph_hi = PROBE_HI; a.li = 0;
    hipLaunchKernelGGL(mega, dim3(grid), dim3(NWAVES * 64), LDS_BYTES, stream, a);
    a.ph_lo = PROBE_LO; a.ph_hi = PROBE_HI; a.li = 1;
    hipLaunchKernelGGL(mega, dim3(grid), dim3(NWAVES * 64), LDS_BYTES, stream, a);
    a.ph_lo = PROBE_HI; a.ph_hi = 15; a.li = 2;
    hipLaunchKernelGGL(mega, dim3(grid), dim3(NWAVES * 64), LDS_BYTES, stream, a);
#elif defined(PER_PHASE)
    for (int k = 0; k < 15; ++k) { if (k == 11) continue; a.ph_lo = k; a.ph_hi = k + 1; a.li = 0; hipLaunchKernelGGL(mega, dim3(grid), dim3(NWAVES * 64), LDS_BYTES, stream, a); }
#else
    a.ph_lo = 0; a.ph_hi = 15; a.li = 0;
    hipLaunchKernelGGL(mega, dim3(grid), dim3(NWAVES * 64), LDS_BYTES, stream, a);
#endif
}
```

```cpp
#include <hip/hip_runtime.h>
#include <cstdio>
#include <cstdint>
#include <stdint.h>

__device__ __forceinline__ float bf2f(unsigned short v) { return __uint_as_float(((unsigned)v) << 16); }
__device__ __forceinline__ float silu_f(float x) { return x / (1.f + __expf(-x)); }
__device__ __forceinline__ float sigmoid_f(float x) { return 1.f / (1.f + __expf(-x)); }
__device__ __forceinline__ float gelu_tanh(float y) { return 0.5f * y * (1.f + tanhf(0.7978845608028654f * (y + 0.044715f * y * y * y))); }

constexpr int D = 1024, SEQ = 8192, MLAT = 16384, NCTX = 256, MCTX = 512, MALL = MLAT + MCTX;
constexpr float EPS = 1e-6f;
namespace pg8 {
#define PG8_LAS __attribute__((address_space(3)))
typedef unsigned short bf16_t;
typedef short bf16x8 __attribute__((ext_vector_type(8)));
typedef float f32x4 __attribute__((ext_vector_type(4)));
typedef unsigned u32x4 __attribute__((ext_vector_type(4)));
constexpr int BM = 256, BK = 64, HALF = 128, HTB = HALF * BK * 2  , STAGE_BYTES = 8 * HTB, NXCD = 8, WGM = 8;

__host__ __device__ __forceinline__ int lds_byte(int r, int c) { const int st = (r >> 4) * 2 + (c >> 5), rr = r & 15, cc = c & 31, ob = rr * 64 + cc * 2; return st * 1024 + (ob ^ (((ob >> 9) & 1) << 5)); }
__host__ __device__ __forceinline__ void stage_rc(int b, int& R, int& C) { const int st = b / 1024, sb = b % 1024, swz = sb ^ (((sb >> 9) & 1) << 5); R = (st >> 1) * 16 + swz / 64; C = (st & 1) * 32 + (swz % 64) / 2; }
__host__ __device__ __forceinline__ int perm32(int rho) { const int n = rho >> 4, i = rho & 15; return 8 * (i >> 2) + 4 * n + (i & 3); }

struct Unit { int pm, pn; };
struct Gemm { const bf16_t* A; const bf16_t* Bt; int M, N, K; };

struct StaticOrder {
    int nM, nN, nwg, G, c;
    __host__ __device__ void init(int M, int N, int G_, int c_) { nM = M / BM; nN = N / BM; nwg = nM * nN; G = G_; c = c_; }
    __host__ __device__ bool next(int i, Unit& u) const {
        const long L = (long)i * G + c; if (L >= nwg) return false;
        int wgid = (int)L; { const int q = nwg / NXCD, r = nwg % NXCD, xcd = wgid % NXCD, off = wgid / NXCD; wgid = (xcd < r ? xcd * (q + 1) : r * (q + 1) + (xcd - r) * q) + off; }
        const int nig = WGM * nN, gid = wgid / nig, fm = gid * WGM, gsz = (nM - fm) < WGM ? (nM - fm) : WGM;
        u.pm = fm + ((wgid % nig) % gsz); u.pn = (wgid % nig) / gsz; return true;
    }
    __device__ __forceinline__ void a_ready(const Unit&) const {}
    __device__ __forceinline__ void done(const Unit&) const {}
};

__device__ __forceinline__ unsigned cvt_pk_bf16(float lo, float hi) { unsigned r; asm volatile("v_cvt_pk_bf16_f32 %0, %1, %2" : "=v"(r) : "v"(lo), "v"(hi)); return r; }
typedef float f32x2 __attribute__((ext_vector_type(2)));
typedef unsigned u32x2 __attribute__((ext_vector_type(2)));
__device__ __forceinline__ u32x4 pack8(const f32x4 a, const f32x4 b) { u32x4 w; w.x = cvt_pk_bf16(a[0], a[1]); w.y = cvt_pk_bf16(a[2], a[3]); w.z = cvt_pk_bf16(b[0], b[1]); w.w = cvt_pk_bf16(b[2], b[3]); return w; }
__device__ __forceinline__ f32x4 sig4(const f32x4 v) { f32x4 r; r[0] = sigmoid_f(v[0]); r[1] = sigmoid_f(v[1]); r[2] = sigmoid_f(v[2]); r[3] = sigmoid_f(v[3]); return r; }
__device__ __forceinline__ void unpack8(const u32x4 w, f32x4& a, f32x4& b) {
    a[0] = __uint_as_float(w.x << 16); a[1] = __uint_as_float(w.x & 0xffff0000u); a[2] = __uint_as_float(w.y << 16); a[3] = __uint_as_float(w.y & 0xffff0000u);
    b[0] = __uint_as_float(w.z << 16); b[1] = __uint_as_float(w.z & 0xffff0000u); b[2] = __uint_as_float(w.w << 16); b[3] = __uint_as_float(w.w & 0xffff0000u); }

struct OneUnit {
    int pm, pn;
    __device__ bool next(int i, Unit& u) const { u.pm = pm; u.pn = pn; return i == 0; }
    __device__ __forceinline__ void a_ready(const Unit&) const {}
    __device__ __forceinline__ void done(const Unit&) const {}
};
struct InprojOrder {
    StaticOrder so; int G, c; bool with_ctx;
    __device__ void init(int G_, int c_, bool wc_) { so.init(MLAT, 4096, G_, c_); G = G_; c = c_; with_ctx = wc_; }
    __device__ bool next(int i, Unit& u) const {
        const long L = (long)i * G + c; if (L < 1024) return so.next(i, u);
        const int r = (int)(L - 1024); if (r >= 12 || !with_ctx) return false;
        const int j = r % 6; u.pm = 64 + r / 6; u.pn = j < 2 ? j : j + 2; return true;
    }
    __device__ __forceinline__ void a_ready(const Unit&) const {}
    __device__ __forceinline__ void done(const Unit&) const {}
};
struct EpiInproj {
    static constexpr bool PERM = true, AFTER_DRAIN = false, MID = false;
    bf16_t *U, *Q, *K, *V, *SGA, *SGB; const float *qn, *kn;
    __device__ __forceinline__ void operator()(const f32x4 (&acc)[2][2][4][2], const Unit& u, int wr, int wc, int fr, int fq) const {
        const int row0 = u.pm * BM + wr * 64 + fr, pn = u.pn;
        if (pn < 2 || pn == 6 || pn == 7) {
            bf16_t* base = (pn < 2 ? U : V) + (pn & 1) * 256 + wc * 32 + 8 * fq;
#pragma unroll
            for (int ai = 0; ai < 2; ++ai)
#pragma unroll
                for (int m = 0; m < 4; ++m) { bf16_t* rowp = base + (size_t)(row0 + ai * HALF + m * 16) * 512;
#pragma unroll
                    for (int bj = 0; bj < 2; ++bj) *(u32x4*)(rowp + bj * HALF) = pack8(acc[ai][bj][m][0], acc[ai][bj][m][1]); }
        } else if (pn < 6) {
            const bool isq = pn < 4; const float* wn = isq ? qn : kn; const float sc = isq ? 0.125f * 1.4426950408889634f : 1.f;
            bf16_t* base = (isq ? Q : K) + ((pn & 1) * 4 + wc) * 64 + 8 * fq;
            f32x4 wv[2][2];
#pragma unroll
            for (int bj = 0; bj < 2; ++bj)
#pragma unroll
                for (int n = 0; n < 2; ++n) wv[bj][n] = *(const f32x4*)(wn + 32 * bj + 8 * fq + 4 * n);
#pragma unroll
            for (int ai = 0; ai < 2; ++ai)
#pragma unroll
                for (int m = 0; m < 4; ++m) {
                    float ss = 0.f;
#pragma unroll
                    for (int bj = 0; bj < 2; ++bj)
#pragma unroll
                        for (int n = 0; n < 2; ++n) { const f32x4 x = acc[ai][bj][m][n]; ss += (x[0] * x[0] + x[1] * x[1]) + (x[2] * x[2] + x[3] * x[3]); }
                    ss += __shfl_xor(ss, 16); ss += __shfl_xor(ss, 32);
                    const float r = rsqrtf(ss * (1.f / 64.f) + EPS) * sc;
                    bf16_t* rowp = base + (size_t)(row0 + ai * HALF + m * 16) * 512;
#pragma unroll
                    for (int bj = 0; bj < 2; ++bj) *(u32x4*)(rowp + bj * 32) = pack8(acc[ai][bj][m][0] * r * wv[bj][0], acc[ai][bj][m][1] * r * wv[bj][1]);
                }
        } else {
            bf16_t* base = (pn < 12 ? SGA : SGB) + ((pn - 8) & 3) * 256 + wc * 32 + 8 * fq;
#pragma unroll
            for (int ai = 0; ai < 2; ++ai)
#pragma unroll
                for (int m = 0; m < 4; ++m) { bf16_t* rowp = base + (size_t)(row0 + ai * HALF + m * 16) * 1024;
#pragma unroll
                    for (int bj = 0; bj < 2; ++bj) *(u32x4*)(rowp + bj * HALF) = pack8(sig4(acc[ai][bj][m][0]), sig4(acc[ai][bj][m][1])); }
        }
    }
};
struct EpiGlu {
    static constexpr bool PERM = true, AFTER_DRAIN = false, MID = false;
    const bf16_t* Ain; const float* bglu; bf16_t* YA; int ldo;
    __device__ __forceinline__ void operator()(const f32x4 (&acc)[2][2][4][2], const Unit& u, int wr, int wc, int fr, int fq) const {
        const int row0 = u.pm * BM + wr * 64 + fr, col0 = u.pn * BM + wc * 32 + 8 * fq;
        f32x4 bv[2][2];
#pragma unroll
        for (int bj = 0; bj < 2; ++bj)
#pragma unroll
            for (int n = 0; n < 2; ++n) bv[bj][n] = *(const f32x4*)(bglu + col0 + bj * HALF + 4 * n);
#pragma unroll
        for (int ai = 0; ai < 2; ++ai)
#pragma unroll
            for (int m = 0; m < 4; ++m) { const size_t off = (size_t)(row0 + ai * HALF + m * 16) * 512 + col0, offo = (size_t)(row0 + ai * HALF + m * 16) * ldo + col0;
#pragma unroll
                for (int bj = 0; bj < 2; ++bj) { f32x4 a0, a1; unpack8(*(const u32x4*)(Ain + off + bj * HALF), a0, a1);
                    *(u32x4*)(YA + offo + bj * HALF) = pack8(a0 * sig4(acc[ai][bj][m][0] + bv[bj][0]), a1 * sig4(acc[ai][bj][m][1] + bv[bj][1])); } }
    }
};
struct EpiMerge {
    static constexpr bool PERM = true, AFTER_DRAIN = false, MID = true;
    const bf16_t* SGA; const bf16_t* SGB; bf16_t* Mo;
    __device__ __forceinline__ void mid(f32x4 (&acc)[2][2][4][2], const Unit& u, int wr, int wc, int fr, int fq) const {
        int row0_ = u.pm * BM + wr * 64 + fr, col0_ = u.pn * BM + wc * 32 + 8 * fq;
        asm volatile("" : "+v"(row0_), "+v"(col0_));
        const int row0 = row0_, col0 = col0_;
#pragma unroll
        for (int ai = 0; ai < 2; ++ai)
#pragma unroll
            for (int m = 0; m < 4; ++m) { const size_t off = (size_t)(row0 + ai * HALF + m * 16) * 1024 + col0;
#pragma unroll
                for (int bj = 0; bj < 2; ++bj) { f32x4 a0, a1, b0, b1; unpack8(*(const u32x4*)(SGA + off + bj * HALF), a0, a1); unpack8(*(const u32x4*)(SGB + off + bj * HALF), b0, b1);
#pragma unroll
                    for (int e = 0; e < 4; ++e) { acc[ai][bj][m][0][e] *= a0[e] * __builtin_amdgcn_rcpf(b0[e]); acc[ai][bj][m][1][e] *= a1[e] * __builtin_amdgcn_rcpf(b1[e]); } }
                if (m == 3) __builtin_amdgcn_sched_barrier(0); }
    }
    __device__ __forceinline__ void operator()(const f32x4 (&acc)[2][2][4][2], const Unit& u, int wr, int wc, int fr, int fq) const {
        int row0_ = u.pm * BM + wr * 64 + fr, col0_ = u.pn * BM + wc * 32 + 8 * fq;
        asm volatile("" : "+v"(row0_), "+v"(col0_));
        const int row0 = row0_, col0 = col0_;
#pragma unroll
        for (int ai = 0; ai < 2; ++ai)
#pragma unroll
            for (int m = 0; m < 4; ++m) { const size_t off = (size_t)(row0 + ai * HALF + m * 16) * 1024 + col0;
#pragma unroll
                for (int bj = 0; bj < 2; ++bj) { f32x4 b0, b1; unpack8(*(const u32x4*)(SGB + off + bj * HALF), b0, b1);
                    *(u32x4*)(Mo + off + bj * HALF) = pack8(acc[ai][bj][m][0] * b0, acc[ai][bj][m][1] * b1); } }
    }
};
struct ExpertGather { const int* idx; __device__ __forceinline__ unsigned row(int pm, int r) const { return (unsigned)((pm >> 6) * SEQ + idx[pm * BM + r]); } };
struct EpiOut {
    static constexpr bool PERM = false, AFTER_DRAIN = false, MID = false;
    const float* x; const float* mod; float* X1;
    __device__ __forceinline__ void operator()(const f32x4 (&acc)[2][2][4][2], const Unit& u, int wr, int wc, int fr, int fq) const {
        const int row0 = u.pm * BM + wr * 64 + fr, col0 = u.pn * BM + wc * 32 + 4 * fq;
        const float* g1 = mod + ((u.pm * BM) >> 13) * 6144 + 2048;
        f32x4 gv[2][2];
#pragma unroll
        for (int bj = 0; bj < 2; ++bj)
#pragma unroll
            for (int n = 0; n < 2; ++n) gv[bj][n] = *(const f32x4*)(g1 + col0 + bj * HALF + n * 16);
#pragma unroll
        for (int ai = 0; ai < 2; ++ai)
#pragma unroll
            for (int m = 0; m < 4; ++m) { const size_t off = (size_t)(row0 + ai * HALF + m * 16) * 1024 + col0;
#pragma unroll
                for (int bj = 0; bj < 2; ++bj)
#pragma unroll
                    for (int n = 0; n < 2; ++n) *(f32x4*)(X1 + off + bj * HALF + n * 16) = *(const f32x4*)(x + off + bj * HALF + n * 16) + gv[bj][n] * acc[ai][bj][m][n]; }
    }
};
struct EpiHid {
    static constexpr bool PERM = true, AFTER_DRAIN = false, MID = false;
    bf16_t* HID;
    __device__ __forceinline__ void operator()(const f32x4 (&acc)[2][2][4][2], const Unit& u, int wr, int wc, int fr, int fq) const {
        const int row0 = u.pm * BM + wr * 64 + fr, f0 = (u.pn & 7) * 128 + wc * 16 + 4 * fq;
#pragma unroll
        for (int ai = 0; ai < 2; ++ai)
#pragma unroll
            for (int m = 0; m < 4; ++m) { bf16_t* rowp = HID + (size_t)(row0 + ai * HALF + m * 16) * 1024 + f0;
#pragma unroll
                for (int bj = 0; bj < 2; ++bj) { const f32x4 g = acc[ai][bj][m][0], up = acc[ai][bj][m][1];
                    u32x2 w; w.x = cvt_pk_bf16(silu_f(g[0]) * up[0], silu_f(g[1]) * up[1]); w.y = cvt_pk_bf16(silu_f(g[2]) * up[2], silu_f(g[3]) * up[3]);
                    *(u32x2*)(rowp + bj * 64) = w; } }
    }
};
struct EpiDown {
    static constexpr bool PERM = true, AFTER_DRAIN = false, MID = false;
    const float* GSEL; bf16_t* Y;
    __device__ __forceinline__ void operator()(const f32x4 (&acc)[2][2][4][2], const Unit& u, int wr, int wc, int fr, int fq) const {
        const int row0 = u.pm * BM + wr * 64 + fr, col0 = (u.pn & 3) * BM + wc * 32 + 8 * fq;
#pragma unroll
        for (int ai = 0; ai < 2; ++ai)
#pragma unroll
            for (int m = 0; m < 4; ++m) { const int row = row0 + ai * HALF + m * 16; const float gs = GSEL[row]; bf16_t* rowp = Y + (size_t)row * 1024 + col0;
#pragma unroll
                for (int bj = 0; bj < 2; ++bj) *(u32x4*)(rowp + bj * HALF) = pack8(acc[ai][bj][m][0] * gs, acc[ai][bj][m][1] * gs); }
    }
};
template <int NT  > struct ExpertOrder {
    int G, c;
    __device__ void init(int G_, int c_) { G = G_; c = c_; }
    __device__ bool next(int i, Unit& u) const {
        constexpr int UPE = 8 * NT;
        long L = (long)i * G + c; if (L >= 16 * UPE) return false;
        if (G == 256) { const int xcd = c & 7, local = c >> 3, rpe = UPE / 32  ; L = (long)(xcd + 8 * (i / rpe)) * UPE + (i % rpe) * 32 + local; }
        const int e = (int)(L / UPE), uu = (int)(L % UPE), b = uu / (4 * NT), m = (uu / NT) & 3, j = uu % NT;
        u.pm = (b * 16 + e) * 4 + m; u.pn = e * NT + j; return true;
    }
    __device__ __forceinline__ void a_ready(const Unit&) const {}
    __device__ __forceinline__ void done(const Unit&) const {}
};
struct NoGather { __device__ __forceinline__ unsigned row(int, int r) const { return (unsigned)r; } };
template <class Epi, class Sched, bool ALIGN_EPI = false, bool GATHER = false, class Gat = NoGather>
__device__ __forceinline__ void gemm_phase(PG8_LAS unsigned char* lds, const Gemm g, const Sched& S, const Epi& E, const Gat gat = Gat()) {
    const int tid = threadIdx.x, wid = __builtin_amdgcn_readfirstlane(tid >> 6), lane = tid & 63, wr = wid >> 2, wc = wid & 3, fr = lane & 15, fq = lane >> 4;
    const int K = g.K, nt = K / BK;
    const size_t kstep = (size_t)(BK * 2);
    const size_t hstep = (size_t)HALF * K * 2;
    const size_t tstep = 2 * hstep;
    unsigned voffB[2]; int Ra[2], Ca[2];
#pragma unroll
    for (int i = 0; i < 2; ++i) { int R, C; stage_rc(tid * 16 + i * 8192, R, C); const int Rb = Epi::PERM ? ((R & ~31) + perm32(R & 31)) : R;
        Ra[i] = R; Ca[i] = C; voffB[i] = (unsigned)(Rb * K + C) * 2u; }
    unsigned vAc[2][2], vAn[2][2];
#define PG8_AOFF(dst, pm) do { _Pragma("unroll") for (int h_ = 0; h_ < 2; ++h_) _Pragma("unroll") for (int i_ = 0; i_ < 2; ++i_) \
        dst[h_][i_] = GATHER ? (gat.row((pm), h_ * HALF + Ra[i_]) * (unsigned)K + (unsigned)Ca[i_]) * 2u : (unsigned)((h_ * HALF + Ra[i_]) * K + Ca[i_]) * 2u; } while (0)
    const unsigned ldsw = (unsigned)wid * 1024u;
    const int aoff = lds_byte(wr * 64 + fr, fq * 8), boff = lds_byte(wc * 32 + fr, fq * 8);
#define PG8_SA(b, h) (((b) * 2 + (h)) * HTB)
#define PG8_SB(b, h) ((4 + (b) * 2 + (h)) * HTB)
#define PG8_STAGE(bufoff, gbase, voff) do { _Pragma("unroll") for (int _i = 0; _i < 2; ++_i) \
        __builtin_amdgcn_global_load_lds((const unsigned*)((const char*)(gbase) + (voff)[_i]), (PG8_LAS unsigned*)(lds + (bufoff) + ldsw + _i * 8192), 16, 0, 0); } while (0)
#define PG8_LDA(dst, b, h) do { _Pragma("unroll") for (int m = 0; m < 4; ++m) _Pragma("unroll") for (int k = 0; k < 2; ++k) dst[m][k] = *(const PG8_LAS bf16x8*)(lds + PG8_SA(b, h) + aoff + m * 2048 + k * 1024); } while (0)
#define PG8_LDB(dst, b, h) do { _Pragma("unroll") for (int n = 0; n < 2; ++n) _Pragma("unroll") for (int k = 0; k < 2; ++k) dst[n][k] = *(const PG8_LAS bf16x8*)(lds + PG8_SB(b, h) + boff + n * 2048 + k * 1024); } while (0)
#define PG8_MMA(ai, bj, At, Bt) do { __builtin_amdgcn_s_setprio(1); _Pragma("unroll") for (int m = 0; m < 4; ++m) _Pragma("unroll") for (int n = 0; n < 2; ++n) _Pragma("unroll") for (int k = 0; k < 2; ++k) \
        acc[ai][bj][m][n] = __builtin_amdgcn_mfma_f32_16x16x32_bf16(Bt[n][k], At[m][k], acc[ai][bj][m][n], 0, 0, 0); __builtin_amdgcn_s_setprio(0); } while (0)
#define PG8_WAIT_V(n) asm volatile("s_waitcnt vmcnt(" #n ")" ::: "memory")
#define PG8_WAIT_L(n) asm volatile("s_waitcnt lgkmcnt(" #n ")" ::: "memory")
#define PG8_BAR __builtin_amdgcn_s_barrier()
#define PG8_SCHED __builtin_amdgcn_sched_barrier(0)
    Unit cur, nxt; int ui = 0;
    if (!S.next(0, cur)) return;
    f32x4 acc[2][2][4][2];
#pragma unroll
    for (int a = 0; a < 2; ++a)
#pragma unroll
        for (int b = 0; b < 2; ++b)
#pragma unroll
            for (int m = 0; m < 4; ++m)
#pragma unroll
                for (int n = 0; n < 2; ++n) acc[a][b][m][n] = (f32x4){0.f, 0.f, 0.f, 0.f};
    bf16x8 At[4][2], B0[2][2], B1[2][2];
    const char* cA = (const char*)g.A + (GATHER ? (size_t)0 : (size_t)cur.pm * tstep); const char* cB = (const char*)g.Bt + (size_t)cur.pn * tstep;
    PG8_AOFF(vAc, cur.pm);
    S.a_ready(cur);
    PG8_STAGE(PG8_SB(0, 0), cB, voffB); PG8_STAGE(PG8_SB(0, 1), cB + hstep, voffB); PG8_STAGE(PG8_SA(0, 0), cA, vAc[0]); PG8_STAGE(PG8_SA(0, 1), cA, vAc[1]);
    if (wr == 1) PG8_BAR;
    PG8_WAIT_V(2); PG8_BAR;
    PG8_STAGE(PG8_SB(1, 0), cB + kstep, voffB); PG8_STAGE(PG8_SA(1, 0), cA + kstep, vAc[0]); PG8_STAGE(PG8_SB(1, 1), cB + hstep + kstep, voffB);
    PG8_WAIT_V(6); PG8_BAR;
    for (;;) {
        const bool has_next = S.next(ui + 1, nxt);
        const char* nA = (has_next && !GATHER) ? (const char*)g.A + (size_t)nxt.pm * tstep : cA; const char* nB = has_next ? (const char*)g.Bt + (size_t)nxt.pn * tstep : cB;
        if (has_next) PG8_AOFF(vAn, nxt.pm); else { _Pragma("unroll") for (int h_ = 0; h_ < 2; ++h_) _Pragma("unroll") for (int i_ = 0; i_ < 2; ++i_) vAn[h_][i_] = vAc[h_][i_]; }
        for (int t = 0; t < nt; t += 2) {
            const bool last = (t == nt - 2);
            const char* a1 = cA + (size_t)(t + 1) * kstep;
            const char* a2 = last ? nA : cA + (size_t)(t + 2) * kstep; const char* b2 = last ? nB : cB + (size_t)(t + 2) * kstep;
            const char* a3 = a2 + kstep; const char* b3 = b2 + kstep;
            unsigned v2[2][2];
#pragma unroll
            for (int h_ = 0; h_ < 2; ++h_)
#pragma unroll
                for (int i_ = 0; i_ < 2; ++i_) v2[h_][i_] = last ? vAn[h_][i_] : vAc[h_][i_];
            if (last && has_next) S.a_ready(nxt);
            PG8_LDB(B0, 0, 0); PG8_LDB(B1, 0, 1); PG8_SCHED; PG8_LDA(At, 0, 0); PG8_STAGE(PG8_SA(1, 1), a1, vAc[1]);
            PG8_WAIT_V(8); PG8_WAIT_L(0); PG8_BAR; PG8_MMA(0, 0, At, B0); PG8_MMA(0, 1, At, B1); PG8_BAR; PG8_SCHED;
            PG8_LDA(At, 0, 1); PG8_STAGE(PG8_SB(0, 0), b2, voffB); PG8_STAGE(PG8_SB(0, 1), b2 + hstep, voffB); PG8_STAGE(PG8_SA(0, 0), a2, v2[0]);
            PG8_WAIT_V(8); PG8_WAIT_L(0); PG8_BAR; PG8_MMA(1, 0, At, B0); PG8_MMA(1, 1, At, B1); PG8_BAR; PG8_SCHED;
            PG8_LDB(B0, 1, 0); PG8_LDB(B1, 1, 1); PG8_SCHED; PG8_LDA(At, 1, 0); PG8_STAGE(PG8_SA(0, 1), a2, v2[1]);
            PG8_WAIT_V(8); PG8_WAIT_L(0); PG8_BAR; PG8_MMA(0, 0, At, B0); PG8_MMA(0, 1, At, B1); PG8_BAR; PG8_SCHED;
            PG8_LDA(At, 1, 1); PG8_STAGE(PG8_SB(1, 0), b3, voffB); PG8_STAGE(PG8_SB(1, 1), b3 + hstep, voffB); PG8_STAGE(PG8_SA(1, 0), a3, v2[0]);
            PG8_WAIT_V(8); PG8_WAIT_L(0); PG8_BAR; PG8_MMA(1, 0, At, B0); PG8_MMA(1, 1, At, B1); PG8_BAR; PG8_SCHED;
            if constexpr (Epi::MID) { if (t == nt / 2 - 2) { E.mid(acc, cur, wr, wc, fr, fq); PG8_SCHED; } }
        }
        if constexpr (ALIGN_EPI) { if (wr == 0) PG8_BAR; }
        if constexpr (!Epi::AFTER_DRAIN) { E(acc, cur, wr, wc, fr, fq); S.done(cur); }
        if (!has_next) break;
#pragma unroll
        for (int a = 0; a < 2; ++a)
#pragma unroll
            for (int b = 0; b < 2; ++b)
#pragma unroll
                for (int m = 0; m < 4; ++m)
#pragma unroll
                    for (int n = 0; n < 2; ++n) acc[a][b][m][n] = (f32x4){0.f, 0.f, 0.f, 0.f};
        cur = nxt; cA = nA; cB = nB; ++ui;
#pragma unroll
        for (int h_ = 0; h_ < 2; ++h_)
#pragma unroll
            for (int i_ = 0; i_ < 2; ++i_) vAc[h_][i_] = vAn[h_][i_];
        if constexpr (ALIGN_EPI) { if (wr == 1) PG8_BAR; }
    }
    PG8_WAIT_V(0);
    if constexpr (!ALIGN_EPI) { if (wr == 0) PG8_BAR; }
    PG8_BAR;
    if constexpr (Epi::AFTER_DRAIN) { E.fused(acc, cur, wr, wc, fr, fq, lds, wid, lane); S.done(cur); }
#undef PG8_AOFF
#undef PG8_SA
#undef PG8_SB
#undef PG8_STAGE
#undef PG8_LDA
#undef PG8_LDB
#undef PG8_MMA
#undef PG8_WAIT_V
#undef PG8_WAIT_L
#undef PG8_BAR
#undef PG8_SCHED
}
}
#define GAS __attribute__((address_space(1)))
#define LAS __attribute__((address_space(3)))
typedef unsigned short bf16;
typedef unsigned v4u __attribute__((ext_vector_type(4)));
typedef float f32x4 __attribute__((ext_vector_type(4)));
typedef short bf16x8 __attribute__((ext_vector_type(8)));
typedef GAS unsigned gu32;
typedef GAS unsigned long long gu64;
#define RLX_AGENT __ATOMIC_RELAXED, __HIP_MEMORY_SCOPE_AGENT
#define LDS_WAIT() asm volatile("s_waitcnt lgkmcnt(0)" ::: "memory")
#define VM_WAIT() asm volatile("s_waitcnt vmcnt(0)" ::: "memory")
__device__ __forceinline__ unsigned long long rt() { return __builtin_amdgcn_s_memrealtime(); }
__device__ __forceinline__ unsigned f2bf(float f) { unsigned u = __builtin_bit_cast(unsigned, f); return (u + 0x7fffu + ((u >> 16) & 1u)) >> 16; }
__device__ __forceinline__ unsigned pk2(float lo, float hi) { return f2bf(lo) | (f2bf(hi) << 16); }

#define XB_TMO      128
#define XB_XCNT(j)  (256  + 64 * (j))
#define XB_XSUB(j)  (1280 + 64 * (j))
#define XB_XGEN(j)  (2304 + 64 * (j))
#define XB_TOP      3328
#define XB_TOPGEN   3392
#define XCD_BAR_WORDS 3456
#define XB_SPIN_CAP (1u << 18)

__device__ __forceinline__ unsigned xb_ld(unsigned* p)              { return __hip_atomic_load(p, __ATOMIC_RELAXED, __HIP_MEMORY_SCOPE_AGENT); }
__device__ __forceinline__ unsigned xb_add(unsigned* p, unsigned v) { return __hip_atomic_fetch_add(p, v, __ATOMIC_RELAXED, __HIP_MEMORY_SCOPE_AGENT); }
__device__ __forceinline__ unsigned xb_xcc_id() { return (unsigned)__builtin_amdgcn_s_getreg((3 << 11) | 20) & 0xFu; }
#define XB_SPIN(cond, bar) do { unsigned _sp = 0; while (cond) { __builtin_amdgcn_s_sleep(1); \
    if ((++_sp & 255u) == 0u) { if (xb_ld(&(bar)[XB_TMO])) break; if (_sp > XB_SPIN_CAP) { atomicAdd(&(bar)[XB_TMO], 1u); break; } } } } while (0)

struct XcdBarrier {
    unsigned* bar; unsigned x;
    volatile LAS unsigned* st;
};

__device__ __forceinline__ XcdBarrier xcd_barrier_post(unsigned* bar, volatile LAS unsigned* st) {
    XcdBarrier b; b.bar = bar; b.x = xb_xcc_id(); b.st = st;
    if (threadIdx.x == 0) (void)xb_add(&bar[XB_XCNT(b.x)], 1u);
    return b;
}
__device__ __forceinline__ void xcd_barrier_complete(unsigned* bar, unsigned x, unsigned& nloc, unsigned& nx) {
    const unsigned G = gridDim.x * gridDim.y * gridDim.z;
    unsigned sum, cnt, mine, sp = 0u;
    for (;;) {
        sum = 0u; cnt = 0u; mine = 0u;
#pragma unroll
        for (unsigned j = 0; j < 16; ++j) { const unsigned c = xb_ld(&bar[XB_XCNT(j)]); sum += c; cnt += (c > 0u) ? 1u : 0u; mine = (j == x) ? c : mine; }
        if (sum == G) break;
        __builtin_amdgcn_s_sleep(1);
        if ((++sp & 255u) == 0u) { if (xb_ld(&bar[XB_TMO])) break; if (sp > XB_SPIN_CAP) { atomicAdd(&bar[XB_TMO], 1u); break; } }
    }
    nloc = mine > 0u ? mine : 1u; nx = cnt > 0u ? cnt : 1u;
}

__device__ __forceinline__ void xcd_barrier(const XcdBarrier& b) {
    asm volatile("s_waitcnt vmcnt(0)" ::: "memory");
    __syncthreads();
    if (threadIdx.x == 0) {
        unsigned* bar = b.bar;
        __builtin_amdgcn_s_waitcnt(0);
        unsigned nloc = b.st[0], nx = b.st[1];
        if (nloc == 0u) { xcd_barrier_complete(bar, b.x, nloc, nx); b.st[0] = nloc; b.st[1] = nx; }
        const unsigned old = xb_add(&bar[XB_XSUB(b.x)], 1u);
        const unsigned gen = old / nloc;
        if (old + 1u == (gen + 1u) * nloc) {
            __builtin_amdgcn_fence(__ATOMIC_RELEASE, "agent");
            asm volatile("s_waitcnt vmcnt(0)" ::: "memory");
            const unsigned og = xb_add(&bar[XB_TOP], 1u);
            const unsigned tg = og / nx;
            if (og + 1u == (tg + 1u) * nx) xb_add(&bar[XB_TOPGEN], 1u);
            else XB_SPIN(xb_ld(&bar[XB_TOPGEN]) == tg, bar);
            __builtin_amdgcn_fence(__ATOMIC_ACQUIRE, "agent");
            xb_add(&bar[XB_XGEN(b.x)], 1u);
            asm volatile("s_waitcnt vmcnt(0)" ::: "memory");
        } else {
            XB_SPIN(xb_ld(&bar[XB_XGEN(b.x)]) == gen, bar);
            __builtin_amdgcn_fence(__ATOMIC_ACQUIRE, "agent");
            asm volatile("s_waitcnt vmcnt(0)" ::: "memory");
        }
    }
    __syncthreads();
}

#ifndef PROBE_MASK
#define PROBE_MASK 0
#endif
#ifndef PROBE_VARIANT
#define PROBE_VARIANT 7
#endif
#ifndef PROBE_REPS
#define PROBE_REPS 4
#endif
constexpr int NWAVES = 8;
constexpr size_t MiB = 1u << 20;
constexpr size_t WS_CTL = 0, CTL_ZERO_BYTES = 256 * 1024;
constexpr int CW_TMO = 0, CW_CODE = 1, CW_BAR = 4096;
constexpr size_t WS_MOD = 160 * 1024;
constexpr size_t WS_AFF = 1 * MiB, WS_IDX = 2 * MiB, WS_GSEL = 2 * MiB + 256 * 1024, WS_SLOT = 3 * MiB;
constexpr size_t WS_H = 4 * MiB;
constexpr size_t WS_BG = 38 * MiB;
constexpr size_t WS_U = WS_BG, WS_V = WS_BG + 17 * MiB, WS_K = WS_BG + 34 * MiB, WS_Q = WS_BG + 51 * MiB, WS_SGA = WS_BG + 68 * MiB, WS_SGB = WS_BG + 100 * MiB;
constexpr size_t WS_YS = WS_BG + 132 * MiB, WS_YAB = WS_BG + 156 * MiB;
constexpr size_t WS_M = WS_BG;
constexpr size_t WS_XE = WS_BG, WS_WGU = WS_SGA, WS_HID = WS_BG + 132 * MiB;
constexpr size_t WS_WIN = 226 * MiB, WS_WGLU = 234 * MiB, WS_WPA = 235 * MiB, WS_WOUT = 237 * MiB;
constexpr size_t WS_WD = 239 * MiB, WS_END = 271 * MiB;
static_assert(WS_YAB + 32 * MiB <= WS_WIN && WS_HID + 64 * MiB <= WS_WD && WS_XE + 64 * MiB <= WS_WGU && WS_WGU + 64 * MiB <= WS_HID && WS_WOUT + 2 * MiB <= WS_WD, "d_ws map");
static_assert(CW_BAR * 4 + 8 * XCD_BAR_WORDS * 4 <= (int)WS_MOD && WS_MOD + 3 * 6144 * 4 <= CTL_ZERO_BYTES, "control region");

constexpr int RING_OFF = 0, RING_BYTES = 131072;
constexpr int LDSCTL_OFF = RING_BYTES, MISC_OFF = LDSCTL_OFF + 320;
constexpr int LDS_BYTES = 147456;

__device__ __forceinline__ float wave_sum(float v) {
#pragma unroll
    for (int o = 1; o < 64; o <<= 1) v += __shfl_xor(v, o);
    return v;
}
template <int MODE> __device__ __forceinline__ int wrow(int n) {
    if (MODE == 1) { const int t = n >> 8, cl = n & 255; return (t >= 2 && t < 6) ? (t * 256 + 128 * ((cl >> 5) & 1) + 32 * (cl >> 6) + (cl & 31)) : n; }
    if (MODE == 2) return (n >> 2) * 8 + (n & 3);
    if (MODE == 3) return (n >> 2) * 8 + 4 + (n & 3);
    return n;
}
struct TItem { const float* W; bf16* WT; int N, ldw, item; };
__device__ __forceinline__ void titem_load(const TItem& t, f32x4 (&ld)[8], int lane) {
    const int nblk = t.N / 32, k0 = 64 * (t.item / nblk), n0 = 32 * (t.item % nblk);
#pragma unroll
    for (int i = 0; i < 8; ++i) ld[i] = *(const f32x4*)(t.W + (size_t)(k0 + 8 * i + (lane >> 3)) * t.N + n0 + 4 * (lane & 7));
}
template <int MODE> __device__ __forceinline__ void titem_finish(const TItem& t, const f32x4 (&ld)[8], LAS float* scr, int lane) {
    const int nblk = t.N / 32, k0 = 64 * (t.item / nblk), n0 = 32 * (t.item % nblk);
#pragma unroll
    for (int i = 0; i < 8; ++i) { LAS float* d = scr + (8 * i + (lane >> 3)) * 33 + 4 * (lane & 7); d[0] = ld[i][0]; d[1] = ld[i][1]; d[2] = ld[i][2]; d[3] = ld[i][3]; }
    LDS_WAIT(); asm volatile("" ::: "memory");
    const int c = lane & 7;
#pragma unroll
    for (int j = 0; j < 4; ++j) { const int n = (lane >> 3) + 8 * j; const LAS float* s = scr + (8 * c) * 33 + n;
        v4u o; o.x = pk2(s[0 * 33], s[1 * 33]); o.y = pk2(s[2 * 33], s[3 * 33]); o.z = pk2(s[4 * 33], s[5 * 33]); o.w = pk2(s[6 * 33], s[7 * 33]);
        *(GAS v4u*)(t.WT + (size_t)wrow<MODE>(n0 + n) * t.ldw + k0 + 8 * c) = o; }
    LDS_WAIT(); asm volatile("" ::: "memory");
}
template <int MODE> __device__ __forceinline__ void transpose_item(const float* W, int K, int N, bf16* WT, int ldw, LAS float* scr, int item, int lane) {
    const TItem t{W, WT, N, ldw, item}; f32x4 ld[8]; titem_load(t, ld, lane); titem_finish<MODE>(t, ld, scr, lane);
}
__device__ __forceinline__ void norm1_rows(const float* src0, bf16* dst0, int nrow, const float* gwt, const float* md, int lane) {
    f32x4 ca[4], cb[4];
#pragma unroll
    for (int j = 0; j < 4; ++j) { const int col = j * 256 + lane * 4; ca[j] = *(const f32x4*)(gwt + col) * (*(const f32x4*)(md + 1024 + col) + 1.f); cb[j] = *(const f32x4*)(md + col); }
    f32x4 na[4], nb[4];
#pragma unroll
    for (int j = 0; j < 4; ++j) { na[j] = *(const f32x4*)(src0 + j * 256 + lane * 4); nb[j] = *(const f32x4*)(src0 + (size_t)(nrow > 1 ? 1 : 0) * D + j * 256 + lane * 4); }
#pragma unroll 1
    for (int rr = 0; rr < nrow; rr += 2) {
        const int rb_ = (rr + 1 < nrow) ? rr + 1 : rr;
        f32x4 va[4], vb[4]; float ssa = 0.f, ssb = 0.f;
#pragma unroll
        for (int j = 0; j < 4; ++j) { va[j] = na[j]; vb[j] = nb[j]; }
        if (rr + 2 < nrow) { const int r2 = rr + 2, r3 = (rr + 3 < nrow) ? rr + 3 : rr + 2;
#pragma unroll
            for (int j = 0; j < 4; ++j) { na[j] = *(const f32x4*)(src0 + (size_t)r2 * D + j * 256 + lane * 4); nb[j] = *(const f32x4*)(src0 + (size_t)r3 * D + j * 256 + lane * 4); } }
#pragma unroll
        for (int j = 0; j < 4; ++j) { ssa += (va[j][0] * va[j][0] + va[j][1] * va[j][1]) + (va[j][2] * va[j][2] + va[j][3] * va[j][3]); ssb += (vb[j][0] * vb[j][0] + vb[j][1] * vb[j][1]) + (vb[j][2] * vb[j][2] + vb[j][3] * vb[j][3]); }
        const float ra = rsqrtf(wave_sum(ssa) * (1.f / D) + EPS), rb = rsqrtf(wave_sum(ssb) * (1.f / D) + EPS);
#pragma unroll
        for (int j = 0; j < 4; ++j) {
            const int col = j * 256 + lane * 4;
            const f32x4 oa = va[j] * ra * ca[j] + cb[j], ob = vb[j] * rb * ca[j] + cb[j];
            pg8::u32x2 w; w.x = pk2(oa[0], oa[1]); w.y = pk2(oa[2], oa[3]); *(pg8::u32x2*)(dst0 + (size_t)rr * D + col) = w;
            w.x = pk2(ob[0], ob[1]); w.y = pk2(ob[2], ob[3]); *(pg8::u32x2*)(dst0 + (size_t)rb_ * D + col) = w;
        }
    }
}

struct Args { const float* in[29]; float* out; unsigned char* ws; int ph_lo, ph_hi, li, pad; };
enum { I_X = 0, I_C, I_CTX, I_CCTX, I_WADA, I_BADA, I_NMIX, I_NFFN, I_WIN, I_LRE, I_LIM, I_LDT, I_BRE, I_BIM, I_CRE, I_CIM, I_SD, I_WGLU, I_BGLU, I_QN, I_KN, I_RPB, I_WPA, I_WPB, I_WOUT, I_WR, I_WEG, I_WEU, I_WED };

typedef float f32x16 __attribute__((ext_vector_type(16)));
constexpr int S5_CH = 64, S5_NCH = 132, S5_NST = S5_CH / 16, S5_NPAIR = S5_NCH / 2, S5_NLAT = SEQ / S5_CH, S5_NCC = NCTX / S5_CH;
constexpr size_t WS_LAM = 512 * 1024, WS_LAMP = 512 * 1024 + 32768;
constexpr size_t WS_S5B = 2 * MiB + 512 * 1024, WS_S5C = 2 * MiB + 768 * 1024;
constexpr size_t WS_SEND = WS_YS, WS_HIN = WS_YS + 12 * MiB;

__device__ __forceinline__ void s5_prep(const Args& args, unsigned char* ws, int dg, int lane) {
    const float* lam_re = args.in[I_LRE]; const float* lam_im = args.in[I_LIM]; const float* b_re = args.in[I_BRE]; const float* b_im = args.in[I_BIM];
    const float* c_re = args.in[I_CRE]; const float* c_im = args.in[I_CIM];
    const float dt = expf(args.in[I_LDT][dg]);
    {
        const int p = lane; const float lre = lam_re[dg * 64 + p], lim = lam_im[dg * 64 + p];
        const float er = expf(lre * dt); float xr = er * cosf(lim * dt), xi = er * sinf(lim * dt);
        float* L = (float*)(ws + WS_LAM) + (dg * 64 + p) * 2; L[0] = xr; L[1] = xi;
#pragma unroll
        for (int s = 0; s < 6; ++s) { const float nr = xr * xr - xi * xi, ni = 2.f * xr * xi; xr = nr; xi = ni; }
        float* LP = (float*)(ws + WS_LAMP) + (dg * 64 + p) * 2; LP[0] = xr; LP[1] = xi;
    }
    const int r = lane & 31, h = lane >> 5;
#pragma unroll
    for (int q = 0; q < 4; ++q) {
        const int p = 2 * r + (q >> 1); const float lre = lam_re[dg * 64 + p], lim = lam_im[dg * 64 + p];
        const float er = expf(lre * dt), lbr = er * cosf(lim * dt), lbi = er * sinf(lim * dt);
        const float nr = lbr - 1.f, ni = lbi, den = lre * lre + lim * lim, cr = (nr * lre + ni * lim) / den, ci = (ni * lre - nr * lim) / den;
        unsigned w[4];
#pragma unroll
        for (int jj = 0; jj < 8; jj += 2) {
            float v[2];
#pragma unroll
            for (int e = 0; e < 2; ++e) { const int c = 8 * h + jj + e; const float br = b_re[(dg * 64 + p) * 16 + c], bi = b_im[(dg * 64 + p) * 16 + c]; v[e] = (q & 1) ? (cr * bi + ci * br) : (cr * br - ci * bi); }
            w[jj >> 1] = pk2(v[0], v[1]);
        }
        *(v4u*)(ws + WS_S5B + ((size_t)(dg * 4 + q) * 64 + lane) * 16) = (v4u){w[0], w[1], w[2], w[3]};
    }
    const int ch = lane & 15, fq = lane >> 4;
#pragma unroll
    for (int ks = 0; ks < 4; ++ks) {
        unsigned w[4];
#pragma unroll
        for (int jj = 0; jj < 8; jj += 2) { const int st = (32 * ks + 8 * fq + jj) >> 1;
            w[jj >> 1] = pk2(c_re[(dg * 16 + ch) * 64 + st], -c_im[(dg * 16 + ch) * 64 + st]); }
        *(v4u*)(ws + WS_S5C + ((size_t)(dg * 4 + ks) * 64 + lane) * 16) = (v4u){w[0], w[1], w[2], w[3]};
    }
}
__device__ __forceinline__ int s5_row(int b, int dir, int pos) {
    if (pos < NCTX) return MLAT + b * NCTX + (dir ? NCTX - 1 - pos : pos);
    const int t = pos - NCTX; return b * SEQ + (dir ? SEQ - 1 - t : t);
}
#define S5_SCAN16(D0, D1, D2, D3) do { _Pragma("unroll") for (int r_ = 0; r_ < 16; ++r_) { \
        const float n0r = fmaf(lm[0], x[0], fmaf(-lm[1], x[1], D0[r_])), n0i = fmaf(lm[0], x[1], fmaf(lm[1], x[0], D1[r_])); \
        const float n1r = fmaf(lm[2], x[2], fmaf(-lm[3], x[3], D2[r_])), n1i = fmaf(lm[2], x[3], fmaf(lm[3], x[2], D3[r_])); \
        x[0] = n0r; x[1] = n0i; x[2] = n1r; x[3] = n1i; D0[r_] = n0r; D1[r_] = n0i; D2[r_] = n1r; D3[r_] = n1i; } } while (0)

#define S5_SCAN16_ONE(Dr, Di, LR, LI, XR, XI) do { _Pragma("unroll") for (int r_ = 0; r_ < 16; ++r_) { \
        const float nr_ = fmaf(LR, XR, fmaf(-(LI), XI, Dr[r_])), ni_ = fmaf(LR, XI, fmaf(LI, XR, Di[r_])); XR = nr_; XI = ni_; Dr[r_] = nr_; Di[r_] = ni_; } } while (0)
__device__ __forceinline__ void s5_pass1(unsigned char* ws, int task, int lane) {
    const int chain = task / S5_NPAIR, w = task % S5_NPAIR, g = chain & 31, dir = (chain >> 5) & 1, b = chain >> 6, dg = dir * 32 + g;
    const bf16* U = (const bf16*)(ws + WS_U);
    bf16x8 Bf[4];
#pragma unroll
    for (int q = 0; q < 4; ++q) Bf[q] = *(const bf16x8*)(ws + WS_S5B + ((size_t)(dg * 4 + q) * 64 + lane) * 16);
    const f32x4 lm = *(const f32x4*)((const float*)(ws + WS_LAM) + (dg * 64 + 2 * (lane & 31)) * 2);
    const int i = lane & 31, hhA = (i >> 2) & 1, ti = (i & 3) + 4 * (i >> 3), h = lane >> 5;
    float x[4] = {0.f, 0.f, 0.f, 0.f};
    const f32x16 z = {0.f, 0.f, 0.f, 0.f, 0.f, 0.f, 0.f, 0.f, 0.f, 0.f, 0.f, 0.f, 0.f, 0.f, 0.f, 0.f};
    bf16x8 an = *(const bf16x8*)(U + (size_t)s5_row(b, dir, (2 * w + hhA) * S5_CH + ti) * 512 + g * 16 + 8 * h);
#pragma unroll 1
    for (int step = 0; step < S5_NST; ++step) {
        const bf16x8 a = an;
        if (step + 1 < S5_NST) an = *(const bf16x8*)(U + (size_t)s5_row(b, dir, (2 * w + hhA) * S5_CH + (step + 1) * 16 + ti) * 512 + g * 16 + 8 * h);
        f32x16 D0 = __builtin_amdgcn_mfma_f32_32x32x16_bf16(a, Bf[0], z, 0, 0, 0), D1 = __builtin_amdgcn_mfma_f32_32x32x16_bf16(a, Bf[1], z, 0, 0, 0);
        f32x16 D2 = __builtin_amdgcn_mfma_f32_32x32x16_bf16(a, Bf[2], z, 0, 0, 0), D3 = __builtin_amdgcn_mfma_f32_32x32x16_bf16(a, Bf[3], z, 0, 0, 0);
        S5_SCAN16(D0, D1, D2, D3);
    }
    float* S = (float*)(ws + WS_SEND) + ((size_t)chain * S5_NCH + 2 * w + h) * 128 + 4 * (lane & 31);
    *(f32x4*)S = (f32x4){x[0], x[1], x[2], x[3]};
}
static_assert(S5_NCH % 6 == 0, "pass 2 batches");
__device__ __forceinline__ void s5_pass2(unsigned char* ws, int gid) {
    const int chain = gid >> 6, p = gid & 63, dg = chain & 63;
    const float lr = ((const float*)(ws + WS_LAMP))[(dg * 64 + p) * 2], li = ((const float*)(ws + WS_LAMP))[(dg * 64 + p) * 2 + 1];
    const float* S = (const float*)(ws + WS_SEND) + (size_t)chain * S5_NCH * 128 + 2 * p; float* H = (float*)(ws + WS_HIN) + (size_t)chain * S5_NCH * 128 + 2 * p;
    float xr = 0.f, xi = 0.f;
#pragma unroll 1
    for (int q0 = 0; q0 < S5_NCH; q0 += 6) {
        float sr[6], si[6];
#pragma unroll
        for (int e = 0; e < 6; ++e) { sr[e] = S[(q0 + e) * 128]; si[e] = S[(q0 + e) * 128 + 1]; }
#pragma unroll
        for (int e = 0; e < 6; ++e) { H[(q0 + e) * 128] = xr; H[(q0 + e) * 128 + 1] = xi;
            const float nr = fmaf(lr, xr, fmaf(-li, xi, sr[e])), ni = fmaf(lr, xi, fmaf(li, xr, si[e])); xr = nr; xi = ni; }
    }
}
__device__ __forceinline__ void s5_pass3(const Args& args, unsigned char* ws, LAS unsigned char* xt  , int task, int lane) {
    const int w = task & 63, g = (task >> 6) & 31, b = task >> 11;
    const bf16* U = (const bf16*)(ws + WS_U); bf16* Ao = (bf16*)(ws + WS_H);
    const int i = lane & 31, hhA = (i >> 2) & 1, ti = (i & 3) + 4 * (i >> 3), h = lane >> 5, j = lane & 31, fq = lane >> 4, ch = lane & 15;
    f32x4 yacc[S5_NST][2];
    const f32x16 z = {0.f, 0.f, 0.f, 0.f, 0.f, 0.f, 0.f, 0.f, 0.f, 0.f, 0.f, 0.f, 0.f, 0.f, 0.f, 0.f};
#pragma unroll
    for (int dir = 0; dir < 2; ++dir) {
        const int dg = dir * 32 + g, chain = (b * 2 + dir) * 32 + g;
        bf16x8 Bf[4], Cf[4];
#pragma unroll
        for (int q = 0; q < 4; ++q) { Bf[q] = *(const bf16x8*)(ws + WS_S5B + ((size_t)(dg * 4 + q) * 64 + lane) * 16); Cf[q] = *(const bf16x8*)(ws + WS_S5C + ((size_t)(dg * 4 + q) * 64 + lane) * 16); }
        const f32x4 lm = *(const f32x4*)((const float*)(ws + WS_LAM) + (dg * 64 + 2 * j) * 2);
        const int cl = 2 * w + h, qc = dir ? (S5_NCC + S5_NLAT - 1 - cl) : (cl + S5_NCC);
        const f32x4 x0 = *(const f32x4*)((const float*)(ws + WS_HIN) + ((size_t)chain * S5_NCH + qc) * 128 + 4 * j);
        float x[4] = {x0[0], x0[1], x0[2], x0[3]};
        bf16x8 an = *(const bf16x8*)(U + ((size_t)b * SEQ + (2 * w + hhA) * S5_CH + (dir ? S5_CH - 1 - ti : ti)) * 512 + g * 16 + 8 * h);
#pragma unroll
        for (int step = 0; step < S5_NST; ++step) {
            const bf16x8 a = an;
            if (step + 1 < S5_NST) { const int n = (step + 1) * 16 + ti, t = (2 * w + hhA) * S5_CH + (dir ? S5_CH - 1 - n : n); an = *(const bf16x8*)(U + ((size_t)b * SEQ + t) * 512 + g * 16 + 8 * h); }
            {   f32x16 D0 = __builtin_amdgcn_mfma_f32_32x32x16_bf16(a, Bf[0], z, 0, 0, 0), D1 = __builtin_amdgcn_mfma_f32_32x32x16_bf16(a, Bf[1], z, 0, 0, 0);
                S5_SCAN16_ONE(D0, D1, lm[0], lm[1], x[0], x[1]);
#pragma unroll
                for (int r = 0; r < 16; ++r) *(LAS unsigned*)(xt + (h * 16 + r) * 272 + 8 * j) = pg8::cvt_pk_bf16(D0[r], D1[r]); }
            {   f32x16 D2 = __builtin_amdgcn_mfma_f32_32x32x16_bf16(a, Bf[2], z, 0, 0, 0), D3 = __builtin_amdgcn_mfma_f32_32x32x16_bf16(a, Bf[3], z, 0, 0, 0);
                S5_SCAN16_ONE(D2, D3, lm[2], lm[3], x[2], x[3]);
#pragma unroll
                for (int r = 0; r < 16; ++r) *(LAS unsigned*)(xt + (h * 16 + r) * 272 + 8 * j + 4) = pg8::cvt_pk_bf16(D2[r], D3[r]); }
            asm volatile("s_waitcnt lgkmcnt(0)" ::: "memory");
            const int rs = dir ? 15 - ch : ch;
#pragma unroll
            for (int hr = 0; hr < 2; ++hr) {
                f32x4 acc = {0.f, 0.f, 0.f, 0.f};
#pragma unroll
                for (int ks = 0; ks < 4; ++ks) { const bf16x8 af = *(const LAS bf16x8*)(xt + (hr * 16 + rs) * 272 + ks * 64 + 16 * fq);
                    acc = __builtin_amdgcn_mfma_f32_16x16x32_bf16(af, Cf[ks], acc, 0, 0, 0); }
                if (dir == 0) yacc[step][hr] = acc; else yacc[S5_NST - 1 - step][hr] += acc;
            }
            asm volatile("s_waitcnt lgkmcnt(0)" ::: "memory");
            __builtin_amdgcn_sched_barrier(0);
        }
    }
    const float dsk = args.in[I_SD][g * 16 + ch];
#pragma unroll
    for (int s = 0; s < S5_NST; ++s)
#pragma unroll
        for (int hr = 0; hr < 2; ++hr)
#pragma unroll
            for (int e = 0; e < 4; ++e) { const size_t o = ((size_t)b * SEQ + (2 * w + hr) * S5_CH + 16 * s + 4 * fq + e) * 512 + g * 16 + ch;
                Ao[o] = (bf16)f2bf(gelu_tanh(yacc[s][hr][e] + bf2f(U[o]) * dsk)); }
}
__device__ __forceinline__ int block_incl_scan(int v, int* scr, int lane, int wave, int& total) {
    int x = v;
#pragma unroll
    for (int o = 1; o < 64; o <<= 1) { const int y = __shfl_up(x, o); if (lane >= o) x += y; }
    if (lane == 63) scr[wave] = x;
    __syncthreads();
    int base = 0, tot = 0;
#pragma unroll
    for (int w = 0; w < 8; ++w) { const int s = scr[w]; if (w < wave) base += s; tot += s; }
    __syncthreads();
    total = tot; return x + base;
}
__device__ __forceinline__ void topk_select(unsigned char* ws, unsigned char* lds_g, int be, int tid, int lane, int wave) {
    unsigned* vals = (unsigned*)lds_g; int* hist = (int*)(lds_g + 32768); int* scr = (int*)(lds_g + 49152);
    const int b = be >> 4, e = be & 15;
    const float* AFF = (const float*)(ws + WS_AFF); int* IDX = (int*)(ws + WS_IDX); float* GSEL = (float*)(ws + WS_GSEL); int* SLOT = (int*)(ws + WS_SLOT);
    for (int i = tid; i < 8192; i += 512) vals[i] = __float_as_uint(AFF[((size_t)b * SEQ + i) * 16 + e]);
    __syncthreads();
    unsigned long long prefix = 0ull; int krem = 1024;
#pragma unroll
    for (int pass = 0; pass < 4; ++pass) {
        const int wdt = pass == 3 ? 12 : 11, shift = pass == 0 ? 34 : (pass == 1 ? 23 : (pass == 2 ? 12 : 0)), nb = 1 << wdt, B = nb / 512;
        for (int i = tid; i < nb; i += 512) hist[i] = 0;
        __syncthreads();
        for (int k = 0; k < 16; ++k) { const int i = tid + 512 * k; const unsigned long long key = ((unsigned long long)vals[i] << 13) | (unsigned)(8191 - i);
            if ((key >> (shift + wdt)) == prefix) atomicAdd(&hist[(int)(key >> shift) & (nb - 1)], 1); }
        __syncthreads();
        int cnt = 0;
        for (int d = 0; d < B; ++d) cnt += hist[tid * B + d];
        int total; const int incl = block_incl_scan(cnt, scr, lane, wave, total);
        int running = total - incl;
        for (int d = tid * B + B - 1; d >= tid * B; --d) { const int hh = hist[d]; if (running < krem && running + hh >= krem) { scr[16] = d; scr[17] = krem - running; } running += hh; }
        __syncthreads();
        const int dstar = scr[16]; krem = scr[17]; prefix = (prefix << wdt) | (unsigned long long)dstar;
        __syncthreads();
    }
    int cnt = 0;
    for (int k = 0; k < 16; ++k) { const int i = tid + 512 * k; const unsigned long long key = ((unsigned long long)vals[i] << 13) | (unsigned)(8191 - i); cnt += key >= prefix ? 1 : 0; }
    int total; int slot = block_incl_scan(cnt, scr, lane, wave, total) - cnt;
    for (int k = 0; k < 16; ++k) { const int i = tid + 512 * k; const unsigned long long key = ((unsigned long long)vals[i] << 13) | (unsigned)(8191 - i);
        if (key >= prefix) { if (slot < 1024) { IDX[be * 1024 + slot] = i; GSEL[be * 1024 + slot] = __uint_as_float(vals[i]); SLOT[be * 8192 + i] = slot; } else SLOT[be * 8192 + i] = -1; ++slot; }
        else SLOT[be * 8192 + i] = -1; }
    __syncthreads();
}
typedef short s16x4 __attribute__((ext_vector_type(4)));
constexpr int AT_ROW = 144;
constexpr int AT_KC = 0, AT_VC = 256 * AT_ROW, AT_RING = 2 * 256 * AT_ROW, AT_RBUF = 2 * 64 * AT_ROW, AT_BIAS = 132096;
static_assert(AT_RING + 3 * AT_RBUF <= RING_BYTES && AT_BIAS >= MISC_OFF + 128 && AT_BIAS + (512 + 640) * 4 <= LDS_BYTES, "attention LDS map");
constexpr float LOG2E = 1.4426950408889634f;

template <int MODE> __device__ __forceinline__ void attn_tile32(const LAS unsigned char* K32, const LAS unsigned char* V32, const bf16x8 q0, const bf16x8 q1, f32x4 (&O)[4], float& lsum,
                                                              int lane, const LAS float* brow, int kc0, int q_cs, float shiftl) {
    const int r16 = lane & 15, fq = lane >> 4;
    f32x4 st[2];
#pragma unroll
    for (int tt = 0; tt < 2; ++tt) {
        const LAS unsigned char* kp = K32 + (16 * tt + r16) * AT_ROW + 16 * fq;
        const bf16x8 k0 = *(const LAS bf16x8*)kp, k1 = *(const LAS bf16x8*)(kp + 64);
        f32x4 c0;
        if (MODE == 0) c0 = (f32x4){shiftl, shiftl, shiftl, shiftl};
        else { const LAS float* bp = brow + 16 * tt + 4 * fq; c0 = (f32x4){bp[0], bp[1], bp[2], bp[3]}; }
        st[tt] = __builtin_amdgcn_mfma_f32_16x16x32_bf16(k0, q0, c0, 0, 0, 0);
        st[tt] = __builtin_amdgcn_mfma_f32_16x16x32_bf16(k1, q1, st[tt], 0, 0, 0);
    }
    float p[2][4];
#pragma unroll
    for (int tt = 0; tt < 2; ++tt)
#pragma unroll
        for (int e = 0; e < 4; ++e) {
            float v = __builtin_amdgcn_exp2f(st[tt][e]);
            if (MODE == 2) { const int kc = kc0 + 16 * tt + 4 * fq + e; v = (kc >= q_cs && kc < q_cs + 16) ? v : 0.f; }
            p[tt][e] = v; lsum += v;
        }
    bf16x8 Pf; { pg8::u32x4 w; w.x = pg8::cvt_pk_bf16(p[0][0], p[0][1]); w.y = pg8::cvt_pk_bf16(p[0][2], p[0][3]); w.z = pg8::cvt_pk_bf16(p[1][0], p[1][1]); w.w = pg8::cvt_pk_bf16(p[1][2], p[1][3]); Pf = __builtin_bit_cast(bf16x8, w); }
    const LAS unsigned char* vp = V32 + (4 * fq + (r16 >> 2)) * AT_ROW + 8 * (r16 & 3);
#pragma unroll
    for (int dt = 0; dt < 4; ++dt) {
        const s16x4 lo = __builtin_amdgcn_ds_read_tr16_b64_v4i16((LAS s16x4*)(vp + 32 * dt)), hi = __builtin_amdgcn_ds_read_tr16_b64_v4i16((LAS s16x4*)(vp + 32 * dt + 16 * AT_ROW));
        const bf16x8 Vf = __builtin_shufflevector(lo, hi, 0, 1, 2, 3, 4, 5, 6, 7);
        O[dt] = __builtin_amdgcn_mfma_f32_16x16x32_bf16(Vf, Pf, O[dt], 0, 0, 0);
    }
}

__device__ __forceinline__ void attn_unit(const Args& args, unsigned char* ws, LAS unsigned char* lds, int unit, int tid, int lane, int wave, int mode  ) {
    const int b = unit >> 7, head = (unit >> 4) & 7, r0 = (unit & 15) * 8, r = r0 + wave;
    const bf16* Q = (const bf16*)(ws + WS_Q); const bf16* Kg = (const bf16*)(ws + WS_K); const bf16* Vg = (const bf16*)(ws + WS_V); bf16* YB = (bf16*)(ws + WS_YAB) + 512;
    const int r16 = lane & 15, fq = lane >> 4;
    float mq = fabsf(args.in[I_QN][lane]), mk = fabsf(args.in[I_KN][lane]);
#pragma unroll
    for (int o = 1; o < 64; o <<= 1) { mq = fmaxf(mq, __shfl_xor(mq, o)); mk = fmaxf(mk, __shfl_xor(mk, o)); }
    const float shiftl = -8.f * mq * mk * LOG2E;
    __syncthreads();
    {
        const bf16* kc = Kg + ((size_t)MLAT + b * NCTX) * 512 + head * 64; const bf16* vc = Vg + ((size_t)MLAT + b * NCTX) * 512 + head * 64;
#pragma unroll
        for (int i = 0; i < 4; ++i) { const int idx = tid + 512 * i, row = idx >> 3, c = idx & 7;
            const v4u kv = *(const v4u*)(kc + (size_t)row * 512 + c * 8), vv = *(const v4u*)(vc + (size_t)row * 512 + c * 8);
            *(LAS v4u*)(lds + AT_KC + row * AT_ROW + c * 16) = kv; *(LAS v4u*)(lds + AT_VC + row * AT_ROW + c * 16) = vv; }
        LAS float* bl = (LAS float*)(lds + AT_BIAS);
        {
            bl[tid] = tid < 465 ? fmaf(args.in[I_RPB][head * 465 + tid], LOG2E, shiftl) : 0.f;
            for (int i = tid; i < 640; i += 512) { const int dr = i / 40, dc = i % 40 - 8; bl[512 + i] = (dr < 15 && dc >= 7 && dc < 23) ? fmaf(args.in[I_RPB][head * 465 + dr * 31 + dc], LOG2E, shiftl) : -30000.f; }
        }
    }
    const int kr_lo = min(max(r0 - 4, 0), 120), kr_hi = min(max(r0 + 3, 0), 120) + 7;
    const int lcol = tid >> 3, lc = tid & 7;
    v4u kv, vv;
    {   const size_t g0 = ((size_t)b * SEQ + kr_lo * 64 + lcol) * 512 + head * 64 + lc * 8;
        const v4u k0 = *(const v4u*)(Kg + g0), v0 = *(const v4u*)(Vg + g0);
        *(LAS v4u*)(lds + AT_RING + lcol * AT_ROW + lc * 16) = k0; *(LAS v4u*)(lds + AT_RING + 64 * AT_ROW + lcol * AT_ROW + lc * 16) = v0;
        kv = *(const v4u*)(Kg + g0 + 64 * 512); vv = *(const v4u*)(Vg + g0 + 64 * 512); }
    bf16x8 Qf[4][2];
#pragma unroll
    for (int j = 0; j < 4; ++j) { const bf16* qp = Q + ((size_t)b * SEQ + r * 64 + 16 * j + r16) * 512 + head * 64 + 8 * fq; Qf[j][0] = *(const bf16x8*)qp; Qf[j][1] = *(const bf16x8*)(qp + 32); }
    f32x4 O[4][4]; float lsum[4];
#pragma unroll
    for (int j = 0; j < 4; ++j) { lsum[j] = 0.f;
#pragma unroll
        for (int dt = 0; dt < 4; ++dt) O[j][dt] = (f32x4){0.f, 0.f, 0.f, 0.f}; }
    __syncthreads();
#pragma unroll 1
    for (int grp = 0; grp < ((mode & 1) ? 8 : 0); ++grp) {
#pragma unroll
        for (int j = 0; j < 4; ++j) attn_tile32<0>(lds + AT_KC + 32 * grp * AT_ROW, lds + AT_VC + 32 * grp * AT_ROW, Qf[j][0], Qf[j][1], O[j], lsum[j], lane, nullptr, 0, 0, shiftl);
    }
    const int rs = min(max(r - 4, 0), 120);
    int buf = 0;
#pragma unroll 1
    for (int kr = kr_lo; kr <= ((mode & 2) ? kr_hi : kr_lo - 1); ++kr) {
        if (kr + 1 <= kr_hi) { const int nbuf = buf == 2 ? 0 : buf + 1; LAS unsigned char* nb = lds + AT_RING + nbuf * AT_RBUF;
            *(LAS v4u*)(nb + lcol * AT_ROW + lc * 16) = kv; *(LAS v4u*)(nb + 64 * AT_ROW + lcol * AT_ROW + lc * 16) = vv; }
        if (kr + 2 <= kr_hi) { const size_t g0 = ((size_t)b * SEQ + (kr + 2) * 64 + lcol) * 512 + head * 64 + lc * 8; kv = *(const v4u*)(Kg + g0); vv = *(const v4u*)(Vg + g0); }
        if (kr >= rs && kr < rs + 8 && (mode & 4)) {
            const LAS unsigned char* kb = lds + AT_RING + buf * AT_RBUF; const LAS unsigned char* vb = kb + 64 * AT_ROW;
            const LAS float* bl = (const LAS float*)(lds + AT_BIAS) + (kr - r + 7) * 31 + 15; const LAS float* bl1 = (const LAS float*)(lds + AT_BIAS) + 512 + (kr - r + 7) * 40 + 8 + 15;
#pragma unroll
            for (int j = 0; j < 4; ++j) { const int cs = j == 0 ? 0 : (j == 3 ? 32 : 16 * j - 8), qc = 16 * j + r16, q_cs = min(max(qc - 8, 0), 48);
                if (j == 0 || j == 3) attn_tile32<2>(kb + cs * AT_ROW, vb + cs * AT_ROW, Qf[j][0], Qf[j][1], O[j], lsum[j], lane, bl + cs - qc, cs, q_cs, shiftl);
                else attn_tile32<1>(kb + cs * AT_ROW, vb + cs * AT_ROW, Qf[j][0], Qf[j][1], O[j], lsum[j], lane, bl1 + cs - qc, cs, q_cs, shiftl); }
        }
        __syncthreads();
        buf = buf == 2 ? 0 : buf + 1;
    }
#pragma unroll
    for (int j = 0; j < 4; ++j) {
        float l = lsum[j]; l += __shfl_xor(l, 16); l += __shfl_xor(l, 32);
        const float inv = 1.f / l;
        bf16* op = YB + ((size_t)b * SEQ + r * 64 + 16 * j + r16) * 1024 + head * 64 + 4 * fq;
#pragma unroll
        for (int dt = 0; dt < 4; ++dt) { pg8::u32x2 w; w.x = pg8::cvt_pk_bf16(O[j][dt][0] * inv, O[j][dt][1] * inv); w.y = pg8::cvt_pk_bf16(O[j][dt][2] * inv, O[j][dt][3] * inv); *(pg8::u32x2*)(op + 16 * dt) = w; }
    }
}
__global__ void __launch_bounds__(NWAVES * 64, 2) mega(Args args) {
    extern __shared__ __attribute__((aligned(16))) unsigned char lds_raw[];
    LAS unsigned char* lds = (LAS unsigned char*)lds_raw;
    volatile LAS unsigned* MISC = (volatile LAS unsigned*)(lds + MISC_OFF);
    const int tid = threadIdx.x, lane = tid & 63, wave = __builtin_amdgcn_readfirstlane(tid >> 6);
    const int G = gridDim.x; const int bx = blockIdx.x; const int vcu = (G % 8 == 0) ? (bx % 8) * (G / 8) + bx / 8 : bx;
    const int gw = vcu * NWAVES + wave, NGW = G * NWAVES;
    unsigned char* ws = args.ws;
    gu32* ctl = (gu32*)(ws + WS_CTL);
    for (int u = tid; u < (LDS_BYTES - LDSCTL_OFF) / 4; u += NWAVES * 64) ((LAS unsigned*)(lds + LDSCTL_OFF))[u] = 0u;
    __syncthreads();
    XcdBarrier bar = xcd_barrier_post((unsigned*)(ctl + CW_BAR) + args.li * XCD_BAR_WORDS, MISC + 8);
    const int lo = args.ph_lo, hi = args.ph_hi;
#define IN(k) (lo <= (k) && (k) < hi)
#define BOTH(k) (IN(k) && IN((k) + 1))
#if defined(TIME_MASK)
    unsigned long long tacc_ = 0ull, tbeg_ = 0ull;
#define TBEG(k) do { if ((TIME_MASK >> (k)) & 1) tbeg_ = __builtin_amdgcn_s_memrealtime(); } while (0)
#define TEND(k) do { if ((TIME_MASK >> (k)) & 1) tacc_ += __builtin_amdgcn_s_memrealtime() - tbeg_; } while (0)
#else
#define TBEG(k) do {} while (0)
#define TEND(k) do {} while (0)
#endif
    float* mod = (float*)(ws + WS_MOD);
    bf16* Hb = (bf16*)(ws + WS_H);

    TBEG(0);
    if (IN(0)) for (int rep_ = 0; rep_ <= ((PROBE_MASK >> 0) & 1) * PROBE_REPS; ++rep_) {
        const float* c = args.in[I_C]; const float* cctx = args.in[I_CCTX]; const float* w_ada = args.in[I_WADA]; const float* b_ada = args.in[I_BADA];
        if (args.li == 0) for (int it = gw; it < 24 * 16; it += NGW) {
            const int cc = it % 24, ks = it / 24, col = cc * 256 + lane * 4;
            f32x4 a0 = {0.f, 0.f, 0.f, 0.f}, a1 = a0, a2 = a0;
#pragma unroll 1
            for (int k0 = ks * 64; k0 < ks * 64 + 64; k0 += 16) {
                f32x4 w[16];
#pragma unroll
                for (int i = 0; i < 16; ++i) w[i] = *(const f32x4*)(w_ada + (size_t)(k0 + i) * 6144 + col);
#pragma unroll
                for (int i = 0; i < 16; ++i) { const float s0 = silu_f(c[k0 + i]), s1 = silu_f(c[1024 + k0 + i]), s2 = silu_f(cctx[k0 + i]); a0 += w[i] * s0; a1 += w[i] * s1; a2 += w[i] * s2; }
            }
            if (ks == 0) { const f32x4 bb = *(const f32x4*)(b_ada + col); a0 += bb; a1 += bb; a2 += bb; }
#pragma unroll
            for (int i = 0; i < 4; ++i) { atomicAdd(mod + col + i, a0[i]); atomicAdd(mod + 6144 + col + i, a1[i]); atomicAdd(mod + 2 * 6144 + col + i, a2[i]); }
        }
        LAS float* scr = (LAS float*)(lds + RING_OFF + wave * 16384);
        constexpr int I_IN = 16 * 128, I_GLU = 8 * 16, I_PA = 8 * 32, I_OUT = 16 * 32, NIT = I_IN + I_GLU + 2 * I_PA + I_OUT;
        for (int it = gw; it < NIT; it += NGW) {
            int r = it;
            if (r < I_IN) { transpose_item<1>(args.in[I_WIN], 1024, 4096, (bf16*)(ws + WS_WIN), 1024, scr, r, lane); continue; } r -= I_IN;
            if (r < I_GLU) { transpose_item<0>(args.in[I_WGLU], 512, 512, (bf16*)(ws + WS_WGLU), 512, scr, r, lane); continue; } r -= I_GLU;
            if (r < I_PA) { transpose_item<0>(args.in[I_WPA], 512, 1024, (bf16*)(ws + WS_WPA), 1024, scr, r, lane); continue; } r -= I_PA;
            if (r < I_PA) { transpose_item<0>(args.in[I_WPB], 512, 1024, (bf16*)(ws + WS_WPA) + 512, 1024, scr, r, lane); continue; } r -= I_PA;
            transpose_item<0>(args.in[I_WOUT], 1024, 1024, (bf16*)(ws + WS_WOUT), 1024, scr, r, lane);
        }
        for (int dg = gw; dg < 64; dg += NGW) s5_prep(args, ws, dg, lane);
        if (BOTH(0)) xcd_barrier(bar);
    }
    TEND(0);
    TBEG(1);
    if (IN(1)) for (int rep_ = 0; rep_ <= ((PROBE_MASK >> 1) & 1) * PROBE_REPS; ++rep_) {
        const float* x = args.in[I_X]; const float* ctx = args.in[I_CTX]; const float* gwt = args.in[I_NMIX];
        for (int blk = gw; blk < MLAT / 8 + MCTX / 2; blk += NGW) {
            if (blk < MLAT / 8) norm1_rows(x + (size_t)blk * 8 * D, Hb + (size_t)blk * 8 * D, 8, gwt, mod + ((blk * 8) >> 13) * 6144, lane);
            else { const int r = (blk - MLAT / 8) * 2; norm1_rows(ctx + (size_t)r * D, Hb + (size_t)(MLAT + r) * D, 2, gwt, mod + 2 * 6144, lane); }
        }
        if (BOTH(1)) xcd_barrier(bar);
    }
    TEND(1);
    TBEG(2);
    if (IN(2)) for (int rep_ = 0; rep_ <= ((PROBE_MASK >> 2) & 1) * PROBE_REPS; ++rep_) {
        pg8::Gemm g{Hb, (const bf16*)(ws + WS_WIN), MALL, 4096, 1024};
        pg8::InprojOrder S; S.init(G, bx, true);
        pg8::EpiInproj E{(bf16*)(ws + WS_U), (bf16*)(ws + WS_Q), (bf16*)(ws + WS_K), (bf16*)(ws + WS_V), (bf16*)(ws + WS_SGA), (bf16*)(ws + WS_SGB), args.in[I_QN], args.in[I_KN]};
        pg8::gemm_phase<pg8::EpiInproj, pg8::InprojOrder, true>(lds + RING_OFF, g, S, E);
        {
            const int maxun = (1036 + G - 1) / G, heavy = 1036 - (maxun - 1) * G, light = heavy < G ? G - heavy : G;
            if (light == G || bx >= heavy) {
                LAS float* scr = (LAS float*)(lds + RING_OFF + wave * 16384);
                for (int it = (light == G ? bx : bx - heavy) * NWAVES + wave; it < 16 * 512; it += light * NWAVES)
                    transpose_item<0>(args.in[I_WED] + (size_t)(it >> 9) * 1048576, 1024, 1024, (bf16*)(ws + WS_WD) + (size_t)(it >> 9) * 1048576, 1024, scr, it & 511, lane);
            }
        }
        if (BOTH(2)) xcd_barrier(bar);
    }
    TEND(2);
#if defined(EXTRA_BARRIERS)
    if (IN(3)) for (int xb_ = 0; xb_ < EXTRA_BARRIERS; ++xb_) xcd_barrier(bar);
#endif
    TBEG(3);
    if (IN(3)) for (int rep_ = 0; rep_ <= ((PROBE_MASK >> 3) & 1) * PROBE_REPS; ++rep_) {
        for (int task = gw; task < 128 * S5_NPAIR; task += NGW) s5_pass1(ws, task, lane);
        if (BOTH(3)) xcd_barrier(bar);
    }
    TEND(3);
    TBEG(4);
    if (IN(4)) for (int rep_ = 0; rep_ <= ((PROBE_MASK >> 4) & 1) * PROBE_REPS; ++rep_) {
        { const int gid = gw * 64 + lane; if (gid < 8192 && (PROBE_VARIANT != 0 || rep_ == ((PROBE_MASK >> 4) & 1) * PROBE_REPS)) s5_pass2(ws, gid); }
        for (int unit = bx; unit < 256; unit += G) attn_unit(args, ws, lds + RING_OFF, unit, tid, lane, wave, rep_ < ((PROBE_MASK >> 4) & 1) * PROBE_REPS ? PROBE_VARIANT : 7);
        if (BOTH(4)) xcd_barrier(bar);
    }
    TEND(4);
    TBEG(5);
    if (IN(5)) for (int rep_ = 0; rep_ <= ((PROBE_MASK >> 5) & 1) * PROBE_REPS; ++rep_) {
        for (int task = gw; task < 4096; task += NGW) s5_pass3(args, ws, lds + RING_OFF + wave * 16384, task, lane);
        if (BOTH(5)) xcd_barrier(bar);
    }
    TEND(5);
    TBEG(6);
    if (IN(6)) for (int rep_ = 0; rep_ <= ((PROBE_MASK >> 6) & 1) * PROBE_REPS; ++rep_) {
        pg8::Gemm g{(const bf16*)(ws + WS_H), (const bf16*)(ws + WS_WGLU), MLAT, 512, 512};
        pg8::StaticOrder S; S.init(MLAT, 512, G, bx);
        pg8::EpiGlu E{(const bf16*)(ws + WS_H), args.in[I_BGLU], (bf16*)(ws + WS_YAB), 1024};
        pg8::gemm_phase<pg8::EpiGlu, pg8::StaticOrder, true>(lds + RING_OFF, g, S, E);
        if (BOTH(6)) xcd_barrier(bar);
    }
    TEND(6);
    TBEG(7);
    if (IN(7)) for (int rep_ = 0; rep_ <= ((PROBE_MASK >> 7) & 1) * PROBE_REPS; ++rep_) {
        pg8::Gemm g{(const bf16*)(ws + WS_YAB), (const bf16*)(ws + WS_WPA), MLAT, 1024, 1024};
        pg8::StaticOrder S; S.init(MLAT, 1024, G, bx);
        pg8::EpiMerge E{(const bf16*)(ws + WS_SGA), (const bf16*)(ws + WS_SGB), (bf16*)(ws + WS_M)};
        pg8::gemm_phase<pg8::EpiMerge, pg8::StaticOrder, true>(lds + RING_OFF, g, S, E);
        if (BOTH(7)) xcd_barrier(bar);
    }
    TEND(7);
    TBEG(8);
    if (IN(8)) for (int rep_ = 0; rep_ <= ((PROBE_MASK >> 8) & 1) * PROBE_REPS; ++rep_) {
        pg8::Gemm g{(const bf16*)(ws + WS_M), (const bf16*)(ws + WS_WOUT), MLAT, 1024, 1024};
        pg8::StaticOrder S; S.init(MLAT, 1024, G, bx);
        pg8::EpiOut E{args.in[I_X], mod, args.out};
        pg8::gemm_phase<pg8::EpiOut, pg8::StaticOrder, true>(lds + RING_OFF, g, S, E);
        if (BOTH(8)) xcd_barrier(bar);
    }
    TEND(8);
    TBEG(9);
    if (IN(9)) for (int rep_ = 0; rep_ <= ((PROBE_MASK >> 9) & 1) * PROBE_REPS; ++rep_) {
        const float* gwt = args.in[I_NFFN]; const float* w_router = args.in[I_WR]; float* AFF = (float*)(ws + WS_AFF);
        __syncthreads();
#pragma unroll
        for (int k = 0; k < 8; ++k) { const int idx4 = tid + 512 * k, c = idx4 >> 2, e4 = idx4 & 3;
            *(LAS f32x4*)(lds + RING_OFF + (((c >> 8) * 4 + (c & 3)) * 64 + ((c & 255) >> 2)) * 80 + e4 * 16) = *(const f32x4*)(w_router + (size_t)c * 16 + e4 * 4); }
        __syncthreads();
        for (int blk = gw; blk < MLAT / 8; blk += NGW) {
            const int row0 = blk * 8; const float* md = mod + (row0 >> 13) * 6144;
            f32x4 ca[4], cb[4];
#pragma unroll
            for (int j = 0; j < 4; ++j) { const int col = j * 256 + lane * 4; ca[j] = *(const f32x4*)(gwt + col) * (*(const f32x4*)(md + 4096 + col) + 1.f); cb[j] = *(const f32x4*)(md + 3072 + col); }
#pragma unroll 1
            for (int rr = 0; rr < 8; rr += 2) {
                const int rowa = row0 + rr, rowb = rowa + 1;
                const float* sa = args.out + (size_t)rowa * D; const float* sb = sa + D;
                f32x4 va[4], vb[4]; float ssa = 0.f, ssb = 0.f;
#pragma unroll
                for (int j = 0; j < 4; ++j) { va[j] = *(const f32x4*)(sa + j * 256 + lane * 4); vb[j] = *(const f32x4*)(sb + j * 256 + lane * 4); }
#pragma unroll
                for (int j = 0; j < 4; ++j) { ssa += (va[j][0] * va[j][0] + va[j][1] * va[j][1]) + (va[j][2] * va[j][2] + va[j][3] * va[j][3]); ssb += (vb[j][0] * vb[j][0] + vb[j][1] * vb[j][1]) + (vb[j][2] * vb[j][2] + vb[j][3] * vb[j][3]); }
                const float ra = rsqrtf(wave_sum(ssa) * (1.f / D) + EPS), rb = rsqrtf(wave_sum(ssb) * (1.f / D) + EPS);
                float la[16], lb[16];
#pragma unroll
                for (int e = 0; e < 16; ++e) { la[e] = 0.f; lb[e] = 0.f; }
#pragma unroll
                for (int j = 0; j < 4; ++j) {
                    const int col = j * 256 + lane * 4;
                    const f32x4 oa = va[j] * ra * ca[j] + cb[j], ob = vb[j] * rb * ca[j] + cb[j];
                    pg8::u32x2 w; w.x = pk2(oa[0], oa[1]); w.y = pk2(oa[2], oa[3]); *(pg8::u32x2*)(Hb + (size_t)rowa * D + col) = w;
                    w.x = pk2(ob[0], ob[1]); w.y = pk2(ob[2], ob[3]); *(pg8::u32x2*)(Hb + (size_t)rowb * D + col) = w;
#pragma unroll
                    for (int i = 0; i < 4; ++i) {
                        const LAS f32x4* wr = (const LAS f32x4*)(lds + RING_OFF + ((j * 4 + i) * 64 + lane) * 80);
#pragma unroll
                        for (int e4 = 0; e4 < 4; ++e4) { const f32x4 wv = wr[e4];
#pragma unroll
                            for (int e = 0; e < 4; ++e) { la[e4 * 4 + e] = fmaf(oa[i], wv[e], la[e4 * 4 + e]); lb[e4 * 4 + e] = fmaf(ob[i], wv[e], lb[e4 * 4 + e]); } }
                        __builtin_amdgcn_sched_barrier(0);
                    }
                }
#define FOLD_STEP(arr, n, mask) do { const bool hi_ = (lane & (mask)) != 0; _Pragma("unroll") for (int k_ = 0; k_ < (n); ++k_) { \
            const float send_ = hi_ ? arr[k_] : arr[(n) + k_], keep_ = hi_ ? arr[(n) + k_] : arr[k_]; arr[k_] = keep_ + __shfl_xor(send_, (mask)); } } while (0)
                FOLD_STEP(la, 8, 32); FOLD_STEP(lb, 8, 32); FOLD_STEP(la, 4, 16); FOLD_STEP(lb, 4, 16); FOLD_STEP(la, 2, 8); FOLD_STEP(lb, 2, 8); FOLD_STEP(la, 1, 4); FOLD_STEP(lb, 1, 4);
#undef FOLD_STEP
                float xa = la[0], xb = lb[0];
                xa += __shfl_xor(xa, 2); xb += __shfl_xor(xb, 2); xa += __shfl_xor(xa, 1); xb += __shfl_xor(xb, 1);
                float ma = xa, mb = xb;
#pragma unroll
                for (int o = 4; o < 64; o <<= 1) { ma = fmaxf(ma, __shfl_xor(ma, o)); mb = fmaxf(mb, __shfl_xor(mb, o)); }
                const float ea = expf(xa - ma), eb = expf(xb - mb); float sua = ea, sub = eb;
#pragma unroll
                for (int o = 4; o < 64; o <<= 1) { sua += __shfl_xor(sua, o); sub += __shfl_xor(sub, o); }
                if ((lane & 3) == 0) { const int e = ((lane >> 5) & 1) * 8 + ((lane >> 4) & 1) * 4 + ((lane >> 3) & 1) * 2 + ((lane >> 2) & 1);
                    AFF[(size_t)rowa * 16 + e] = ea / sua; AFF[(size_t)rowb * 16 + e] = eb / sub; }
            }
        }
        if (BOTH(9)) xcd_barrier(bar);
    }
    TEND(9);
    TBEG(10);
    if (IN(10)) for (int rep_ = 0; rep_ <= ((PROBE_MASK >> 10) & 1) * PROBE_REPS; ++rep_) {
        const bool split = G >= 64;
        if (!split || bx >= 32) {
            const int w2 = split ? (bx - 32) * NWAVES + wave : bx * NWAVES + wave, NW2 = (split ? G - 32 : G) * NWAVES;
            LAS float* scr = (LAS float*)(lds + RING_OFF + wave * 16384);
            auto mk = [&](int it) { const int e = it >> 10, which = (it >> 9) & 1; return TItem{(which ? args.in[I_WEU] : args.in[I_WEG]) + (size_t)e * 1048576, (bf16*)(ws + WS_WGU) + (size_t)e * 2097152, 1024, 1024, it & 511}; };
            int it = w2; f32x4 lda[8], ldb[8];
            if (it < 16 * 2 * 512) titem_load(mk(it), lda, lane);
            while (it < 16 * 2 * 512) {
                const int itn = it + NW2, it2 = itn + NW2;
                if (itn < 16 * 2 * 512) titem_load(mk(itn), ldb, lane);
                if ((it >> 9) & 1) titem_finish<3>(mk(it), lda, scr, lane); else titem_finish<2>(mk(it), lda, scr, lane);
                if (itn >= 16 * 2 * 512) break;
                if (it2 < 16 * 2 * 512) titem_load(mk(it2), lda, lane);
                if ((itn >> 9) & 1) titem_finish<3>(mk(itn), ldb, scr, lane); else titem_finish<2>(mk(itn), ldb, scr, lane);
                it = it2;
            }
        }
        if (split) { if (bx < 32) topk_select(ws, lds_raw, bx, tid, lane, wave); }
        else { __syncthreads(); for (int be = bx; be < 32; be += G) topk_select(ws, lds_raw, be, tid, lane, wave); }
        if (BOTH(10)) xcd_barrier(bar);
    }
    TEND(10);
    TBEG(12);
    if (IN(12)) for (int rep_ = 0; rep_ <= ((PROBE_MASK >> 12) & 1) * PROBE_REPS; ++rep_) {
        pg8::Gemm g{Hb, (const bf16*)(ws + WS_WGU), 32768, 2048, 1024};
        pg8::ExpertOrder<8> S; S.init(G, bx);
        pg8::EpiHid E{(bf16*)(ws + WS_HID)};
        pg8::gemm_phase<pg8::EpiHid, pg8::ExpertOrder<8>, true, true, pg8::ExpertGather>(lds + RING_OFF, g, S, E, pg8::ExpertGather{(const int*)(ws + WS_IDX)});
        if (BOTH(12)) xcd_barrier(bar);
    }
    TEND(12);
    TBEG(13);
    if (IN(13)) for (int rep_ = 0; rep_ <= ((PROBE_MASK >> 13) & 1) * PROBE_REPS; ++rep_) {
        pg8::Gemm g{(const bf16*)(ws + WS_HID), (const bf16*)(ws + WS_WD), 32768, 1024, 1024};
        pg8::ExpertOrder<4> S; S.init(G, bx);
        pg8::EpiDown E{(const float*)(ws + WS_GSEL), (bf16*)(ws + WS_XE)};
        pg8::gemm_phase<pg8::EpiDown, pg8::ExpertOrder<4>, true>(lds + RING_OFF, g, S, E);
        if (BOTH(13)) xcd_barrier(bar);
    }
    TEND(13);
    TBEG(14);
    if (IN(14)) for (int rep_ = 0; rep_ <= ((PROBE_MASK >> 14) & 1) * PROBE_REPS; ++rep_) {
        const int* SLOT = (const int*)(ws + WS_SLOT); const bf16* Y = (const bf16*)(ws + WS_XE);
        for (int blk = gw; blk < MLAT / 8; blk += NGW) {
            const int row0 = blk * 8, b = row0 >> 13, t0 = row0 & 8191;
            const int sv0 = SLOT[(b * 16 + (lane & 15)) * 8192 + t0 + (lane >> 4)], sv1 = SLOT[(b * 16 + (lane & 15)) * 8192 + t0 + 4 + (lane >> 4)];
            f32x4 cg[4];
#pragma unroll
            for (int j = 0; j < 4; ++j) cg[j] = *(const f32x4*)(mod + b * 6144 + 5120 + j * 256 + lane * 4);
#pragma unroll 1
            for (int rp = 0; rp < 4; ++rp) {
                const int sv = rp < 2 ? sv0 : sv1, lbase = (rp & 1) * 32;
                unsigned mask = (unsigned)__builtin_amdgcn_readfirstlane((int)(unsigned)(__ballot(sv >= 0) >> lbase));
                float* oa = args.out + (size_t)(row0 + 2 * rp) * D + lane * 4; float* ob = oa + D;
                f32x4 xa[4], xb[4], aa[4], ab[4];
#pragma unroll
                for (int j = 0; j < 4; ++j) { xa[j] = *(const f32x4*)(oa + j * 256); xb[j] = *(const f32x4*)(ob + j * 256); aa[j] = (f32x4){0.f, 0.f, 0.f, 0.f}; ab[j] = aa[j]; }
                for (;;) {
                    const bf16* p[4]; float fa[4], fb[4];
#pragma unroll
                    for (int q = 0; q < 4; ++q) {
                        if (mask) { const int bit = __builtin_ctz(mask); mask &= mask - 1u; const int s = __builtin_amdgcn_readlane(sv, lbase + bit), e = bit & 15;
                            p[q] = Y + ((size_t)(b * 16 + e) * 1024 + s) * D; fa[q] = bit < 16 ? 1.f : 0.f; fb[q] = 1.f - fa[q]; }
                        else { p[q] = Y; fa[q] = 0.f; fb[q] = 0.f; }
                    }
                    pg8::u32x2 w[4][4];
#pragma unroll
                    for (int q = 0; q < 4; ++q)
#pragma unroll
                        for (int j = 0; j < 4; ++j) w[q][j] = *(const pg8::u32x2*)(p[q] + j * 256 + lane * 4);
#pragma unroll
                    for (int q = 0; q < 4; ++q)
#pragma unroll
                        for (int j = 0; j < 4; ++j) { const f32x4 v = {__uint_as_float(w[q][j].x << 16), __uint_as_float(w[q][j].x & 0xffff0000u), __uint_as_float(w[q][j].y << 16), __uint_as_float(w[q][j].y & 0xffff0000u)};
                            aa[j] += v * fa[q]; ab[j] += v * fb[q]; }
                    if (!mask) break;
                }
#pragma unroll
                for (int j = 0; j < 4; ++j) { *(f32x4*)(oa + j * 256) = xa[j] + cg[j] * aa[j]; *(f32x4*)(ob + j * 256) = xb[j] + cg[j] * ab[j]; }
            }
        }
    }
    TEND(14);
#if defined(TIME_MASK)
    if (bx == 0 && tid == 0) { const unsigned long long te_ = __builtin_amdgcn_s_memrealtime(); while (__builtin_amdgcn_s_memrealtime() - te_ < tacc_) __builtin_amdgcn_s_sleep(4); }
#endif
#undef IN
#undef BOTH
}
extern "C" void kernel_launch(void* const* d_in, const int* in_sizes, int n_in, void* d_out, int out_size, void* d_ws, size_t ws_size, hipStream_t stream) {
    static int grid = 0;
    if (grid == 0) {
        if (n_in != 29 || ws_size < WS_END) { fprintf(stderr, "kernel_launch: bad arguments (n_in %d, ws %zu)\n", n_in, ws_size); grid = -1; return; }
        int dev = 0, cus = 0;
        if (hipGetDevice(&dev) != hipSuccess || hipDeviceGetAttribute(&cus, hipDeviceAttributeMultiprocessorCount, dev) != hipSuccess) { grid = -1; return; }
        if (hipFuncSetAttribute((const void*)mega, hipFuncAttributeMaxDynamicSharedMemorySize, LDS_BYTES) != hipSuccess) { fprintf(stderr, "kernel_launch: hipFuncSetAttribute failed\n"); grid = -1; return; }
        (void)hipGetLastError();
        grid = cus;
    }
    if (grid < 0) return;
    float* out = (float*)d_out; unsigned char* ws = (unsigned char*)d_ws;
    (void)hipMemsetAsync(ws + WS_CTL, 0, CTL_ZERO_BYTES, stream);
    Args a{};
    for (int i = 0; i < 29; ++i) a.in[i] = (const float*)d_in[i];
    a.out = out; a.ws = ws;
#if defined(PROBE_LO)
    a.ph_lo = 0; a.ph_hi = PROBE_HI; a.li = 0;
    hipLaunchKernelGGL(mega, dim3(grid), dim3(NWAVES * 64), LDS_BYTES, stream, a);
    a.ph_lo = PROBE_LO; a.ph_hi = PROBE_HI; a.li = 1;
    hipLaunchKernelGGL(mega, dim3(grid), dim3(NWAVES * 64), LDS_BYTES, stream, a);
    a.ph_lo = PROBE_HI; a.ph_hi = 15; a.li = 2;
    hipLaunchKernelGGL(mega, dim3(grid), dim3(NWAVES * 64), LDS_BYTES, stream, a);
#elif defined(PER_PHASE)
    for (int k = 0; k < 15; ++k) { if (k == 11) continue; a.ph_lo = k; a.ph_hi = k + 1; a.li = 0; hipLaunchKernelGGL(mega, dim3(grid), dim3(NWAVES * 64), LDS_BYTES, stream, a); }
#else
    a.ph_lo = 0; a.ph_hi = 15; a.li = 0;
    hipLaunchKernelGGL(mega, dim3(grid), dim3(NWAVES * 64), LDS_BYTES, stream, a);
#endif
}
```

```cpp
#include <hip/hip_runtime.h>
#include <cstdio>
#include <cstdint>
#include <stdint.h>

__device__ __forceinline__ float bf2f(unsigned short v) { return __uint_as_float(((unsigned)v) << 16); }
__device__ __forceinline__ float silu_f(float x) { return x / (1.f + __expf(-x)); }
__device__ __forceinline__ float sigmoid_f(float x) { return 1.f / (1.f + __expf(-x)); }
__device__ __forceinline__ float gelu_tanh(float y) { return 0.5f * y * (1.f + tanhf(0.7978845608028654f * (y + 0.044715f * y * y * y))); }

constexpr int D = 1024, SEQ = 8192, MLAT = 16384, NCTX = 256, MCTX = 512, MALL = MLAT + MCTX;
constexpr float EPS = 1e-6f;
namespace pg8 {
#define PG8_LAS __attribute__((address_space(3)))
typedef unsigned short bf16_t;
typedef short bf16x8 __attribute__((ext_vector_type(8)));
typedef float f32x4 __attribute__((ext_vector_type(4)));
typedef unsigned u32x4 __attribute__((ext_vector_type(4)));
constexpr int BM = 256, BK = 64, HALF = 128, HTB = HALF * BK * 2  , STAGE_BYTES = 8 * HTB, NXCD = 8, WGM = 8;

__host__ __device__ __forceinline__ int lds_byte(int r, int c) { const int st = (r >> 4) * 2 + (c >> 5), rr = r & 15, cc = c & 31, ob = rr * 64 + cc * 2; return st * 1024 + (ob ^ (((ob >> 9) & 1) << 5)); }
__host__ __device__ __forceinline__ void stage_rc(int b, int& R, int& C) { const int st = b / 1024, sb = b % 1024, swz = sb ^ (((sb >> 9) & 1) << 5); R = (st >> 1) * 16 + swz / 64; C = (st & 1) * 32 + (swz % 64) / 2; }
__host__ __device__ __forceinline__ int perm32(int rho) { const int n = rho >> 4, i = rho & 15; return 8 * (i >> 2) + 4 * n + (i & 3); }

struct Unit { int pm, pn; };
struct Gemm { const bf16_t* A; const bf16_t* Bt; int M, N, K; };

struct StaticOrder {
    int nM, nN, nwg, G, c;
    __host__ __device__ void init(int M, int N, int G_, int c_) { nM = M / BM; nN = N / BM; nwg = nM * nN; G = G_; c = c_; }
    __host__ __device__ bool next(int i, Unit& u) const {
        const long L = (long)i * G + c; if (L >= nwg) return false;
        int wgid = (int)L; { const int q = nwg / NXCD, r = nwg % NXCD, xcd = wgid % NXCD, off = wgid / NXCD; wgid = (xcd < r ? xcd * (q + 1) : r * (q + 1) + (xcd - r) * q) + off; }
        const int nig = WGM * nN, gid = wgid / nig, fm = gid * WGM, gsz = (nM - fm) < WGM ? (nM - fm) : WGM;
        u.pm = fm + ((wgid % nig) % gsz); u.pn = (wgid % nig) / gsz; return true;
    }
    __device__ __forceinline__ void a_ready(const Unit&) const {}
    __device__ __forceinline__ void done(const Unit&) const {}
};

__device__ __forceinline__ unsigned cvt_pk_bf16(float lo, float hi) { unsigned r; asm volatile("v_cvt_pk_bf16_f32 %0, %1, %2" : "=v"(r) : "v"(lo), "v"(hi)); return r; }
typedef float f32x2 __attribute__((ext_vector_type(2)));
typedef unsigned u32x2 __attribute__((ext_vector_type(2)));
__device__ __forceinline__ u32x4 pack8(const f32x4 a, const f32x4 b) { u32x4 w; w.x = cvt_pk_bf16(a[0], a[1]); w.y = cvt_pk_bf16(a[2], a[3]); w.z = cvt_pk_bf16(b[0], b[1]); w.w = cvt_pk_bf16(b[2], b[3]); return w; }
__device__ __forceinline__ f32x4 sig4(const f32x4 v) { f32x4 r; r[0] = sigmoid_f(v[0]); r[1] = sigmoid_f(v[1]); r[2] = sigmoid_f(v[2]); r[3] = sigmoid_f(v[3]); return r; }
__device__ __forceinline__ void unpack8(const u32x4 w, f32x4& a, f32x4& b) {
    a[0] = __uint_as_float(w.x << 16); a[1] = __uint_as_float(w.x & 0xffff0000u); a[2] = __uint_as_float(w.y << 16); a[3] = __uint_as_float(w.y & 0xffff0000u);
    b[0] = __uint_as_float(w.z << 16); b[1] = __uint_as_float(w.z & 0xffff0000u); b[2] = __uint_as_float(w.w << 16); b[3] = __uint_as_float(w.w & 0xffff0000u); }

struct OneUnit {
    int pm, pn;
    __device__ bool next(int i, Unit& u) const { u.pm = pm; u.pn = pn; return i == 0; }
    __device__ __forceinline__ void a_ready(const Unit&) const {}
    __device__ __forceinline__ void done(const Unit&) const {}
};
struct InprojOrder {
    StaticOrder so; int G, c; bool with_ctx;
    __device__ void init(int G_, int c_, bool wc_) { so.init(MLAT, 4096, G_, c_); G = G_; c = c_; with_ctx = wc_; }
    __device__ bool next(int i, Unit& u) const {
        const long L = (long)i * G + c; if (L < 1024) return so.next(i, u);
        const int r = (int)(L - 1024); if (r >= 12 || !with_ctx) return false;
        const int j = r % 6; u.pm = 64 + r / 6; u.pn = j < 2 ? j : j + 2; return true;
    }
    __device__ __forceinline__ void a_ready(const Unit&) const {}
    __device__ __forceinline__ void done(const Unit&) const {}
};
struct EpiInproj {
    static constexpr bool PERM = true, AFTER_DRAIN = false, MID = false;
    bf16_t *U, *Q, *K, *V, *SGA, *SGB; const float *qn, *kn;
    __device__ __forceinline__ void operator()(const f32x4 (&acc)[2][2][4][2], const Unit& u, int wr, int wc, int fr, int fq) const {
        const int row0 = u.pm * BM + wr * 64 + fr, pn = u.pn;
        if (pn < 2 || pn == 6 || pn == 7) {
            bf16_t* base = (pn < 2 ? U : V) + (pn & 1) * 256 + wc * 32 + 8 * fq;
#pragma unroll
            for (int ai = 0; ai < 2; ++ai)
#pragma unroll
                for (int m = 0; m < 4; ++m) { bf16_t* rowp = base + (size_t)(row0 + ai * HALF + m * 16) * 512;
#pragma unroll
                    for (int bj = 0; bj < 2; ++bj) *(u32x4*)(rowp + bj * HALF) = pack8(acc[ai][bj][m][0], acc[ai][bj][m][1]); }
        } else if (pn < 6) {
            const bool isq = pn < 4; const float* wn = isq ? qn : kn; const float sc = isq ? 0.125f * 1.4426950408889634f : 1.f;
            bf16_t* base = (isq ? Q : K) + ((pn & 1) * 4 + wc) * 64 + 8 * fq;
            f32x4 wv[2][2];
#pragma unroll
            for (int bj = 0; bj < 2; ++bj)
#pragma unroll
                for (int n = 0; n < 2; ++n) wv[bj][n] = *(const f32x4*)(wn + 32 * bj + 8 * fq + 4 * n);
#pragma unroll
            for (int ai = 0; ai < 2; ++ai)
#pragma unroll
                for (int m = 0; m < 4; ++m) {
                    float ss = 0.f;
#pragma unroll
                    for (int bj = 0; bj < 2; ++bj)
#pragma unroll
                        for (int n = 0; n < 2; ++n) { const f32x4 x = acc[ai][bj][m][n]; ss += (x[0] * x[0] + x[1] * x[1]) + (x[2] * x[2] + x[3] * x[3]); }
                    ss += __shfl_xor(ss, 16); ss += __shfl_xor(ss, 32);
                    const float r = rsqrtf(ss * (1.f / 64.f) + EPS) * sc;
                    bf16_t* rowp = base + (size_t)(row0 + ai * HALF + m * 16) * 512;
#pragma unroll
                    for (int bj = 0; bj < 2; ++bj) *(u32x4*)(rowp + bj * 32) = pack8(acc[ai][bj][m][0] * r * wv[bj][0], acc[ai][bj][m][1] * r * wv[bj][1]);
                }
        } else {
            bf16_t* base = (pn < 12 ? SGA : SGB) + ((pn - 8) & 3) * 256 + wc * 32 + 8 * fq;
#pragma unroll
            for (int ai = 0; ai < 2; ++ai)
#pragma unroll
                for (int m = 0; m < 4; ++m) { bf16_t* rowp = base + (size_t)(row0 + ai * HALF + m * 16) * 1024;
#pragma unroll
                    for (int bj = 0; bj < 2; ++bj) *(u32x4*)(rowp + bj * HALF) = pack8(sig4(acc[ai][bj][m][0]), sig4(acc[ai][bj][m][1])); }
        }
    }
};
struct EpiGlu {
    static constexpr bool PERM = true, AFTER_DRAIN = false, MID = false;
    const bf16_t* Ain; const float* bglu; bf16_t* YA; int ldo;
    __device__ __forceinline__ void operator()(const f32x4 (&acc)[2][2][4][2], const Unit& u, int wr, int wc, int fr, int fq) const {
        const int row0 = u.pm * BM + wr * 64 + fr, col0 = u.pn * BM + wc * 32 + 8 * fq;
        f32x4 bv[2][2];
#pragma unroll
        for (int bj = 0; bj < 2; ++bj)
#pragma unroll
            for (int n = 0; n < 2; ++n) bv[bj][n] = *(const f32x4*)(bglu + col0 + bj * HALF + 4 * n);
#pragma unroll
        for (int ai = 0; ai < 2; ++ai)
#pragma unroll
            for (int m = 0; m < 4; ++m) { const size_t off = (size_t)(row0 + ai * HALF + m * 16) * 512 + col0, offo = (size_t)(row0 + ai * HALF + m * 16) * ldo + col0;
#pragma unroll
                for (int bj = 0; bj < 2; ++bj) { f32x4 a0, a1; unpack8(*(const u32x4*)(Ain + off + bj * HALF), a0, a1);
                    *(u32x4*)(YA + offo + bj * HALF) = pack8(a0 * sig4(acc[ai][bj][m][0] + bv[bj][0]), a1 * sig4(acc[ai][bj][m][1] + bv[bj][1])); } }
    }
};
struct EpiMerge {
    static constexpr bool PERM = true, AFTER_DRAIN = false, MID = true;
    const bf16_t* SGA; const bf16_t* SGB; bf16_t* Mo;
    __device__ __forceinline__ void mid(f32x4 (&acc)[2][2][4][2], const Unit& u, int wr, int wc, int fr, int fq) const {
        int row0_ = u.pm * BM + wr * 64 + fr, col0_ = u.pn * BM + wc * 32 + 8 * fq;
        asm volatile("" : "+v"(row0_), "+v"(col0_));
        const int row0 = row0_, col0 = col0_;
#pragma unroll
        for (int ai = 0; ai < 2; ++ai)
#pragma unroll
            for (int m = 0; m < 4; ++m) { const size_t off = (size_t)(row0 + ai * HALF + m * 16) * 1024 + col0;
#pragma unroll
                for (int bj = 0; bj < 2; ++bj) { f32x4 a0, a1, b0, b1; unpack8(*(const u32x4*)(SGA + off + bj * HALF), a0, a1); unpack8(*(const u32x4*)(SGB + off + bj * HALF), b0, b1);
#pragma unroll
                    for (int e = 0; e < 4; ++e) { acc[ai][bj][m][0][e] *= a0[e] * __builtin_amdgcn_rcpf(b0[e]); acc[ai][bj][m][1][e] *= a1[e] * __builtin_amdgcn_rcpf(b1[e]); } }
                if (m == 3) __builtin_amdgcn_sched_barrier(0); }
    }
    __device__ __forceinline__ void operator()(const f32x4 (&acc)[2][2][4][2], const Unit& u, int wr, int wc, int fr, int fq) const {
        int row0_ = u.pm * BM + wr * 64 + fr, col0_ = u.pn * BM + wc * 32 + 8 * fq;
        asm volatile("" : "+v"(row0_), "+v"(col0_));
        const int row0 = row0_, col0 = col0_;
#pragma unroll
        for (int ai = 0; ai < 2; ++ai)
#pragma unroll
            for (int m = 0; m < 4; ++m) { const size_t off = (size_t)(row0 + ai * HALF + m * 16) * 1024 + col0;
#pragma unroll
                for (int bj = 0; bj < 2; ++bj) { f32x4 b0, b1; unpack8(*(const u32x4*)(SGB + off + bj * HALF), b0, b1);
                    *(u32x4*)(Mo + off + bj * HALF) = pack8(acc[ai][bj][m][0] * b0, acc[ai][bj][m][1] * b1); } }
    }
};
struct ExpertGather { const int* idx; __device__ __forceinline__ unsigned row(int pm, int r) const { return (unsigned)((pm >> 6) * SEQ + idx[pm * BM + r]); } };
struct EpiOut {
    static constexpr bool PERM = false, AFTER_DRAIN = false, MID = false;
    const float* x; const float* mod; float* X1;
    __device__ __forceinline__ void operator()(const f32x4 (&acc)[2][2][4][2], const Unit& u, int wr, int wc, int fr, int fq) const {
        const int row0 = u.pm * BM + wr * 64 + fr, col0 = u.pn * BM + wc * 32 + 4 * fq;
        const float* g1 = mod + ((u.pm * BM) >> 13) * 6144 + 2048;
        f32x4 gv[2][2];
#pragma unroll
        for (int bj = 0; bj < 2; ++bj)
#pragma unroll
            for (int n = 0; n < 2; ++n) gv[bj][n] = *(const f32x4*)(g1 + col0 + bj * HALF + n * 16);
#pragma unroll
        for (int ai = 0; ai < 2; ++ai)
#pragma unroll
            for (int m = 0; m < 4; ++m) { const size_t off = (size_t)(row0 + ai * HALF + m * 16) * 1024 + col0;
#pragma unroll
                for (int bj = 0; bj < 2; ++bj)
#pragma unroll
                    for (int n = 0; n < 2; ++n) *(f32x4*)(X1 + off + bj * HALF + n * 16) = *(const f32x4*)(x + off + bj * HALF + n * 16) + gv[bj][n] * acc[ai][bj][m][n]; }
    }
};
struct EpiHid {
    static constexpr bool PERM = true, AFTER_DRAIN = false, MID = false;
    bf16_t* HID;
    __device__ __forceinline__ void operator()(const f32x4 (&acc)[2][2][4][2], const Unit& u, int wr, int wc, int fr, int fq) const {
        const int row0 = u.pm * BM + wr * 64 + fr, f0 = (u.pn & 7) * 128 + wc * 16 + 4 * fq;
#pragma unroll
        for (int ai = 0; ai < 2; ++ai)
#pragma unroll
            for (int m = 0; m < 4; ++m) { bf16_t* rowp = HID + (size_t)(row0 + ai * HALF + m * 16) * 1024 + f0;
#pragma unroll
                for (int bj = 0; bj < 2; ++bj) { const f32x4 g = acc[ai][bj][m][0], up = acc[ai][bj][m][1];
                    u32x2 w; w.x = cvt_pk_bf16(silu_f(g[0]) * up[0], silu_f(g[1]) * up[1]); w.y = cvt_pk_bf16(silu_f(g[2]) * up[2], silu_f(g[3]) * up[3]);
                    *(u32x2*)(rowp + bj * 64) = w; } }
    }
};
struct EpiDown {
    static constexpr bool PERM = true, AFTER_DRAIN = false, MID = false;
    const float* GSEL; bf16_t* Y;
    __device__ __forceinline__ void operator()(const f32x4 (&acc)[2][2][4][2], const Unit& u, int wr, int wc, int fr, int fq) const {
        const int row0 = u.pm * BM + wr * 64 + fr, col0 = (u.pn & 3) * BM + wc * 32 + 8 * fq;
#pragma unroll
        for (int ai = 0; ai < 2; ++ai)
#pragma unroll
            for (int m = 0; m < 4; ++m) { const int row = row0 + ai * HALF + m * 16; const float gs = GSEL[row]; bf16_t* rowp = Y + (size_t)row * 1024 + col0;
#pragma unroll
                for (int bj = 0; bj < 2; ++bj) *(u32x4*)(rowp + bj * HALF) = pack8(acc[ai][bj][m][0] * gs, acc[ai][bj][m][1] * gs); }
    }
};
template <int NT  > struct ExpertOrder {
    int G, c, e_hi, pn_hi;
    __device__ void init(int G_, int c_, int e_hi_ = 16, int pn_hi_ = 0) { G = G_; c = c_; e_hi = e_hi_; pn_hi = pn_hi_; }
    __device__ bool next(int i, Unit& u) const {
        constexpr int UPE = 8 * NT;
        long L = (long)i * G + c; if (L >= 16 * UPE) return false;
        if (G == 256) { const int xcd = c & 7, local = c >> 3, rpe = UPE / 32  ; L = (long)(xcd + 8 * (i / rpe)) * UPE + (i % rpe) * 32 + local; }
        const int e = (int)(L / UPE), uu = (int)(L % UPE), b = uu / (4 * NT), m = (uu / NT) & 3, j = uu % NT;
        u.pm = (b * 16 + e) * 4 + m; u.pn = e * NT + j + (e >= e_hi ? pn_hi : 0); return true;
    }
    __device__ __forceinline__ void a_ready(const Unit&) const {}
    __device__ __forceinline__ void done(const Unit&) const {}
};
struct NoGather { __device__ __forceinline__ unsigned row(int, int r) const { return (unsigned)r; } };
template <class Epi, class Sched, bool ALIGN_EPI = false, bool GATHER = false, class Gat = NoGather>
__device__ __forceinline__ void gemm_phase(PG8_LAS unsigned char* lds, const Gemm g, const Sched& S, const Epi& E, const Gat gat = Gat()) {
    const int tid = threadIdx.x, wid = __builtin_amdgcn_readfirstlane(tid >> 6), lane = tid & 63, wr = wid >> 2, wc = wid & 3, fr = lane & 15, fq = lane >> 4;
    const int K = g.K, nt = K / BK;
    const size_t kstep = (size_t)(BK * 2);
    const size_t hstep = (size_t)HALF * K * 2;
    const size_t tstep = 2 * hstep;
    unsigned voffB[2]; int Ra[2], Ca[2];
#pragma unroll
    for (int i = 0; i < 2; ++i) { int R, C; stage_rc(tid * 16 + i * 8192, R, C); const int Rb = Epi::PERM ? ((R & ~31) + perm32(R & 31)) : R;
        Ra[i] = R; Ca[i] = C; voffB[i] = (unsigned)(Rb * K + C) * 2u; }
    unsigned vAc[2][2], vAn[2][2];
#define PG8_AOFF(dst, pm) do { _Pragma("unroll") for (int h_ = 0; h_ < 2; ++h_) _Pragma("unroll") for (int i_ = 0; i_ < 2; ++i_) \
        dst[h_][i_] = GATHER ? (gat.row((pm), h_ * HALF + Ra[i_]) * (unsigned)K + (unsigned)Ca[i_]) * 2u : (unsigned)((h_ * HALF + Ra[i_]) * K + Ca[i_]) * 2u; } while (0)
    const unsigned ldsw = (unsigned)wid * 1024u;
    const int aoff = lds_byte(wr * 64 + fr, fq * 8), boff = lds_byte(wc * 32 + fr, fq * 8);
#define PG8_SA(b, h) (((b) * 2 + (h)) * HTB)
#define PG8_SB(b, h) ((4 + (b) * 2 + (h)) * HTB)
#define PG8_STAGE(bufoff, gbase, voff) do { _Pragma("unroll") for (int _i = 0; _i < 2; ++_i) \
        __builtin_amdgcn_global_load_lds((const unsigned*)((const char*)(gbase) + (voff)[_i]), (PG8_LAS unsigned*)(lds + (bufoff) + ldsw + _i * 8192), 16, 0, 0); } while (0)
#define PG8_LDA(dst, b, h) do { _Pragma("unroll") for (int m = 0; m < 4; ++m) _Pragma("unroll") for (int k = 0; k < 2; ++k) dst[m][k] = *(const PG8_LAS bf16x8*)(lds + PG8_SA(b, h) + aoff + m * 2048 + k * 1024); } while (0)
#define PG8_LDB(dst, b, h) do { _Pragma("unroll") for (int n = 0; n < 2; ++n) _Pragma("unroll") for (int k = 0; k < 2; ++k) dst[n][k] = *(const PG8_LAS bf16x8*)(lds + PG8_SB(b, h) + boff + n * 2048 + k * 1024); } while (0)
#define PG8_MMA(ai, bj, At, Bt) do { __builtin_amdgcn_s_setprio(1); _Pragma("unroll") for (int m = 0; m < 4; ++m) _Pragma("unroll") for (int n = 0; n < 2; ++n) _Pragma("unroll") for (int k = 0; k < 2; ++k) \
        acc[ai][bj][m][n] = __builtin_amdgcn_mfma_f32_16x16x32_bf16(Bt[n][k], At[m][k], acc[ai][bj][m][n], 0, 0, 0); __builtin_amdgcn_s_setprio(0); } while (0)
#define PG8_WAIT_V(n) asm volatile("s_waitcnt vmcnt(" #n ")" ::: "memory")
#define PG8_WAIT_L(n) asm volatile("s_waitcnt lgkmcnt(" #n ")" ::: "memory")
#define PG8_BAR __builtin_amdgcn_s_barrier()
#define PG8_SCHED __builtin_amdgcn_sched_barrier(0)
    Unit cur, nxt; int ui = 0;
    if (!S.next(0, cur)) return;
    f32x4 acc[2][2][4][2];
#pragma unroll
    for (int a = 0; a < 2; ++a)
#pragma unroll
        for (int b = 0; b < 2; ++b)
#pragma unroll
            for (int m = 0; m < 4; ++m)
#pragma unroll
                for (int n = 0; n < 2; ++n) acc[a][b][m][n] = (f32x4){0.f, 0.f, 0.f, 0.f};
    bf16x8 At[4][2], B0[2][2], B1[2][2];
    const char* cA = (const char*)g.A + (GATHER ? (size_t)0 : (size_t)cur.pm * tstep); const char* cB = (const char*)g.Bt + (size_t)cur.pn * tstep;
    PG8_AOFF(vAc, cur.pm);
    S.a_ready(cur);
    PG8_STAGE(PG8_SB(0, 0), cB, voffB); PG8_STAGE(PG8_SB(0, 1), cB + hstep, voffB); PG8_STAGE(PG8_SA(0, 0), cA, vAc[0]); PG8_STAGE(PG8_SA(0, 1), cA, vAc[1]);
    if (wr == 1) PG8_BAR;
    PG8_WAIT_V(2); PG8_BAR;
    PG8_STAGE(PG8_SB(1, 0), cB + kstep, voffB); PG8_STAGE(PG8_SA(1, 0), cA + kstep, vAc[0]); PG8_STAGE(PG8_SB(1, 1), cB + hstep + kstep, voffB);
    PG8_WAIT_V(6); PG8_BAR;
    for (;;) {
        const bool has_next = S.next(ui + 1, nxt);
        const char* nA = (has_next && !GATHER) ? (const char*)g.A + (size_t)nxt.pm * tstep : cA; const char* nB = has_next ? (const char*)g.Bt + (size_t)nxt.pn * tstep : cB;
        if (has_next) PG8_AOFF(vAn, nxt.pm); else { _Pragma("unroll") for (int h_ = 0; h_ < 2; ++h_) _Pragma("unroll") for (int i_ = 0; i_ < 2; ++i_) vAn[h_][i_] = vAc[h_][i_]; }
        for (int t = 0; t < nt; t += 2) {
            const bool last = (t == nt - 2);
            const char* a1 = cA + (size_t)(t + 1) * kstep;
            const char* a2 = last ? nA : cA + (size_t)(t + 2) * kstep; const char* b2 = last ? nB : cB + (size_t)(t + 2) * kstep;
            const char* a3 = a2 + kstep; const char* b3 = b2 + kstep;
            unsigned v2[2][2];
#pragma unroll
            for (int h_ = 0; h_ < 2; ++h_)
#pragma unroll
                for (int i_ = 0; i_ < 2; ++i_) v2[h_][i_] = last ? vAn[h_][i_] : vAc[h_][i_];
            if (last && has_next) S.a_ready(nxt);
            PG8_LDB(B0, 0, 0); PG8_LDB(B1, 0, 1); PG8_SCHED; PG8_LDA(At, 0, 0); PG8_STAGE(PG8_SA(1, 1), a1, vAc[1]);
            PG8_WAIT_V(8); PG8_WAIT_L(0); PG8_BAR; PG8_MMA(0, 0, At, B0); PG8_MMA(0, 1, At, B1); PG8_BAR; PG8_SCHED;
            PG8_LDA(At, 0, 1); PG8_STAGE(PG8_SB(0, 0), b2, voffB); PG8_STAGE(PG8_SB(0, 1), b2 + hstep, voffB); PG8_STAGE(PG8_SA(0, 0), a2, v2[0]);
            PG8_WAIT_V(8); PG8_WAIT_L(0); PG8_BAR; PG8_MMA(1, 0, At, B0); PG8_MMA(1, 1, At, B1); PG8_BAR; PG8_SCHED;
            PG8_LDB(B0, 1, 0); PG8_LDB(B1, 1, 1); PG8_SCHED; PG8_LDA(At, 1, 0); PG8_STAGE(PG8_SA(0, 1), a2, v2[1]);
            PG8_WAIT_V(8); PG8_WAIT_L(0); PG8_BAR; PG8_MMA(0, 0, At, B0); PG8_MMA(0, 1, At, B1); PG8_BAR; PG8_SCHED;
            PG8_LDA(At, 1, 1); PG8_STAGE(PG8_SB(1, 0), b3, voffB); PG8_STAGE(PG8_SB(1, 1), b3 + hstep, voffB); PG8_STAGE(PG8_SA(1, 0), a3, v2[0]);
            PG8_WAIT_V(8); PG8_WAIT_L(0); PG8_BAR; PG8_MMA(1, 0, At, B0); PG8_MMA(1, 1, At, B1); PG8_BAR; PG8_SCHED;
            if constexpr (Epi::MID) { if (t == nt / 2 - 2) { E.mid(acc, cur, wr, wc, fr, fq); PG8_SCHED; } }
        }
        if constexpr (ALIGN_EPI) { if (wr == 0) PG8_BAR; }
        if constexpr (!Epi::AFTER_DRAIN) { E(acc, cur, wr, wc, fr, fq); S.done(cur); }
        if (!has_next) break;
#pragma unroll
        for (int a = 0; a < 2; ++a)
#pragma unroll
            for (int b = 0; b < 2; ++b)
#pragma unroll
                for (int m = 0; m < 4; ++m)
#pragma unroll
                    for (int n = 0; n < 2; ++n) acc[a][b][m][n] = (f32x4){0.f, 0.f, 0.f, 0.f};
        cur = nxt; cA = nA; cB = nB; ++ui;
#pragma unroll
        for (int h_ = 0; h_ < 2; ++h_)
#pragma unroll
            for (int i_ = 0; i_ < 2; ++i_) vAc[h_][i_] = vAn[h_][i_];
        if constexpr (ALIGN_EPI) { if (wr == 1) PG8_BAR; }
    }
    PG8_WAIT_V(0);
    if constexpr (!ALIGN_EPI) { if (wr == 0) PG8_BAR; }
    PG8_BAR;
    if constexpr (Epi::AFTER_DRAIN) { E.fused(acc, cur, wr, wc, fr, fq, lds, wid, lane); S.done(cur); }
#undef PG8_AOFF
#undef PG8_SA
#undef PG8_SB
#undef PG8_STAGE
#undef PG8_LDA
#undef PG8_LDB
#undef PG8_MMA
#undef PG8_WAIT_V
#undef PG8_WAIT_L
#undef PG8_BAR
#undef PG8_SCHED
}
}
#define GAS __attribute__((address_space(1)))
#define LAS __attribute__((address_space(3)))
typedef unsigned short bf16;
typedef unsigned v4u __attribute__((ext_vector_type(4)));
typedef float f32x4 __attribute__((ext_vector_type(4)));
typedef short bf16x8 __attribute__((ext_vector_type(8)));
typedef GAS unsigned gu32;
typedef GAS unsigned long long gu64;
#define RLX_AGENT __ATOMIC_RELAXED, __HIP_MEMORY_SCOPE_AGENT
#define LDS_WAIT() asm volatile("s_waitcnt lgkmcnt(0)" ::: "memory")
#define VM_WAIT() asm volatile("s_waitcnt vmcnt(0)" ::: "memory")
__device__ __forceinline__ unsigned long long rt() { return __builtin_amdgcn_s_memrealtime(); }
__device__ __forceinline__ unsigned f2bf(float f) { unsigned u = __builtin_bit_cast(unsigned, f); return (u + 0x7fffu + ((u >> 16) & 1u)) >> 16; }
__device__ __forceinline__ unsigned pk2(float lo, float hi) { return f2bf(lo) | (f2bf(hi) << 16); }

#define XB_TMO      128
#define XB_XCNT(j)  (256  + 64 * (j))
#define XB_XSUB(j)  (1280 + 64 * (j))
#define XB_XGEN(j)  (2304 + 64 * (j))
#define XB_TOP      3328
#define XB_TOPGEN   3392
#define XCD_BAR_WORDS 3456
#define XB_SPIN_CAP (1u << 18)

__device__ __forceinline__ unsigned xb_ld(unsigned* p)              { return __hip_atomic_load(p, __ATOMIC_RELAXED, __HIP_MEMORY_SCOPE_AGENT); }
__device__ __forceinline__ unsigned xb_add(unsigned* p, unsigned v) { return __hip_atomic_fetch_add(p, v, __ATOMIC_RELAXED, __HIP_MEMORY_SCOPE_AGENT); }
__device__ __forceinline__ unsigned xb_xcc_id() { return (unsigned)__builtin_amdgcn_s_getreg((3 << 11) | 20) & 0xFu; }
#define XB_SPIN(cond, bar) do { unsigned _sp = 0; while (cond) { __builtin_amdgcn_s_sleep(1); \
    if ((++_sp & 255u) == 0u) { if (xb_ld(&(bar)[XB_TMO])) break; if (_sp > XB_SPIN_CAP) { atomicAdd(&(bar)[XB_TMO], 1u); break; } } } } while (0)

struct XcdBarrier {
    unsigned* bar; unsigned x;
    volatile LAS unsigned* st;
};

__device__ __forceinline__ XcdBarrier xcd_barrier_post(unsigned* bar, volatile LAS unsigned* st) {
    XcdBarrier b; b.bar = bar; b.x = xb_xcc_id(); b.st = st;
    if (threadIdx.x == 0) (void)xb_add(&bar[XB_XCNT(b.x)], 1u);
    return b;
}
__device__ __forceinline__ void xcd_barrier_complete(unsigned* bar, unsigned x, unsigned& nloc, unsigned& nx) {
    const unsigned G = gridDim.x * gridDim.y * gridDim.z;
    unsigned sum, cnt, mine, sp = 0u;
    for (;;) {
        sum = 0u; cnt = 0u; mine = 0u;
#pragma unroll
        for (unsigned j = 0; j < 16; ++j) { const unsigned c = xb_ld(&bar[XB_XCNT(j)]); sum += c; cnt += (c > 0u) ? 1u : 0u; mine = (j == x) ? c : mine; }
        if (sum == G) break;
        __builtin_amdgcn_s_sleep(1);
        if ((++sp & 255u) == 0u) { if (xb_ld(&bar[XB_TMO])) break; if (sp > XB_SPIN_CAP) { atomicAdd(&bar[XB_TMO], 1u); break; } }
    }
    nloc = mine > 0u ? mine : 1u; nx = cnt > 0u ? cnt : 1u;
}

__device__ __forceinline__ void xcd_barrier(const XcdBarrier& b) {
    asm volatile("s_waitcnt vmcnt(0)" ::: "memory");
    __syncthreads();
    if (threadIdx.x == 0) {
        unsigned* bar = b.bar;
        __builtin_amdgcn_s_waitcnt(0);
        unsigned nloc = b.st[0], nx = b.st[1];
        if (nloc == 0u) { xcd_barrier_complete(bar, b.x, nloc, nx); b.st[0] = nloc; b.st[1] = nx; }
        const unsigned old = xb_add(&bar[XB_XSUB(b.x)], 1u);
        const unsigned gen = old / nloc;
        if (old + 1u == (gen + 1u) * nloc) {
            __builtin_amdgcn_fence(__ATOMIC_RELEASE, "agent");
            asm volatile("s_waitcnt vmcnt(0)" ::: "memory");
            const unsigned og = xb_add(&bar[XB_TOP], 1u);
            const unsigned tg = og / nx;
            if (og + 1u == (tg + 1u) * nx) xb_add(&bar[XB_TOPGEN], 1u);
            else XB_SPIN(xb_ld(&bar[XB_TOPGEN]) == tg, bar);
            __builtin_amdgcn_fence(__ATOMIC_ACQUIRE, "agent");
            xb_add(&bar[XB_XGEN(b.x)], 1u);
            asm volatile("s_waitcnt vmcnt(0)" ::: "memory");
        } else {
            XB_SPIN(xb_ld(&bar[XB_XGEN(b.x)]) == gen, bar);
            __builtin_amdgcn_fence(__ATOMIC_ACQUIRE, "agent");
            asm volatile("s_waitcnt vmcnt(0)" ::: "memory");
        }
    }
    __syncthreads();
}

#ifndef PROBE_MASK
#define PROBE_MASK 0
#endif
#ifndef PROBE_VARIANT
#define PROBE_VARIANT 7
#endif
#ifndef PROBE_REPS
#define PROBE_REPS 4
#endif
constexpr int NWAVES = 8;
constexpr size_t MiB = 1u << 20;
constexpr size_t WS_CTL = 0, CTL_ZERO_BYTES = 256 * 1024;
constexpr int CW_TMO = 0, CW_CODE = 1, CW_BAR = 4096;
constexpr size_t WS_MOD = 160 * 1024;
constexpr size_t WS_AFF = 1 * MiB, WS_IDX = 2 * MiB, WS_GSEL = 2 * MiB + 256 * 1024, WS_SLOT = 3 * MiB;
constexpr size_t WS_H = 4 * MiB;
constexpr size_t WS_BG = 38 * MiB;
constexpr size_t WS_U = WS_BG, WS_V = WS_BG + 17 * MiB, WS_K = WS_BG + 34 * MiB, WS_Q = WS_BG + 51 * MiB, WS_SGA = WS_BG + 68 * MiB, WS_SGB = WS_BG + 100 * MiB;
constexpr size_t WS_YS = WS_BG + 132 * MiB, WS_YAB = WS_BG + 156 * MiB;
constexpr size_t WS_M = WS_BG;
constexpr size_t WS_XE = WS_BG, WS_HID = WS_BG + 132 * MiB;
constexpr size_t WS_WIN = 226 * MiB, WS_WGLU = 234 * MiB, WS_WPA = 235 * MiB, WS_WOUT = 237 * MiB;
constexpr size_t WS_WD = 239 * MiB;
constexpr int WGU_NLO = 8;
constexpr size_t WS_WGU = 271 * MiB, WS_WGU_HI = 107 * MiB, WS_END = 303 * MiB;
constexpr int WGU_HI_PN = (int)(((long)WS_WGU_HI - (long)WS_WGU) / (512 * 1024)) - 8 * WGU_NLO;
static_assert(((long)WS_WGU - (long)WS_WGU_HI) % (4 * (long)MiB) == 0 && WS_WGU_HI + (16 - WGU_NLO) * 4 * MiB <= WS_HID && WS_XE + 64 * MiB <= WS_WGU_HI && WS_WD + 32 * MiB <= WS_WGU, "gate|up halves");
static_assert(WS_YAB + 32 * MiB <= WS_WIN && WS_HID + 64 * MiB <= WS_WD && WS_WOUT + 2 * MiB <= WS_WD, "d_ws map");
static_assert(CW_BAR * 4 + 8 * XCD_BAR_WORDS * 4 <= (int)WS_MOD && WS_MOD + 3 * 6144 * 4 <= CTL_ZERO_BYTES, "control region");

constexpr int RING_OFF = 0, RING_BYTES = 131072;
constexpr int LDSCTL_OFF = RING_BYTES, MISC_OFF = LDSCTL_OFF + 320;
constexpr int LDS_BYTES = 147456;

__device__ __forceinline__ float wave_sum(float v) {
#pragma unroll
    for (int o = 1; o < 64; o <<= 1) v += __shfl_xor(v, o);
    return v;
}
template <int MODE> __device__ __forceinline__ int wrow(int n) {
    if (MODE == 1) { const int t = n >> 8, cl = n & 255; return (t >= 2 && t < 6) ? (t * 256 + 128 * ((cl >> 5) & 1) + 32 * (cl >> 6) + (cl & 31)) : n; }
    if (MODE == 2) return (n >> 2) * 8 + (n & 3);
    if (MODE == 3) return (n >> 2) * 8 + 4 + (n & 3);
    return n;
}
struct TItem { const float* W; bf16* WT; int N, ldw, item; };
__device__ __forceinline__ void titem_load(const TItem& t, f32x4 (&ld)[8], int lane) {
    const int nblk = t.N / 32, k0 = 64 * (t.item / nblk), n0 = 32 * (t.item % nblk);
#pragma unroll
    for (int i = 0; i < 8; ++i) ld[i] = *(const f32x4*)(t.W + (size_t)(k0 + 8 * i + (lane >> 3)) * t.N + n0 + 4 * (lane & 7));
}
template <int MODE> __device__ __forceinline__ void titem_finish(const TItem& t, const f32x4 (&ld)[8], LAS float* scr, int lane) {
    const int nblk = t.N / 32, k0 = 64 * (t.item / nblk), n0 = 32 * (t.item % nblk);
#pragma unroll
    for (int i = 0; i < 8; ++i) { LAS float* d = scr + (8 * i + (lane >> 3)) * 33 + 4 * (lane & 7); d[0] = ld[i][0]; d[1] = ld[i][1]; d[2] = ld[i][2]; d[3] = ld[i][3]; }
    LDS_WAIT(); asm volatile("" ::: "memory");
    const int c = lane & 7;
#pragma unroll
    for (int j = 0; j < 4; ++j) { const int n = (lane >> 3) + 8 * j; const LAS float* s = scr + (8 * c) * 33 + n;
        v4u o; o.x = pk2(s[0 * 33], s[1 * 33]); o.y = pk2(s[2 * 33], s[3 * 33]); o.z = pk2(s[4 * 33], s[5 * 33]); o.w = pk2(s[6 * 33], s[7 * 33]);
        *(GAS v4u*)(t.WT + (size_t)wrow<MODE>(n0 + n) * t.ldw + k0 + 8 * c) = o; }
    LDS_WAIT(); asm volatile("" ::: "memory");
}
template <int MODE> __device__ __forceinline__ void transpose_item(const float* W, int K, int N, bf16* WT, int ldw, LAS float* scr, int item, int lane) {
    const TItem t{W, WT, N, ldw, item}; f32x4 ld[8]; titem_load(t, ld, lane); titem_finish<MODE>(t, ld, scr, lane);
}
__device__ __forceinline__ void norm1_rows(const float* src0, bf16* dst0, int nrow, const float* gwt, const float* md, int lane) {
    f32x4 ca[4], cb[4];
#pragma unroll
    for (int j = 0; j < 4; ++j) { const int col = j * 256 + lane * 4; ca[j] = *(const f32x4*)(gwt + col) * (*(const f32x4*)(md + 1024 + col) + 1.f); cb[j] = *(const f32x4*)(md + col); }
    f32x4 na[4], nb[4];
#pragma unroll
    for (int j = 0; j < 4; ++j) { na[j] = *(const f32x4*)(src0 + j * 256 + lane * 4); nb[j] = *(const f32x4*)(src0 + (size_t)(nrow > 1 ? 1 : 0) * D + j * 256 + lane * 4); }
#pragma unroll 1
    for (int rr = 0; rr < nrow; rr += 2) {
        const int rb_ = (rr + 1 < nrow) ? rr + 1 : rr;
        f32x4 va[4], vb[4]; float ssa = 0.f, ssb = 0.f;
#pragma unroll
        for (int j = 0; j < 4; ++j) { va[j] = na[j]; vb[j] = nb[j]; }
        if (rr + 2 < nrow) { const int r2 = rr + 2, r3 = (rr + 3 < nrow) ? rr + 3 : rr + 2;
#pragma unroll
            for (int j = 0; j < 4; ++j) { na[j] = *(const f32x4*)(src0 + (size_t)r2 * D + j * 256 + lane * 4); nb[j] = *(const f32x4*)(src0 + (size_t)r3 * D + j * 256 + lane * 4); } }
#pragma unroll
        for (int j = 0; j < 4; ++j) { ssa += (va[j][0] * va[j][0] + va[j][1] * va[j][1]) + (va[j][2] * va[j][2] + va[j][3] * va[j][3]); ssb += (vb[j][0] * vb[j][0] + vb[j][1] * vb[j][1]) + (vb[j][2] * vb[j][2] + vb[j][3] * vb[j][3]); }
        const float ra = rsqrtf(wave_sum(ssa) * (1.f / D) + EPS), rb = rsqrtf(wave_sum(ssb) * (1.f / D) + EPS);
#pragma unroll
        for (int j = 0; j < 4; ++j) {
            const int col = j * 256 + lane * 4;
            const f32x4 oa = va[j] * ra * ca[j] + cb[j], ob = vb[j] * rb * ca[j] + cb[j];
            pg8::u32x2 w; w.x = pk2(oa[0], oa[1]); w.y = pk2(oa[2], oa[3]); *(pg8::u32x2*)(dst0 + (size_t)rr * D + col) = w;
            w.x = pk2(ob[0], ob[1]); w.y = pk2(ob[2], ob[3]); *(pg8::u32x2*)(dst0 + (size_t)rb_ * D + col) = w;
        }
    }
}

struct Args { const float* in[29]; float* out; unsigned char* ws; int ph_lo, ph_hi, li, pad; };
enum { I_X = 0, I_C, I_CTX, I_CCTX, I_WADA, I_BADA, I_NMIX, I_NFFN, I_WIN, I_LRE, I_LIM, I_LDT, I_BRE, I_BIM, I_CRE, I_CIM, I_SD, I_WGLU, I_BGLU, I_QN, I_KN, I_RPB, I_WPA, I_WPB, I_WOUT, I_WR, I_WEG, I_WEU, I_WED };

typedef float f32x16 __attribute__((ext_vector_type(16)));
constexpr int S5_CH = 64, S5_NCH = 132, S5_NST = S5_CH / 16, S5_NPAIR = S5_NCH / 2, S5_NLAT = SEQ / S5_CH, S5_NCC = NCTX / S5_CH;
constexpr size_t WS_LAM = 512 * 1024, WS_LAMP = 512 * 1024 + 32768;
constexpr size_t WS_S5B = 2 * MiB + 512 * 1024, WS_S5C = 2 * MiB + 768 * 1024;
constexpr size_t WS_SEND = WS_YS, WS_HIN = WS_YS + 12 * MiB;

__device__ __forceinline__ void s5_prep(const Args& args, unsigned char* ws, int dg, int lane) {
    const float* lam_re = args.in[I_LRE]; const float* lam_im = args.in[I_LIM]; const float* b_re = args.in[I_BRE]; const float* b_im = args.in[I_BIM];
    const float* c_re = args.in[I_CRE]; const float* c_im = args.in[I_CIM];
    const float dt = expf(args.in[I_LDT][dg]);
    {
        const int p = lane; const float lre = lam_re[dg * 64 + p], lim = lam_im[dg * 64 + p];
        const float er = expf(lre * dt); float xr = er * cosf(lim * dt), xi = er * sinf(lim * dt);
        float* L = (float*)(ws + WS_LAM) + (dg * 64 + p) * 2; L[0] = xr; L[1] = xi;
#pragma unroll
        for (int s = 0; s < 6; ++s) { const float nr = xr * xr - xi * xi, ni = 2.f * xr * xi; xr = nr; xi = ni; }
        float* LP = (float*)(ws + WS_LAMP) + (dg * 64 + p) * 2; LP[0] = xr; LP[1] = xi;
    }
    const int r = lane & 31, h = lane >> 5;
#pragma unroll
    for (int q = 0; q < 4; ++q) {
        const int p = 2 * r + (q >> 1); const float lre = lam_re[dg * 64 + p], lim = lam_im[dg * 64 + p];
        const float er = expf(lre * dt), lbr = er * cosf(lim * dt), lbi = er * sinf(lim * dt);
        const float nr = lbr - 1.f, ni = lbi, den = lre * lre + lim * lim, cr = (nr * lre + ni * lim) / den, ci = (ni * lre - nr * lim) / den;
        unsigned w[4];
#pragma unroll
        for (int jj = 0; jj < 8; jj += 2) {
            float v[2];
#pragma unroll
            for (int e = 0; e < 2; ++e) { const int c = 8 * h + jj + e; const float br = b_re[(dg * 64 + p) * 16 + c], bi = b_im[(dg * 64 + p) * 16 + c]; v[e] = (q & 1) ? (cr * bi + ci * br) : (cr * br - ci * bi); }
            w[jj >> 1] = pk2(v[0], v[1]);
        }
        *(v4u*)(ws + WS_S5B + ((size_t)(dg * 4 + q) * 64 + lane) * 16) = (v4u){w[0], w[1], w[2], w[3]};
    }
    const int ch = lane & 15, fq = lane >> 4;
#pragma unroll
    for (int ks = 0; ks < 4; ++ks) {
        unsigned w[4];
#pragma unroll
        for (int jj = 0; jj < 8; jj += 2) { const int st = (32 * ks + 8 * fq + jj) >> 1;
            w[jj >> 1] = pk2(c_re[(dg * 16 + ch) * 64 + st], -c_im[(dg * 16 + ch) * 64 + st]); }
        *(v4u*)(ws + WS_S5C + ((size_t)(dg * 4 + ks) * 64 + lane) * 16) = (v4u){w[0], w[1], w[2], w[3]};
    }
}
__device__ __forceinline__ int s5_row(int b, int dir, int pos) {
    if (pos < NCTX) return MLAT + b * NCTX + (dir ? NCTX - 1 - pos : pos);
    const int t = pos - NCTX; return b * SEQ + (dir ? SEQ - 1 - t : t);
}
#define S5_SCAN16(D0, D1, D2, D3) do { _Pragma("unroll") for (int r_ = 0; r_ < 16; ++r_) { \
        const float n0r = fmaf(lm[0], x[0], fmaf(-lm[1], x[1], D0[r_])), n0i = fmaf(lm[0], x[1], fmaf(lm[1], x[0], D1[r_])); \
        const float n1r = fmaf(lm[2], x[2], fmaf(-lm[3], x[3], D2[r_])), n1i = fmaf(lm[2], x[3], fmaf(lm[3], x[2], D3[r_])); \
        x[0] = n0r; x[1] = n0i; x[2] = n1r; x[3] = n1i; D0[r_] = n0r; D1[r_] = n0i; D2[r_] = n1r; D3[r_] = n1i; } } while (0)

#define S5_SCAN16_ONE(Dr, Di, LR, LI, XR, XI) do { _Pragma("unroll") for (int r_ = 0; r_ < 16; ++r_) { \
        const float nr_ = fmaf(LR, XR, fmaf(-(LI), XI, Dr[r_])), ni_ = fmaf(LR, XI, fmaf(LI, XR, Di[r_])); XR = nr_; XI = ni_; Dr[r_] = nr_; Di[r_] = ni_; } } while (0)
__device__ __forceinline__ void s5_pass1(unsigned char* ws, int task, int lane) {
    const int chain = task / S5_NPAIR, w = task % S5_NPAIR, g = chain & 31, dir = (chain >> 5) & 1, b = chain >> 6, dg = dir * 32 + g;
    const bf16* U = (const bf16*)(ws + WS_U);
    bf16x8 Bf[4];
#pragma unroll
    for (int q = 0; q < 4; ++q) Bf[q] = *(const bf16x8*)(ws + WS_S5B + ((size_t)(dg * 4 + q) * 64 + lane) * 16);
    const f32x4 lm = *(const f32x4*)((const float*)(ws + WS_LAM) + (dg * 64 + 2 * (lane & 31)) * 2);
    const int i = lane & 31, hhA = (i >> 2) & 1, ti = (i & 3) + 4 * (i >> 3), h = lane >> 5;
    float x[4] = {0.f, 0.f, 0.f, 0.f};
    const f32x16 z = {0.f, 0.f, 0.f, 0.f, 0.f, 0.f, 0.f, 0.f, 0.f, 0.f, 0.f, 0.f, 0.f, 0.f, 0.f, 0.f};
    bf16x8 an = *(const bf16x8*)(U + (size_t)s5_row(b, dir, (2 * w + hhA) * S5_CH + ti) * 512 + g * 16 + 8 * h);
#pragma unroll 1
    for (int step = 0; step < S5_NST; ++step) {
        const bf16x8 a = an;
        if (step + 1 < S5_NST) an = *(const bf16x8*)(U + (size_t)s5_row(b, dir, (2 * w + hhA) * S5_CH + (step + 1) * 16 + ti) * 512 + g * 16 + 8 * h);
        f32x16 D0 = __builtin_amdgcn_mfma_f32_32x32x16_bf16(a, Bf[0], z, 0, 0, 0), D1 = __builtin_amdgcn_mfma_f32_32x32x16_bf16(a, Bf[1], z, 0, 0, 0);
        f32x16 D2 = __builtin_amdgcn_mfma_f32_32x32x16_bf16(a, Bf[2], z, 0, 0, 0), D3 = __builtin_amdgcn_mfma_f32_32x32x16_bf16(a, Bf[3], z, 0, 0, 0);
        S5_SCAN16(D0, D1, D2, D3);
    }
    float* S = (float*)(ws + WS_SEND) + ((size_t)chain * S5_NCH + 2 * w + h) * 128 + 4 * (lane & 31);
    *(f32x4*)S = (f32x4){x[0], x[1], x[2], x[3]};
}
static_assert(S5_NCH % 6 == 0, "pass 2 batches");
__device__ __forceinline__ void s5_pass2(unsigned char* ws, int gid) {
    const int chain = gid >> 6, p = gid & 63, dg = chain & 63;
    const float lr = ((const float*)(ws + WS_LAMP))[(dg * 64 + p) * 2], li = ((const float*)(ws + WS_LAMP))[(dg * 64 + p) * 2 + 1];
    const float* S = (const float*)(ws + WS_SEND) + (size_t)chain * S5_NCH * 128 + 2 * p; float* H = (float*)(ws + WS_HIN) + (size_t)chain * S5_NCH * 128 + 2 * p;
    float xr = 0.f, xi = 0.f;
#pragma unroll 1
    for (int q0 = 0; q0 < S5_NCH; q0 += 6) {
        float sr[6], si[6];
#pragma unroll
        for (int e = 0; e < 6; ++e) { sr[e] = S[(q0 + e) * 128]; si[e] = S[(q0 + e) * 128 + 1]; }
#pragma unroll
        for (int e = 0; e < 6; ++e) { H[(q0 + e) * 128] = xr; H[(q0 + e) * 128 + 1] = xi;
            const float nr = fmaf(lr, xr, fmaf(-li, xi, sr[e])), ni = fmaf(lr, xi, fmaf(li, xr, si[e])); xr = nr; xi = ni; }
    }
}
__device__ __forceinline__ void s5_pass3(const Args& args, unsigned char* ws, LAS unsigned char* xt  , int task, int lane) {
    const int w = task & 63, g = (task >> 6) & 31, b = task >> 11;
    const bf16* U = (const bf16*)(ws + WS_U); bf16* Ao = (bf16*)(ws + WS_H);
    const int i = lane & 31, hhA = (i >> 2) & 1, ti = (i & 3) + 4 * (i >> 3), h = lane >> 5, j = lane & 31, fq = lane >> 4, ch = lane & 15;
    f32x4 yacc[S5_NST][2];
    const f32x16 z = {0.f, 0.f, 0.f, 0.f, 0.f, 0.f, 0.f, 0.f, 0.f, 0.f, 0.f, 0.f, 0.f, 0.f, 0.f, 0.f};
#pragma unroll
    for (int dir = 0; dir < 2; ++dir) {
        const int dg = dir * 32 + g, chain = (b * 2 + dir) * 32 + g;
        bf16x8 Bf[4], Cf[4];
#pragma unroll
        for (int q = 0; q < 4; ++q) { Bf[q] = *(const bf16x8*)(ws + WS_S5B + ((size_t)(dg * 4 + q) * 64 + lane) * 16); Cf[q] = *(const bf16x8*)(ws + WS_S5C + ((size_t)(dg * 4 + q) * 64 + lane) * 16); }
        const f32x4 lm = *(const f32x4*)((const float*)(ws + WS_LAM) + (dg * 64 + 2 * j) * 2);
        const int cl = 2 * w + h, qc = dir ? (S5_NCC + S5_NLAT - 1 - cl) : (cl + S5_NCC);
        const f32x4 x0 = *(const f32x4*)((const float*)(ws + WS_HIN) + ((size_t)chain * S5_NCH + qc) * 128 + 4 * j);
        float x[4] = {x0[0], x0[1], x0[2], x0[3]};
        bf16x8 an = *(const bf16x8*)(U + ((size_t)b * SEQ + (2 * w + hhA) * S5_CH + (dir ? S5_CH - 1 - ti : ti)) * 512 + g * 16 + 8 * h);
#pragma unroll
        for (int step = 0; step < S5_NST; ++step) {
            const bf16x8 a = an;
            if (step + 1 < S5_NST) { const int n = (step + 1) * 16 + ti, t = (2 * w + hhA) * S5_CH + (dir ? S5_CH - 1 - n : n); an = *(const bf16x8*)(U + ((size_t)b * SEQ + t) * 512 + g * 16 + 8 * h); }
            {   f32x16 D0 = __builtin_amdgcn_mfma_f32_32x32x16_bf16(a, Bf[0], z, 0, 0, 0), D1 = __builtin_amdgcn_mfma_f32_32x32x16_bf16(a, Bf[1], z, 0, 0, 0);
                S5_SCAN16_ONE(D0, D1, lm[0], lm[1], x[0], x[1]);
#pragma unroll
                for (int r = 0; r < 16; ++r) *(LAS unsigned*)(xt + (h * 16 + r) * 272 + 8 * j) = pg8::cvt_pk_bf16(D0[r], D1[r]); }
            {   f32x16 D2 = __builtin_amdgcn_mfma_f32_32x32x16_bf16(a, Bf[2], z, 0, 0, 0), D3 = __builtin_amdgcn_mfma_f32_32x32x16_bf16(a, Bf[3], z, 0, 0, 0);
                S5_SCAN16_ONE(D2, D3, lm[2], lm[3], x[2], x[3]);
#pragma unroll
                for (int r = 0; r < 16; ++r) *(LAS unsigned*)(xt + (h * 16 + r) * 272 + 8 * j + 4) = pg8::cvt_pk_bf16(D2[r], D3[r]); }
            asm volatile("s_waitcnt lgkmcnt(0)" ::: "memory");
            const int rs = dir ? 15 - ch : ch;
#pragma unroll
            for (int hr = 0; hr < 2; ++hr) {
                f32x4 acc = {0.f, 0.f, 0.f, 0.f};
#pragma unroll
                for (int ks = 0; ks < 4; ++ks) { const bf16x8 af = *(const LAS bf16x8*)(xt + (hr * 16 + rs) * 272 + ks * 64 + 16 * fq);
                    acc = __builtin_amdgcn_mfma_f32_16x16x32_bf16(af, Cf[ks], acc, 0, 0, 0); }
                if (dir == 0) yacc[step][hr] = acc; else yacc[S5_NST - 1 - step][hr] += acc;
            }
            asm volatile("s_waitcnt lgkmcnt(0)" ::: "memory");
            __builtin_amdgcn_sched_barrier(0);
        }
    }
    const float dsk = args.in[I_SD][g * 16 + ch];
#pragma unroll
    for (int s = 0; s < S5_NST; ++s)
#pragma unroll
        for (int hr = 0; hr < 2; ++hr)
#pragma unroll
            for (int e = 0; e < 4; ++e) { const size_t o = ((size_t)b * SEQ + (2 * w + hr) * S5_CH + 16 * s + 4 * fq + e) * 512 + g * 16 + ch;
                Ao[o] = (bf16)f2bf(gelu_tanh(yacc[s][hr][e] + bf2f(U[o]) * dsk)); }
}
__device__ __forceinline__ int block_incl_scan(int v, int* scr, int lane, int wave, int& total) {
    int x = v;
#pragma unroll
    for (int o = 1; o < 64; o <<= 1) { const int y = __shfl_up(x, o); if (lane >= o) x += y; }
    if (lane == 63) scr[wave] = x;
    __syncthreads();
    int base = 0, tot = 0;
#pragma unroll
    for (int w = 0; w < 8; ++w) { const int s = scr[w]; if (w < wave) base += s; tot += s; }
    __syncthreads();
    total = tot; return x + base;
}
__device__ __forceinline__ void topk_select(unsigned char* ws, unsigned char* lds_g, int be, int tid, int lane, int wave) {
    unsigned* vals = (unsigned*)lds_g; int* hist = (int*)(lds_g + 32768); int* scr = (int*)(lds_g + 49152);
    const int b = be >> 4, e = be & 15;
    const float* AFF = (const float*)(ws + WS_AFF); int* IDX = (int*)(ws + WS_IDX); float* GSEL = (float*)(ws + WS_GSEL); int* SLOT = (int*)(ws + WS_SLOT);
    for (int i = tid; i < 8192; i += 512) vals[i] = __float_as_uint(AFF[((size_t)b * SEQ + i) * 16 + e]);
    __syncthreads();
    unsigned long long prefix = 0ull; int krem = 1024;
#pragma unroll
    for (int pass = 0; pass < 4; ++pass) {
        const int wdt = pass == 3 ? 12 : 11, shift = pass == 0 ? 34 : (pass == 1 ? 23 : (pass == 2 ? 12 : 0)), nb = 1 << wdt, B = nb / 512;
        for (int i = tid; i < nb; i += 512) hist[i] = 0;
        __syncthreads();
        for (int k = 0; k < 16; ++k) { const int i = tid + 512 * k; const unsigned long long key = ((unsigned long long)vals[i] << 13) | (unsigned)(8191 - i);
            if ((key >> (shift + wdt)) == prefix) atomicAdd(&hist[(int)(key >> shift) & (nb - 1)], 1); }
        __syncthreads();
        int cnt = 0;
        for (int d = 0; d < B; ++d) cnt += hist[tid * B + d];
        int total; const int incl = block_incl_scan(cnt, scr, lane, wave, total);
        int running = total - incl;
        for (int d = tid * B + B - 1; d >= tid * B; --d) { const int hh = hist[d]; if (running < krem && running + hh >= krem) { scr[16] = d; scr[17] = krem - running; } running += hh; }
        __syncthreads();
        const int dstar = scr[16]; krem = scr[17]; prefix = (prefix << wdt) | (unsigned long long)dstar;
        __syncthreads();
    }
    int cnt = 0;
    for (int k = 0; k < 16; ++k) { const int i = tid + 512 * k; const unsigned long long key = ((unsigned long long)vals[i] << 13) | (unsigned)(8191 - i); cnt += key >= prefix ? 1 : 0; }
    int total; int slot = block_incl_scan(cnt, scr, lane, wave, total) - cnt;
    for (int k = 0; k < 16; ++k) { const int i = tid + 512 * k; const unsigned long long key = ((unsigned long long)vals[i] << 13) | (unsigned)(8191 - i);
        if (key >= prefix) { if (slot < 1024) { IDX[be * 1024 + slot] = i; GSEL[be * 1024 + slot] = __uint_as_float(vals[i]); SLOT[be * 8192 + i] = slot; } else SLOT[be * 8192 + i] = -1; ++slot; }
        else SLOT[be * 8192 + i] = -1; }
    __syncthreads();
}
typedef short s16x4 __attribute__((ext_vector_type(4)));
constexpr int AT_ROW = 144;
constexpr int AT_KC = 0, AT_VC = 256 * AT_ROW, AT_RING = 2 * 256 * AT_ROW, AT_RBUF = 2 * 64 * AT_ROW, AT_BIAS = 132096;
static_assert(AT_RING + 3 * AT_RBUF <= RING_BYTES && AT_BIAS >= MISC_OFF + 128 && AT_BIAS + (512 + 640) * 4 <= LDS_BYTES, "attention LDS map");
constexpr float LOG2E = 1.4426950408889634f;

template <int MODE> __device__ __forceinline__ void attn_tile32(const LAS unsigned char* K32, const LAS unsigned char* V32, const bf16x8 q0, const bf16x8 q1, f32x4 (&O)[4], float& lsum,
                                                              int lane, const LAS float* brow, int kc0, int q_cs, float shiftl) {
    const int r16 = lane & 15, fq = lane >> 4;
    f32x4 st[2];
#pragma unroll
    for (int tt = 0; tt < 2; ++tt) {
        const LAS unsigned char* kp = K32 + (16 * tt + r16) * AT_ROW + 16 * fq;
        const bf16x8 k0 = *(const LAS bf16x8*)kp, k1 = *(const LAS bf16x8*)(kp + 64);
        f32x4 c0;
        if (MODE == 0) c0 = (f32x4){shiftl, shiftl, shiftl, shiftl};
        else { const LAS float* bp = brow + 16 * tt + 4 * fq; c0 = (f32x4){bp[0], bp[1], bp[2], bp[3]}; }
        st[tt] = __builtin_amdgcn_mfma_f32_16x16x32_bf16(k0, q0, c0, 0, 0, 0);
        st[tt] = __builtin_amdgcn_mfma_f32_16x16x32_bf16(k1, q1, st[tt], 0, 0, 0);
    }
    float p[2][4];
#pragma unroll
    for (int tt = 0; tt < 2; ++tt)
#pragma unroll
        for (int e = 0; e < 4; ++e) {
            float v = __builtin_amdgcn_exp2f(st[tt][e]);
            if (MODE == 2) { const int kc = kc0 + 16 * tt + 4 * fq + e; v = (kc >= q_cs && kc < q_cs + 16) ? v : 0.f; }
            p[tt][e] = v; lsum += v;
        }
    bf16x8 Pf; { pg8::u32x4 w; w.x = pg8::cvt_pk_bf16(p[0][0], p[0][1]); w.y = pg8::cvt_pk_bf16(p[0][2], p[0][3]); w.z = pg8::cvt_pk_bf16(p[1][0], p[1][1]); w.w = pg8::cvt_pk_bf16(p[1][2], p[1][3]); Pf = __builtin_bit_cast(bf16x8, w); }
    const LAS unsigned char* vp = V32 + (4 * fq + (r16 >> 2)) * AT_ROW + 8 * (r16 & 3);
#pragma unroll
    for (int dt = 0; dt < 4; ++dt) {
        const s16x4 lo = __builtin_amdgcn_ds_read_tr16_b64_v4i16((LAS s16x4*)(vp + 32 * dt)), hi = __builtin_amdgcn_ds_read_tr16_b64_v4i16((LAS s16x4*)(vp + 32 * dt + 16 * AT_ROW));
        const bf16x8 Vf = __builtin_shufflevector(lo, hi, 0, 1, 2, 3, 4, 5, 6, 7);
        O[dt] = __builtin_amdgcn_mfma_f32_16x16x32_bf16(Vf, Pf, O[dt], 0, 0, 0);
    }
}

__device__ __forceinline__ void attn_unit(const Args& args, unsigned char* ws, LAS unsigned char* lds, int unit, int tid, int lane, int wave, int mode  ) {
    const int b = unit >> 7, head = (unit >> 4) & 7, r0 = (unit & 15) * 8, r = r0 + wave;
    const bf16* Q = (const bf16*)(ws + WS_Q); const bf16* Kg = (const bf16*)(ws + WS_K); const bf16* Vg = (const bf16*)(ws + WS_V); bf16* YB = (bf16*)(ws + WS_YAB) + 512;
    const int r16 = lane & 15, fq = lane >> 4;
    float mq = fabsf(args.in[I_QN][lane]), mk = fabsf(args.in[I_KN][lane]);
#pragma unroll
    for (int o = 1; o < 64; o <<= 1) { mq = fmaxf(mq, __shfl_xor(mq, o)); mk = fmaxf(mk, __shfl_xor(mk, o)); }
    const float shiftl = -8.f * mq * mk * LOG2E;
    __syncthreads();
    {
        const bf16* kc = Kg + ((size_t)MLAT + b * NCTX) * 512 + head * 64; const bf16* vc = Vg + ((size_t)MLAT + b * NCTX) * 512 + head * 64;
#pragma unroll
        for (int i = 0; i < 4; ++i) { const int idx = tid + 512 * i, row = idx >> 3, c = idx & 7;
            const v4u kv = *(const v4u*)(kc + (size_t)row * 512 + c * 8), vv = *(const v4u*)(vc + (size_t)row * 512 + c * 8);
            *(LAS v4u*)(lds + AT_KC + row * AT_ROW + c * 16) = kv; *(LAS v4u*)(lds + AT_VC + row * AT_ROW + c * 16) = vv; }
        LAS float* bl = (LAS float*)(lds + AT_BIAS);
        {
            bl[tid] = tid < 465 ? fmaf(args.in[I_RPB][head * 465 + tid], LOG2E, shiftl) : 0.f;
            for (int i = tid; i < 640; i += 512) { const int dr = i / 40, dc = i % 40 - 8; bl[512 + i] = (dr < 15 && dc >= 7 && dc < 23) ? fmaf(args.in[I_RPB][head * 465 + dr * 31 + dc], LOG2E, shiftl) : -30000.f; }
        }
    }
    const int kr_lo = min(max(r0 - 4, 0), 120), kr_hi = min(max(r0 + 3, 0), 120) + 7;
    const int lcol = tid >> 3, lc = tid & 7;
    v4u kv, vv;
    {   const size_t g0 = ((size_t)b * SEQ + kr_lo * 64 + lcol) * 512 + head * 64 + lc * 8;
        const v4u k0 = *(const v4u*)(Kg + g0), v0 = *(const v4u*)(Vg + g0);
        *(LAS v4u*)(lds + AT_RING + lcol * AT_ROW + lc * 16) = k0; *(LAS v4u*)(lds + AT_RING + 64 * AT_ROW + lcol * AT_ROW + lc * 16) = v0;
        kv = *(const v4u*)(Kg + g0 + 64 * 512); vv = *(const v4u*)(Vg + g0 + 64 * 512); }
    bf16x8 Qf[4][2];
#pragma unroll
    for (int j = 0; j < 4; ++j) { const bf16* qp = Q + ((size_t)b * SEQ + r * 64 + 16 * j + r16) * 512 + head * 64 + 8 * fq; Qf[j][0] = *(const bf16x8*)qp; Qf[j][1] = *(const bf16x8*)(qp + 32); }
    f32x4 O[4][4]; float lsum[4];
#pragma unroll
    for (int j = 0; j < 4; ++j) { lsum[j] = 0.f;
#pragma unroll
        for (int dt = 0; dt < 4; ++dt) O[j][dt] = (f32x4){0.f, 0.f, 0.f, 0.f}; }
    __syncthreads();
#pragma unroll 1
    for (int grp = 0; grp < ((mode & 1) ? 8 : 0); ++grp) {
#pragma unroll
        for (int j = 0; j < 4; ++j) attn_tile32<0>(lds + AT_KC + 32 * grp * AT_ROW, lds + AT_VC + 32 * grp * AT_ROW, Qf[j][0], Qf[j][1], O[j], lsum[j], lane, nullptr, 0, 0, shiftl);
    }
    const int rs = min(max(r - 4, 0), 120);
    int buf = 0;
#pragma unroll 1
    for (int kr = kr_lo; kr <= ((mode & 2) ? kr_hi : kr_lo - 1); ++kr) {
        if (kr + 1 <= kr_hi) { const int nbuf = buf == 2 ? 0 : buf + 1; LAS unsigned char* nb = lds + AT_RING + nbuf * AT_RBUF;
            *(LAS v4u*)(nb + lcol * AT_ROW + lc * 16) = kv; *(LAS v4u*)(nb + 64 * AT_ROW + lcol * AT_ROW + lc * 16) = vv; }
        if (kr + 2 <= kr_hi) { const size_t g0 = ((size_t)b * SEQ + (kr + 2) * 64 + lcol) * 512 + head * 64 + lc * 8; kv = *(const v4u*)(Kg + g0); vv = *(const v4u*)(Vg + g0); }
        if (kr >= rs && kr < rs + 8 && (mode & 4)) {
            const LAS unsigned char* kb = lds + AT_RING + buf * AT_RBUF; const LAS unsigned char* vb = kb + 64 * AT_ROW;
            const LAS float* bl = (const LAS float*)(lds + AT_BIAS) + (kr - r + 7) * 31 + 15; const LAS float* bl1 = (const LAS float*)(lds + AT_BIAS) + 512 + (kr - r + 7) * 40 + 8 + 15;
#pragma unroll
            for (int j = 0; j < 4; ++j) { const int cs = j == 0 ? 0 : (j == 3 ? 32 : 16 * j - 8), qc = 16 * j + r16, q_cs = min(max(qc - 8, 0), 48);
                if (j == 0 || j == 3) attn_tile32<2>(kb + cs * AT_ROW, vb + cs * AT_ROW, Qf[j][0], Qf[j][1], O[j], lsum[j], lane, bl + cs - qc, cs, q_cs, shiftl);
                else attn_tile32<1>(kb + cs * AT_ROW, vb + cs * AT_ROW, Qf[j][0], Qf[j][1], O[j], lsum[j], lane, bl1 + cs - qc, cs, q_cs, shiftl); }
        }
        __syncthreads();
        buf = buf == 2 ? 0 : buf + 1;
    }
#pragma unroll
    for (int j = 0; j < 4; ++j) {
        float l = lsum[j]; l += __shfl_xor(l, 16); l += __shfl_xor(l, 32);
        const float inv = 1.f / l;
        bf16* op = YB + ((size_t)b * SEQ + r * 64 + 16 * j + r16) * 1024 + head * 64 + 4 * fq;
#pragma unroll
        for (int dt = 0; dt < 4; ++dt) { pg8::u32x2 w; w.x = pg8::cvt_pk_bf16(O[j][dt][0] * inv, O[j][dt][1] * inv); w.y = pg8::cvt_pk_bf16(O[j][dt][2] * inv, O[j][dt][3] * inv); *(pg8::u32x2*)(op + 16 * dt) = w; }
    }
}
__global__ void __launch_bounds__(NWAVES * 64, 2) mega(Args args) {
    extern __shared__ __attribute__((aligned(16))) unsigned char lds_raw[];
    LAS unsigned char* lds = (LAS unsigned char*)lds_raw;
    volatile LAS unsigned* MISC = (volatile LAS unsigned*)(lds + MISC_OFF);
    const int tid = threadIdx.x, lane = tid & 63, wave = __builtin_amdgcn_readfirstlane(tid >> 6);
    const int G = gridDim.x; const int bx = blockIdx.x; const int vcu = (G % 8 == 0) ? (bx % 8) * (G / 8) + bx / 8 : bx;
    const int gw = vcu * NWAVES + wave, NGW = G * NWAVES;
    unsigned char* ws = args.ws;
    gu32* ctl = (gu32*)(ws + WS_CTL);
    for (int u = tid; u < (LDS_BYTES - LDSCTL_OFF) / 4; u += NWAVES * 64) ((LAS unsigned*)(lds + LDSCTL_OFF))[u] = 0u;
    __syncthreads();
    XcdBarrier bar = xcd_barrier_post((unsigned*)(ctl + CW_BAR) + args.li * XCD_BAR_WORDS, MISC + 8);
    const int lo = args.ph_lo, hi = args.ph_hi;
#define IN(k) (lo <= (k) && (k) < hi)
#define BOTH(k) (IN(k) && IN((k) + 1))
#if defined(TIME_MASK)
    unsigned long long tacc_ = 0ull, tbeg_ = 0ull;
#define TBEG(k) do { if ((TIME_MASK >> (k)) & 1) tbeg_ = __builtin_amdgcn_s_memrealtime(); } while (0)
#define TEND(k) do { if ((TIME_MASK >> (k)) & 1) tacc_ += __builtin_amdgcn_s_memrealtime() - tbeg_; } while (0)
#else
#define TBEG(k) do {} while (0)
#define TEND(k) do {} while (0)
#endif
    float* mod = (float*)(ws + WS_MOD);
    bf16* Hb = (bf16*)(ws + WS_H);

    TBEG(0);
    if (IN(0)) for (int rep_ = 0; rep_ <= ((PROBE_MASK >> 0) & 1) * PROBE_REPS; ++rep_) {
        const float* c = args.in[I_C]; const float* cctx = args.in[I_CCTX]; const float* w_ada = args.in[I_WADA]; const float* b_ada = args.in[I_BADA];
        if (args.li == 0) for (int it = gw; it < 24 * 16; it += NGW) {
            const int cc = it % 24, ks = it / 24, col = cc * 256 + lane * 4;
            f32x4 a0 = {0.f, 0.f, 0.f, 0.f}, a1 = a0, a2 = a0;
#pragma unroll 1
            for (int k0 = ks * 64; k0 < ks * 64 + 64; k0 += 16) {
                f32x4 w[16];
#pragma unroll
                for (int i = 0; i < 16; ++i) w[i] = *(const f32x4*)(w_ada + (size_t)(k0 + i) * 6144 + col);
#pragma unroll
                for (int i = 0; i < 16; ++i) { const float s0 = silu_f(c[k0 + i]), s1 = silu_f(c[1024 + k0 + i]), s2 = silu_f(cctx[k0 + i]); a0 += w[i] * s0; a1 += w[i] * s1; a2 += w[i] * s2; }
            }
            if (ks == 0) { const f32x4 bb = *(const f32x4*)(b_ada + col); a0 += bb; a1 += bb; a2 += bb; }
#pragma unroll
            for (int i = 0; i < 4; ++i) { atomicAdd(mod + col + i, a0[i]); atomicAdd(mod + 6144 + col + i, a1[i]); atomicAdd(mod + 2 * 6144 + col + i, a2[i]); }
        }
        LAS float* scr = (LAS float*)(lds + RING_OFF + wave * 16384);
        constexpr int I_IN = 16 * 128, I_GLU = 8 * 16, I_PA = 8 * 32, I_OUT = 16 * 32, NIT = I_IN + I_GLU + 2 * I_PA + I_OUT;
        for (int it = gw; it < NIT; it += NGW) {
            int r = it;
            if (r < I_IN) { transpose_item<1>(args.in[I_WIN], 1024, 4096, (bf16*)(ws + WS_WIN), 1024, scr, r, lane); continue; } r -= I_IN;
            if (r < I_GLU) { transpose_item<0>(args.in[I_WGLU], 512, 512, (bf16*)(ws + WS_WGLU), 512, scr, r, lane); continue; } r -= I_GLU;
            if (r < I_PA) { transpose_item<0>(args.in[I_WPA], 512, 1024, (bf16*)(ws + WS_WPA), 1024, scr, r, lane); continue; } r -= I_PA;
            if (r < I_PA) { transpose_item<0>(args.in[I_WPB], 512, 1024, (bf16*)(ws + WS_WPA) + 512, 1024, scr, r, lane); continue; } r -= I_PA;
            transpose_item<0>(args.in[I_WOUT], 1024, 1024, (bf16*)(ws + WS_WOUT), 1024, scr, r, lane);
        }
        for (int dg = gw; dg < 64; dg += NGW) s5_prep(args, ws, dg, lane);
        if (BOTH(0)) xcd_barrier(bar);
    }
    TEND(0);
    TBEG(1);
    if (IN(1)) for (int rep_ = 0; rep_ <= ((PROBE_MASK >> 1) & 1) * PROBE_REPS; ++rep_) {
        const float* x = args.in[I_X]; const float* ctx = args.in[I_CTX]; const float* gwt = args.in[I_NMIX];
        for (int blk = gw; blk < MLAT / 8 + MCTX / 2; blk += NGW) {
            if (blk < MLAT / 8) norm1_rows(x + (size_t)blk * 8 * D, Hb + (size_t)blk * 8 * D, 8, gwt, mod + ((blk * 8) >> 13) * 6144, lane);
            else { const int r = (blk - MLAT / 8) * 2; norm1_rows(ctx + (size_t)r * D, Hb + (size_t)(MLAT + r) * D, 2, gwt, mod + 2 * 6144, lane); }
        }
        if (BOTH(1)) xcd_barrier(bar);
    }
    TEND(1);
    TBEG(2);
    if (IN(2)) for (int rep_ = 0; rep_ <= ((PROBE_MASK >> 2) & 1) * PROBE_REPS; ++rep_) {
        pg8::Gemm g{Hb, (const bf16*)(ws + WS_WIN), MALL, 4096, 1024};
        pg8::InprojOrder S; S.init(G, bx, true);
        pg8::EpiInproj E{(bf16*)(ws + WS_U), (bf16*)(ws + WS_Q), (bf16*)(ws + WS_K), (bf16*)(ws + WS_V), (bf16*)(ws + WS_SGA), (bf16*)(ws + WS_SGB), args.in[I_QN], args.in[I_KN]};
        pg8::gemm_phase<pg8::EpiInproj, pg8::InprojOrder, true>(lds + RING_OFF, g, S, E);
        {
            const int maxun = (1036 + G - 1) / G, heavy = 1036 - (maxun - 1) * G, light = heavy < G ? G - heavy : G;
            if (light == G || bx >= heavy) {
                LAS float* scr = (LAS float*)(lds + RING_OFF + wave * 16384);
                for (int it = (light == G ? bx : bx - heavy) * NWAVES + wave; it < 16 * 512; it += light * NWAVES)
                    transpose_item<0>(args.in[I_WED] + (size_t)(it >> 9) * 1048576, 1024, 1024, (bf16*)(ws + WS_WD) + (size_t)(it >> 9) * 1048576, 1024, scr, it & 511, lane);
            }
        }
        if (BOTH(2)) xcd_barrier(bar);
    }
    TEND(2);
#if defined(EXTRA_BARRIERS)
    if (IN(3)) for (int xb_ = 0; xb_ < EXTRA_BARRIERS; ++xb_) xcd_barrier(bar);
#endif
    TBEG(3);
    if (IN(3)) for (int rep_ = 0; rep_ <= ((PROBE_MASK >> 3) & 1) * PROBE_REPS; ++rep_) {
        for (int task = gw; task < 128 * S5_NPAIR; task += NGW) s5_pass1(ws, task, lane);
        if (BOTH(3)) xcd_barrier(bar);
    }
    TEND(3);
    TBEG(4);
    if (IN(4)) for (int rep_ = 0; rep_ <= ((PROBE_MASK >> 4) & 1) * PROBE_REPS; ++rep_) {
        { const int gid = gw * 64 + lane; if (gid < 8192 && (PROBE_VARIANT != 0 || rep_ == ((PROBE_MASK >> 4) & 1) * PROBE_REPS)) s5_pass2(ws, gid); }
        for (int unit = bx; unit < 256; unit += G) attn_unit(args, ws, lds + RING_OFF, unit, tid, lane, wave, rep_ < ((PROBE_MASK >> 4) & 1) * PROBE_REPS ? PROBE_VARIANT : 7);
        if (BOTH(4)) xcd_barrier(bar);
    }
    TEND(4);
    TBEG(5);
    if (IN(5)) for (int rep_ = 0; rep_ <= ((PROBE_MASK >> 5) & 1) * PROBE_REPS; ++rep_) {
        for (int task = gw; task < 4096; task += NGW) s5_pass3(args, ws, lds + RING_OFF + wave * 16384, task, lane);
        if (BOTH(5)) xcd_barrier(bar);
    }
    TEND(5);
    TBEG(6);
    if (IN(6)) for (int rep_ = 0; rep_ <= ((PROBE_MASK >> 6) & 1) * PROBE_REPS; ++rep_) {
        pg8::Gemm g{(const bf16*)(ws + WS_H), (const bf16*)(ws + WS_WGLU), MLAT, 512, 512};
        pg8::StaticOrder S; S.init(MLAT, 512, G, bx);
        pg8::EpiGlu E{(const bf16*)(ws + WS_H), args.in[I_BGLU], (bf16*)(ws + WS_YAB), 1024};
        pg8::gemm_phase<pg8::EpiGlu, pg8::StaticOrder, true>(lds + RING_OFF, g, S, E);
        if (G > 128 && bx >= 128) {
            LAS float* scr = (LAS float*)(lds + RING_OFF + wave * 16384);
            for (int it = (bx - 128) * NWAVES + wave; it < WGU_NLO * 1024; it += (G - 128) * NWAVES) { const int e = it >> 10, which = (it >> 9) & 1;
                if (which == 0) transpose_item<2>(args.in[I_WEG] + (size_t)e * 1048576, 1024, 1024, (bf16*)(ws + WS_WGU) + (size_t)e * 2097152, 1024, scr, it & 511, lane);
                else transpose_item<3>(args.in[I_WEU] + (size_t)e * 1048576, 1024, 1024, (bf16*)(ws + WS_WGU) + (size_t)e * 2097152, 1024, scr, it & 511, lane); }
        }
        if (BOTH(6)) xcd_barrier(bar);
    }
    TEND(6);
    TBEG(7);
    if (IN(7)) for (int rep_ = 0; rep_ <= ((PROBE_MASK >> 7) & 1) * PROBE_REPS; ++rep_) {
        pg8::Gemm g{(const bf16*)(ws + WS_YAB), (const bf16*)(ws + WS_WPA), MLAT, 1024, 1024};
        pg8::StaticOrder S; S.init(MLAT, 1024, G, bx);
        pg8::EpiMerge E{(const bf16*)(ws + WS_SGA), (const bf16*)(ws + WS_SGB), (bf16*)(ws + WS_M)};
        pg8::gemm_phase<pg8::EpiMerge, pg8::StaticOrder, true>(lds + RING_OFF, g, S, E);
        if (BOTH(7)) xcd_barrier(bar);
    }
    TEND(7);
    TBEG(8);
    if (IN(8)) for (int rep_ = 0; rep_ <= ((PROBE_MASK >> 8) & 1) * PROBE_REPS; ++rep_) {
        pg8::Gemm g{(const bf16*)(ws + WS_M), (const bf16*)(ws + WS_WOUT), MLAT, 1024, 1024};
        pg8::StaticOrder S; S.init(MLAT, 1024, G, bx);
        pg8::EpiOut E{args.in[I_X], mod, args.out};
        pg8::gemm_phase<pg8::EpiOut, pg8::StaticOrder, true>(lds + RING_OFF, g, S, E);
        if (BOTH(8)) xcd_barrier(bar);
    }
    TEND(8);
    TBEG(9);
    if (IN(9)) for (int rep_ = 0; rep_ <= ((PROBE_MASK >> 9) & 1) * PROBE_REPS; ++rep_) {
        const float* gwt = args.in[I_NFFN]; const float* w_router = args.in[I_WR]; float* AFF = (float*)(ws + WS_AFF);
        __syncthreads();
#pragma unroll
        for (int k = 0; k < 8; ++k) { const int idx4 = tid + 512 * k, c = idx4 >> 2, e4 = idx4 & 3;
            *(LAS f32x4*)(lds + RING_OFF + (((c >> 8) * 4 + (c & 3)) * 64 + ((c & 255) >> 2)) * 80 + e4 * 16) = *(const f32x4*)(w_router + (size_t)c * 16 + e4 * 4); }
        __syncthreads();
        for (int blk = gw; blk < MLAT / 8; blk += NGW) {
            const int row0 = blk * 8; const float* md = mod + (row0 >> 13) * 6144;
            f32x4 ca[4], cb[4];
#pragma unroll
            for (int j = 0; j < 4; ++j) { const int col = j * 256 + lane * 4; ca[j] = *(const f32x4*)(gwt + col) * (*(const f32x4*)(md + 4096 + col) + 1.f); cb[j] = *(const f32x4*)(md + 3072 + col); }
#pragma unroll 1
            for (int rr = 0; rr < 8; rr += 2) {
                const int rowa = row0 + rr, rowb = rowa + 1;
                const float* sa = args.out + (size_t)rowa * D; const float* sb = sa + D;
                f32x4 va[4], vb[4]; float ssa = 0.f, ssb = 0.f;
#pragma unroll
                for (int j = 0; j < 4; ++j) { va[j] = *(const f32x4*)(sa + j * 256 + lane * 4); vb[j] = *(const f32x4*)(sb + j * 256 + lane * 4); }
#pragma unroll
                for (int j = 0; j < 4; ++j) { ssa += (va[j][0] * va[j][0] + va[j][1] * va[j][1]) + (va[j][2] * va[j][2] + va[j][3] * va[j][3]); ssb += (vb[j][0] * vb[j][0] + vb[j][1] * vb[j][1]) + (vb[j][2] * vb[j][2] + vb[j][3] * vb[j][3]); }
                const float ra = rsqrtf(wave_sum(ssa) * (1.f / D) + EPS), rb = rsqrtf(wave_sum(ssb) * (1.f / D) + EPS);
                float la[16], lb[16];
#pragma unroll
                for (int e = 0; e < 16; ++e) { la[e] = 0.f; lb[e] = 0.f; }
#pragma unroll
                for (int j = 0; j < 4; ++j) {
                    const int col = j * 256 + lane * 4;
                    const f32x4 oa = va[j] * ra * ca[j] + cb[j], ob = vb[j] * rb * ca[j] + cb[j];
                    pg8::u32x2 w; w.x = pk2(oa[0], oa[1]); w.y = pk2(oa[2], oa[3]); *(pg8::u32x2*)(Hb + (size_t)rowa * D + col) = w;
                    w.x = pk2(ob[0], ob[1]); w.y = pk2(ob[2], ob[3]); *(pg8::u32x2*)(Hb + (size_t)rowb * D + col) = w;
#pragma unroll
                    for (int i = 0; i < 4; ++i) {
                        const LAS f32x4* wr = (const LAS f32x4*)(lds + RING_OFF + ((j * 4 + i) * 64 + lane) * 80);
#pragma unroll
                        for (int e4 = 0; e4 < 4; ++e4) { const f32x4 wv = wr[e4];
#pragma unroll
                            for (int e = 0; e < 4; ++e) { la[e4 * 4 + e] = fmaf(oa[i], wv[e], la[e4 * 4 + e]); lb[e4 * 4 + e] = fmaf(ob[i], wv[e], lb[e4 * 4 + e]); } }
                        __builtin_amdgcn_sched_barrier(0);
                    }
                }
#define FOLD_STEP(arr, n, mask) do { const bool hi_ = (lane & (mask)) != 0; _Pragma("unroll") for (int k_ = 0; k_ < (n); ++k_) { \
            const float send_ = hi_ ? arr[k_] : arr[(n) + k_], keep_ = hi_ ? arr[(n) + k_] : arr[k_]; arr[k_] = keep_ + __shfl_xor(send_, (mask)); } } while (0)
                FOLD_STEP(la, 8, 32); FOLD_STEP(lb, 8, 32); FOLD_STEP(la, 4, 16); FOLD_STEP(lb, 4, 16); FOLD_STEP(la, 2, 8); FOLD_STEP(lb, 2, 8); FOLD_STEP(la, 1, 4); FOLD_STEP(lb, 1, 4);
#undef FOLD_STEP
                float xa = la[0], xb = lb[0];
                xa += __shfl_xor(xa, 2); xb += __shfl_xor(xb, 2); xa += __shfl_xor(xa, 1); xb += __shfl_xor(xb, 1);
                float ma = xa, mb = xb;
#pragma unroll
                for (int o = 4; o < 64; o <<= 1) { ma = fmaxf(ma, __shfl_xor(ma, o)); mb = fmaxf(mb, __shfl_xor(mb, o)); }
                const float ea = expf(xa - ma), eb = expf(xb - mb); float sua = ea, sub = eb;
#pragma unroll
                for (int o = 4; o < 64; o <<= 1) { sua += __shfl_xor(sua, o); sub += __shfl_xor(sub, o); }
                if ((lane & 3) == 0) { const int e = ((lane >> 5) & 1) * 8 + ((lane >> 4) & 1) * 4 + ((lane >> 3) & 1) * 2 + ((lane >> 2) & 1);
                    AFF[(size_t)rowa * 16 + e] = ea / sua; AFF[(size_t)rowb * 16 + e] = eb / sub; }
            }
        }
        if (BOTH(9)) xcd_barrier(bar);
    }
    TEND(9);
    TBEG(10);
    if (IN(10)) for (int rep_ = 0; rep_ <= ((PROBE_MASK >> 10) & 1) * PROBE_REPS; ++rep_) {
        const bool split = G >= 64;
        if (!split || bx >= 32) {
            const int w2 = split ? (bx - 32) * NWAVES + wave : bx * NWAVES + wave, NW2 = (split ? G - 32 : G) * NWAVES;
            LAS float* scr = (LAS float*)(lds + RING_OFF + wave * 16384);
            auto mk = [&](int it) { const int e = it >> 10, which = (it >> 9) & 1; return TItem{(which ? args.in[I_WEU] : args.in[I_WEG]) + (size_t)e * 1048576, (bf16*)(ws + (e < WGU_NLO ? WS_WGU : WS_WGU_HI)) + (size_t)(e < WGU_NLO ? e : e - WGU_NLO) * 2097152, 1024, 1024, it & 511}; };
            int it = (G > 128 ? WGU_NLO * 1024 : 0) + w2; f32x4 lda[8], ldb[8];
            if (it < 16 * 2 * 512) titem_load(mk(it), lda, lane);
            while (it < 16 * 2 * 512) {
                const int itn = it + NW2, it2 = itn + NW2;
                if (itn < 16 * 2 * 512) titem_load(mk(itn), ldb, lane);
                if ((it >> 9) & 1) titem_finish<3>(mk(it), lda, scr, lane); else titem_finish<2>(mk(it), lda, scr, lane);
                if (itn >= 16 * 2 * 512) break;
                if (it2 < 16 * 2 * 512) titem_load(mk(it2), lda, lane);
                if ((itn >> 9) & 1) titem_finish<3>(mk(itn), ldb, scr, lane); else titem_finish<2>(mk(itn), ldb, scr, lane);
                it = it2;
            }
        }
        if (split) { if (bx < 32) topk_select(ws, lds_raw, bx, tid, lane, wave); }
        else { __syncthreads(); for (int be = bx; be < 32; be += G) topk_select(ws, lds_raw, be, tid, lane, wave); }
        if (BOTH(10)) xcd_barrier(bar);
    }
    TEND(10);
    TBEG(12);
    if (IN(12)) for (int rep_ = 0; rep_ <= ((PROBE_MASK >> 12) & 1) * PROBE_REPS; ++rep_) {
        pg8::Gemm g{Hb, (const bf16*)(ws + WS_WGU), 32768, 2048, 1024};
        pg8::ExpertOrder<8> S; S.init(G, bx, WGU_NLO, WGU_HI_PN);
        pg8::EpiHid E{(bf16*)(ws + WS_HID)};
        pg8::gemm_phase<pg8::EpiHid, pg8::ExpertOrder<8>, true, true, pg8::ExpertGather>(lds + RING_OFF, g, S, E, pg8::ExpertGather{(const int*)(ws + WS_IDX)});
        if (BOTH(12)) xcd_barrier(bar);
    }
    TEND(12);
    TBEG(13);
    if (IN(13)) for (int rep_ = 0; rep_ <= ((PROBE_MASK >> 13) & 1) * PROBE_REPS; ++rep_) {
        pg8::Gemm g{(const bf16*)(ws + WS_HID), (const bf16*)(ws + WS_WD), 32768, 1024, 1024};
        pg8::ExpertOrder<4> S; S.init(G, bx);
        pg8::EpiDown E{(const float*)(ws + WS_GSEL), (bf16*)(ws + WS_XE)};
        pg8::gemm_phase<pg8::EpiDown, pg8::ExpertOrder<4>, true>(lds + RING_OFF, g, S, E);
        if (BOTH(13)) xcd_barrier(bar);
    }
    TEND(13);
    TBEG(14);
    if (IN(14)) for (int rep_ = 0; rep_ <= ((PROBE_MASK >> 14) & 1) * PROBE_REPS; ++rep_) {
        const int* SLOT = (const int*)(ws + WS_SLOT); const bf16* Y = (const bf16*)(ws + WS_XE);
        for (int blk = gw; blk < MLAT / 8; blk += NGW) {
            const int row0 = blk * 8, b = row0 >> 13, t0 = row0 & 8191;
            const int sv0 = SLOT[(b * 16 + (lane & 15)) * 8192 + t0 + (lane >> 4)], sv1 = SLOT[(b * 16 + (lane & 15)) * 8192 + t0 + 4 + (lane >> 4)];
            f32x4 cg[4];
#pragma unroll
            for (int j = 0; j < 4; ++j) cg[j] = *(const f32x4*)(mod + b * 6144 + 5120 + j * 256 + lane * 4);
#pragma unroll 1
            for (int rp = 0; rp < 4; ++rp) {
                const int sv = rp < 2 ? sv0 : sv1, lbase = (rp & 1) * 32;
                unsigned mask = (unsigned)__builtin_amdgcn_readfirstlane((int)(unsigned)(__ballot(sv >= 0) >> lbase));
                float* oa = args.out + (size_t)(row0 + 2 * rp) * D + lane * 4; float* ob = oa + D;
                f32x4 xa[4], xb[4], aa[4], ab[4];
#pragma unroll
                for (int j = 0; j < 4; ++j) { xa[j] = *(const f32x4*)(oa + j * 256); xb[j] = *(const f32x4*)(ob + j * 256); aa[j] = (f32x4){0.f, 0.f, 0.f, 0.f}; ab[j] = aa[j]; }
                for (;;) {
                    const bf16* p[4]; float fa[4], fb[4];
#pragma unroll
                    for (int q = 0; q < 4; ++q) {
                        if (mask) { const int bit = __builtin_ctz(mask); mask &= mask - 1u; const int s = __builtin_amdgcn_readlane(sv, lbase + bit), e = bit & 15;
                            p[q] = Y + ((size_t)(b * 16 + e) * 1024 + s) * D; fa[q] = bit < 16 ? 1.f : 0.f; fb[q] = 1.f - fa[q]; }
                        else { p[q] = Y; fa[q] = 0.f; fb[q] = 0.f; }
                    }
                    pg8::u32x2 w[4][4];
#pragma unroll
                    for (int q = 0; q < 4; ++q)
#pragma unroll
                        for (int j = 0; j < 4; ++j) w[q][j] = *(const pg8::u32x2*)(p[q] + j * 256 + lane * 4);
#pragma unroll
                    for (int q = 0; q < 4; ++q)
#pragma unroll
                        for (int j = 0; j < 4; ++j) { const f32x4 v = {__uint_as_float(w[q][j].x << 16), __uint_as_float(w[q][j].x & 0xffff0000u), __uint_as_float(w[q][j].y << 16), __uint_as_float(w[q][j].y & 0xffff0000u)};
                            aa[j] += v * fa[q]; ab[j] += v * fb[q]; }
                    if (!mask) break;
                }
#pragma unroll
                for (int j = 0; j < 4; ++j) { *(f32x4*)(oa + j * 256) = xa[j] + cg[j] * aa[j]; *(f32x4*)(ob + j * 256) = xb[j] + cg[j] * ab[j]; }
            }
        }
    }
    TEND(14);
#if defined(TIME_MASK)
    if (bx == 0 && tid == 0) { const unsigned long long te_ = __builtin_amdgcn_s_memrealtime(); while (__builtin_amdgcn_s_memrealtime() - te_ < tacc_) __builtin_amdgcn_s_sleep(4); }
#endif
#undef IN
#undef BOTH
}
extern "C" void kernel_launch(void* const* d_in, const int* in_sizes, int n_in, void* d_out, int out_size, void* d_ws, size_t ws_size, hipStream_t stream) {
    static int grid = 0;
    if (grid == 0) {
        if (n_in != 29 || ws_size < WS_END) { fprintf(stderr, "kernel_launch: bad arguments (n_in %d, ws %zu)\n", n_in, ws_size); grid = -1; return; }
        int dev = 0, cus = 0;
        if (hipGetDevice(&dev) != hipSuccess || hipDeviceGetAttribute(&cus, hipDeviceAttributeMultiprocessorCount, dev) != hipSuccess) { grid = -1; return; }
        if (hipFuncSetAttribute((const void*)mega, hipFuncAttributeMaxDynamicSharedMemorySize, LDS_BYTES) != hipSuccess) { fprintf(stderr, "kernel_launch: hipFuncSetAttribute failed\n"); grid = -1; return; }
        (void)hipGetLastError();
        grid = cus;
    }
    if (grid < 0) return;
    float* out = (float*)d_out; unsigned char* ws = (unsigned char*)d_ws;
    (void)hipMemsetAsync(ws + WS_CTL, 0, CTL_ZERO_BYTES, stream);
    Args a{};
    for (int i = 0; i < 29; ++i) a.in[i] = (const float*)d_in[i];
    a.out = out; a.ws = ws;
#if defined(PROBE_LO)
    a.ph_lo = 0; a.ph_hi = PROBE_HI; a.li = 0;
    hipLaunchKernelGGL(mega, dim3(grid), dim3(NWAVES * 64), LDS_BYTES, stream, a);
    a.ph_lo = PROBE_LO; a.ph_hi = PROBE_HI; a.li = 1;
    hipLaunchKernelGGL(mega, dim3(grid), dim3(NWAVES * 64), LDS_BYTES, stream, a);
    a.ph_lo = PROBE_HI; a.ph_hi = 15; a.li = 2;
    hipLaunchKernelGGL(mega, dim3(grid), dim3(NWAVES * 64), LDS_BYTES, stream, a);
#elif defined(PER_PHASE)
    for (int k = 0; k < 15; ++k) { if (k == 11) continue; a.ph_lo = k; a.ph_hi = k + 1; a.li = 0; hipLaunchKernelGGL(mega, dim3(grid), dim3(NWAVES * 64), LDS_BYTES, stream, a); }
#else
    a.ph_lo = 0; a.ph_hi = 15; a.li = 0;
    hipLaunchKernelGGL(mega, dim3(grid), dim3(NWAVES * 64), LDS_BYTES, stream, a);
#endif
}
```

```cpp
#include <hip/hip_runtime.h>
#include <cstdio>
#include <cstdint>
#include <stdint.h>

__device__ __forceinline__ float bf2f(unsigned short v) { return __uint_as_float(((unsigned)v) << 16); }
__device__ __forceinline__ float silu_f(float x) { return x / (1.f + __expf(-x)); }
__device__ __forceinline__ float sigmoid_f(float x) { return 1.f / (1.f + __expf(-x)); }
__device__ __forceinline__ float gelu_tanh(float y) { return 0.5f * y * (1.f + tanhf(0.7978845608028654f * (y + 0.044715f * y * y * y))); }

constexpr int D = 1024, SEQ = 8192, MLAT = 16384, NCTX = 256, MCTX = 512, MALL = MLAT + MCTX;
constexpr float EPS = 1e-6f;
namespace pg8 {
#define PG8_LAS __attribute__((address_space(3)))
typedef unsigned short bf16_t;
typedef short bf16x8 __attribute__((ext_vector_type(8)));
typedef float f32x4 __attribute__((ext_vector_type(4)));
typedef unsigned u32x4 __attribute__((ext_vector_type(4)));
constexpr int BM = 256, BK = 64, HALF = 128, HTB = HALF * BK * 2  , STAGE_BYTES = 8 * HTB, NXCD = 8, WGM = 8;

__host__ __device__ __forceinline__ int lds_byte(int r, int c) { const int st = (r >> 4) * 2 + (c >> 5), rr = r & 15, cc = c & 31, ob = rr * 64 + cc * 2; return st * 1024 + (ob ^ (((ob >> 9) & 1) << 5)); }
__host__ __device__ __forceinline__ void stage_rc(int b, int& R, int& C) { const int st = b / 1024, sb = b % 1024, swz = sb ^ (((sb >> 9) & 1) << 5); R = (st >> 1) * 16 + swz / 64; C = (st & 1) * 32 + (swz % 64) / 2; }
__host__ __device__ __forceinline__ int perm32(int rho) { const int n = rho >> 4, i = rho & 15; return 8 * (i >> 2) + 4 * n + (i & 3); }

struct Unit { int pm, pn; };
struct Gemm { const bf16_t* A; const bf16_t* Bt; int M, N, K; };

struct StaticOrder {
    int nM, nN, nwg, G, c;
    __host__ __device__ void init(int M, int N, int G_, int c_) { nM = M / BM; nN = N / BM; nwg = nM * nN; G = G_; c = c_; }
    __host__ __device__ bool next(int i, Unit& u) const {
        const long L = (long)i * G + c; if (L >= nwg) return false;
        int wgid = (int)L; { const int q = nwg / NXCD, r = nwg % NXCD, xcd = wgid % NXCD, off = wgid / NXCD; wgid = (xcd < r ? xcd * (q + 1) : r * (q + 1) + (xcd - r) * q) + off; }
        const int nig = WGM * nN, gid = wgid / nig, fm = gid * WGM, gsz = (nM - fm) < WGM ? (nM - fm) : WGM;
        u.pm = fm + ((wgid % nig) % gsz); u.pn = (wgid % nig) / gsz; return true;
    }
    __device__ __forceinline__ void a_ready(const Unit&) const {}
    __device__ __forceinline__ void done(const Unit&) const {}
};

__device__ __forceinline__ unsigned cvt_pk_bf16(float lo, float hi) { unsigned r; asm volatile("v_cvt_pk_bf16_f32 %0, %1, %2" : "=v"(r) : "v"(lo), "v"(hi)); return r; }
typedef float f32x2 __attribute__((ext_vector_type(2)));
typedef unsigned u32x2 __attribute__((ext_vector_type(2)));
__device__ __forceinline__ u32x4 pack8(const f32x4 a, const f32x4 b) { u32x4 w; w.x = cvt_pk_bf16(a[0], a[1]); w.y = cvt_pk_bf16(a[2], a[3]); w.z = cvt_pk_bf16(b[0], b[1]); w.w = cvt_pk_bf16(b[2], b[3]); return w; }
__device__ __forceinline__ f32x4 sig4(const f32x4 v) { f32x4 r; r[0] = sigmoid_f(v[0]); r[1] = sigmoid_f(v[1]); r[2] = sigmoid_f(v[2]); r[3] = sigmoid_f(v[3]); return r; }
__device__ __forceinline__ void unpack8(const u32x4 w, f32x4& a, f32x4& b) {
    a[0] = __uint_as_float(w.x << 16); a[1] = __uint_as_float(w.x & 0xffff0000u); a[2] = __uint_as_float(w.y << 16); a[3] = __uint_as_float(w.y & 0xffff0000u);
    b[0] = __uint_as_float(w.z << 16); b[1] = __uint_as_float(w.z & 0xffff0000u); b[2] = __uint_as_float(w.w << 16); b[3] = __uint_as_float(w.w & 0xffff0000u); }

struct OneUnit {
    int pm, pn;
    __device__ bool next(int i, Unit& u) const { u.pm = pm; u.pn = pn; return i == 0; }
    __device__ __forceinline__ void a_ready(const Unit&) const {}
    __device__ __forceinline__ void done(const Unit&) const {}
};
struct InprojOrder {
    StaticOrder so; int G, c; bool with_ctx;
    __device__ void init(int G_, int c_, bool wc_) { so.init(MLAT, 4096, G_, c_); G = G_; c = c_; with_ctx = wc_; }
    __device__ bool next(int i, Unit& u) const {
        const long L = (long)i * G + c; if (L < 1024) return so.next(i, u);
        const int r = (int)(L - 1024); if (r >= 12 || !with_ctx) return false;
        const int j = r % 6; u.pm = 64 + r / 6; u.pn = j < 2 ? j : j + 2; return true;
    }
    __device__ __forceinline__ void a_ready(const Unit&) const {}
    __device__ __forceinline__ void done(const Unit&) const {}
};
struct EpiInproj {
    static constexpr bool PERM = true, AFTER_DRAIN = false, MID = false;
    bf16_t *U, *Q, *K, *V, *SGA, *SGB; const float *qn, *kn;
    __device__ __forceinline__ void operator()(const f32x4 (&acc)[2][2][4][2], const Unit& u, int wr, int wc, int fr, int fq) const {
        const int row0 = u.pm * BM + wr * 64 + fr, pn = u.pn;
        if (pn < 2 || pn == 6 || pn == 7) {
            bf16_t* base = (pn < 2 ? U : V) + (pn & 1) * 256 + wc * 32 + 8 * fq;
#pragma unroll
            for (int ai = 0; ai < 2; ++ai)
#pragma unroll
                for (int m = 0; m < 4; ++m) { bf16_t* rowp = base + (size_t)(row0 + ai * HALF + m * 16) * 512;
#pragma unroll
                    for (int bj = 0; bj < 2; ++bj) *(u32x4*)(rowp + bj * HALF) = pack8(acc[ai][bj][m][0], acc[ai][bj][m][1]); }
        } else if (pn < 6) {
            const bool isq = pn < 4; const float* wn = isq ? qn : kn; const float sc = isq ? 0.125f * 1.4426950408889634f : 1.f;
            bf16_t* base = (isq ? Q : K) + ((pn & 1) * 4 + wc) * 64 + 8 * fq;
            f32x4 wv[2][2];
#pragma unroll
            for (int bj = 0; bj < 2; ++bj)
#pragma unroll
                for (int n = 0; n < 2; ++n) wv[bj][n] = *(const f32x4*)(wn + 32 * bj + 8 * fq + 4 * n);
#pragma unroll
            for (int ai = 0; ai < 2; ++ai)
#pragma unroll
                for (int m = 0; m < 4; ++m) {
                    float ss = 0.f;
#pragma unroll
                    for (int bj = 0; bj < 2; ++bj)
#pragma unroll
                        for (int n = 0; n < 2; ++n) { const f32x4 x = acc[ai][bj][m][n]; ss += (x[0] * x[0] + x[1] * x[1]) + (x[2] * x[2] + x[3] * x[3]); }
                    ss += __shfl_xor(ss, 16); ss += __shfl_xor(ss, 32);
                    const float r = rsqrtf(ss * (1.f / 64.f) + EPS) * sc;
                    bf16_t* rowp = base + (size_t)(row0 + ai * HALF + m * 16) * 512;
#pragma unroll
                    for (int bj = 0; bj < 2; ++bj) *(u32x4*)(rowp + bj * 32) = pack8(acc[ai][bj][m][0] * r * wv[bj][0], acc[ai][bj][m][1] * r * wv[bj][1]);
                }
        } else {
            bf16_t* base = (pn < 12 ? SGA : SGB) + ((pn - 8) & 3) * 256 + wc * 32 + 8 * fq;
#pragma unroll
            for (int ai = 0; ai < 2; ++ai)
#pragma unroll
                for (int m = 0; m < 4; ++m) { bf16_t* rowp = base + (size_t)(row0 + ai * HALF + m * 16) * 1024;
#pragma unroll
                    for (int bj = 0; bj < 2; ++bj) *(u32x4*)(rowp + bj * HALF) = pack8(sig4(acc[ai][bj][m][0]), sig4(acc[ai][bj][m][1])); }
        }
    }
};
struct EpiGlu {
    static constexpr bool PERM = true, AFTER_DRAIN = false, MID = false;
    const bf16_t* Ain; const float* bglu; bf16_t* YA; int ldo;
    __device__ __forceinline__ void operator()(const f32x4 (&acc)[2][2][4][2], const Unit& u, int wr, int wc, int fr, int fq) const {
        const int row0 = u.pm * BM + wr * 64 + fr, col0 = u.pn * BM + wc * 32 + 8 * fq;
        f32x4 bv[2][2];
#pragma unroll
        for (int bj = 0; bj < 2; ++bj)
#pragma unroll
            for (int n = 0; n < 2; ++n) bv[bj][n] = *(const f32x4*)(bglu + col0 + bj * HALF + 4 * n);
#pragma unroll
        for (int ai = 0; ai < 2; ++ai)
#pragma unroll
            for (int m = 0; m < 4; ++m) { const size_t off = (size_t)(row0 + ai * HALF + m * 16) * 512 + col0, offo = (size_t)(row0 + ai * HALF + m * 16) * ldo + col0;
#pragma unroll
                for (int bj = 0; bj < 2; ++bj) { f32x4 a0, a1; unpack8(*(const u32x4*)(Ain + off + bj * HALF), a0, a1);
                    *(u32x4*)(YA + offo + bj * HALF) = pack8(a0 * sig4(acc[ai][bj][m][0] + bv[bj][0]), a1 * sig4(acc[ai][bj][m][1] + bv[bj][1])); } }
    }
};
struct EpiMerge {
    static constexpr bool PERM = true, AFTER_DRAIN = false, MID = true;
    const bf16_t* SGA; const bf16_t* SGB; bf16_t* Mo;
    __device__ __forceinline__ void mid(f32x4 (&acc)[2][2][4][2], const Unit& u, int wr, int wc, int fr, int fq) const {
        int row0_ = u.pm * BM + wr * 64 + fr, col0_ = u.pn * BM + wc * 32 + 8 * fq;
        asm volatile("" : "+v"(row0_), "+v"(col0_));
        const int row0 = row0_, col0 = col0_;
#pragma unroll
        for (int ai = 0; ai < 2; ++ai)
#pragma unroll
            for (int m = 0; m < 4; ++m) { const size_t off = (size_t)(row0 + ai * HALF + m * 16) * 1024 + col0;
#pragma unroll
                for (int bj = 0; bj < 2; ++bj) { f32x4 a0, a1, b0, b1; unpack8(*(const u32x4*)(SGA + off + bj * HALF), a0, a1); unpack8(*(const u32x4*)(SGB + off + bj * HALF), b0, b1);
#pragma unroll
                    for (int e = 0; e < 4; ++e) { acc[ai][bj][m][0][e] *= a0[e] * __builtin_amdgcn_rcpf(b0[e]); acc[ai][bj][m][1][e] *= a1[e] * __builtin_amdgcn_rcpf(b1[e]); } }
                if (m == 3) __builtin_amdgcn_sched_barrier(0); }
    }
    __device__ __forceinline__ void operator()(const f32x4 (&acc)[2][2][4][2], const Unit& u, int wr, int wc, int fr, int fq) const {
        int row0_ = u.pm * BM + wr * 64 + fr, col0_ = u.pn * BM + wc * 32 + 8 * fq;
        asm volatile("" : "+v"(row0_), "+v"(col0_));
        const int row0 = row0_, col0 = col0_;
#pragma unroll
        for (int ai = 0; ai < 2; ++ai)
#pragma unroll
            for (int m = 0; m < 4; ++m) { const size_t off = (size_t)(row0 + ai * HALF + m * 16) * 1024 + col0;
#pragma unroll
                for (int bj = 0; bj < 2; ++bj) { f32x4 b0, b1; unpack8(*(const u32x4*)(SGB + off + bj * HALF), b0, b1);
                    *(u32x4*)(Mo + off + bj * HALF) = pack8(acc[ai][bj][m][0] * b0, acc[ai][bj][m][1] * b1); } }
    }
};
struct ExpertGather { const int* idx; __device__ __forceinline__ unsigned row(int pm, int r) const { return (unsigned)((pm >> 6) * SEQ + idx[pm * BM + r]); } };
struct EpiOut {
    static constexpr bool PERM = false, AFTER_DRAIN = false, MID = false;
    const float* x; const float* mod; float* X1;
    __device__ __forceinline__ void operator()(const f32x4 (&acc)[2][2][4][2], const Unit& u, int wr, int wc, int fr, int fq) const {
        const int row0 = u.pm * BM + wr * 64 + fr, col0 = u.pn * BM + wc * 32 + 4 * fq;
        const float* g1 = mod + ((u.pm * BM) >> 13) * 6144 + 2048;
        f32x4 gv[2][2];
#pragma unroll
        for (int bj = 0; bj < 2; ++bj)
#pragma unroll
            for (int n = 0; n < 2; ++n) gv[bj][n] = *(const f32x4*)(g1 + col0 + bj * HALF + n * 16);
#pragma unroll
        for (int ai = 0; ai < 2; ++ai)
#pragma unroll
            for (int m = 0; m < 4; ++m) { const size_t off = (size_t)(row0 + ai * HALF + m * 16) * 1024 + col0;
#pragma unroll
                for (int bj = 0; bj < 2; ++bj)
#pragma unroll
                    for (int n = 0; n < 2; ++n) *(f32x4*)(X1 + off + bj * HALF + n * 16) = *(const f32x4*)(x + off + bj * HALF + n * 16) + gv[bj][n] * acc[ai][bj][m][n]; }
    }
};
struct EpiHid {
    static constexpr bool PERM = true, AFTER_DRAIN = false, MID = false;
    bf16_t* HID;
    __device__ __forceinline__ void operator()(const f32x4 (&acc)[2][2][4][2], const Unit& u, int wr, int wc, int fr, int fq) const {
        const int row0 = u.pm * BM + wr * 64 + fr, f0 = (u.pn & 7) * 128 + wc * 16 + 4 * fq;
#pragma unroll
        for (int ai = 0; ai < 2; ++ai)
#pragma unroll
            for (int m = 0; m < 4; ++m) { bf16_t* rowp = HID + (size_t)(row0 + ai * HALF + m * 16) * 1024 + f0;
#pragma unroll
                for (int bj = 0; bj < 2; ++bj) { const f32x4 g = acc[ai][bj][m][0], up = acc[ai][bj][m][1];
                    u32x2 w; w.x = cvt_pk_bf16(silu_f(g[0]) * up[0], silu_f(g[1]) * up[1]); w.y = cvt_pk_bf16(silu_f(g[2]) * up[2], silu_f(g[3]) * up[3]);
                    *(u32x2*)(rowp + bj * 64) = w; } }
    }
};
struct EpiDown {
    static constexpr bool PERM = true, AFTER_DRAIN = false, MID = false;
    const float* GSEL; bf16_t* Y;
    __device__ __forceinline__ void operator()(const f32x4 (&acc)[2][2][4][2], const Unit& u, int wr, int wc, int fr, int fq) const {
        const int row0 = u.pm * BM + wr * 64 + fr, col0 = (u.pn & 3) * BM + wc * 32 + 8 * fq;
#pragma unroll
        for (int ai = 0; ai < 2; ++ai)
#pragma unroll
            for (int m = 0; m < 4; ++m) { const int row = row0 + ai * HALF + m * 16; const float gs = GSEL[row]; bf16_t* rowp = Y + (size_t)row * 1024 + col0;
#pragma unroll
                for (int bj = 0; bj < 2; ++bj) *(u32x4*)(rowp + bj * HALF) = pack8(acc[ai][bj][m][0] * gs, acc[ai][bj][m][1] * gs); }
    }
};
template <int NT  > struct ExpertOrder {
    int G, c, e_hi, pn_hi;
    __device__ void init(int G_, int c_, int e_hi_ = 16, int pn_hi_ = 0) { G = G_; c = c_; e_hi = e_hi_; pn_hi = pn_hi_; }
    __device__ bool next(int i, Unit& u) const {
        constexpr int UPE = 8 * NT;
        long L = (long)i * G + c; if (L >= 16 * UPE) return false;
        if (G == 256) { const int xcd = c & 7, local = c >> 3, rpe = UPE / 32  ; L = (long)(xcd + 8 * (i / rpe)) * UPE + (i % rpe) * 32 + local; }
        const int e = (int)(L / UPE), uu = (int)(L % UPE), b = uu / (4 * NT), m = (uu / NT) & 3, j = uu % NT;
        u.pm = (b * 16 + e) * 4 + m; u.pn = e * NT + j + (e >= e_hi ? pn_hi : 0); return true;
    }
    __device__ __forceinline__ void a_ready(const Unit&) const {}
    __device__ __forceinline__ void done(const Unit&) const {}
};
struct NoGather { __device__ __forceinline__ unsigned row(int, int r) const { return (unsigned)r; } };
template <class Epi, class Sched, bool ALIGN_EPI = false, bool GATHER = false, class Gat = NoGather>
__device__ __forceinline__ void gemm_phase(PG8_LAS unsigned char* lds, const Gemm g, const Sched& S, const Epi& E, const Gat gat = Gat()) {
    const int tid = threadIdx.x, wid = __builtin_amdgcn_readfirstlane(tid >> 6), lane = tid & 63, wr = wid >> 2, wc = wid & 3, fr = lane & 15, fq = lane >> 4;
    const int K = g.K, nt = K / BK;
    const size_t kstep = (size_t)(BK * 2);
    const size_t hstep = (size_t)HALF * K * 2;
    const size_t tstep = 2 * hstep;
    unsigned voffB[2]; int Ra[2], Ca[2];
#pragma unroll
    for (int i = 0; i < 2; ++i) { int R, C; stage_rc(tid * 16 + i * 8192, R, C); const int Rb = Epi::PERM ? ((R & ~31) + perm32(R & 31)) : R;
        Ra[i] = R; Ca[i] = C; voffB[i] = (unsigned)(Rb * K + C) * 2u; }
    unsigned vAc[2][2], vAn[2][2];
#define PG8_AOFF(dst, pm) do { _Pragma("unroll") for (int h_ = 0; h_ < 2; ++h_) _Pragma("unroll") for (int i_ = 0; i_ < 2; ++i_) \
        dst[h_][i_] = GATHER ? (gat.row((pm), h_ * HALF + Ra[i_]) * (unsigned)K + (unsigned)Ca[i_]) * 2u : (unsigned)((h_ * HALF + Ra[i_]) * K + Ca[i_]) * 2u; } while (0)
    const unsigned ldsw = (unsigned)wid * 1024u;
    const int aoff = lds_byte(wr * 64 + fr, fq * 8), boff = lds_byte(wc * 32 + fr, fq * 8);
#define PG8_SA(b, h) (((b) * 2 + (h)) * HTB)
#define PG8_SB(b, h) ((4 + (b) * 2 + (h)) * HTB)
#define PG8_STAGE(bufoff, gbase, voff) do { _Pragma("unroll") for (int _i = 0; _i < 2; ++_i) \
        __builtin_amdgcn_global_load_lds((const unsigned*)((const char*)(gbase) + (voff)[_i]), (PG8_LAS unsigned*)(lds + (bufoff) + ldsw + _i * 8192), 16, 0, 0); } while (0)
#define PG8_LDA(dst, b, h) do { _Pragma("unroll") for (int m = 0; m < 4; ++m) _Pragma("unroll") for (int k = 0; k < 2; ++k) dst[m][k] = *(const PG8_LAS bf16x8*)(lds + PG8_SA(b, h) + aoff + m * 2048 + k * 1024); } while (0)
#define PG8_LDB(dst, b, h) do { _Pragma("unroll") for (int n = 0; n < 2; ++n) _Pragma("unroll") for (int k = 0; k < 2; ++k) dst[n][k] = *(const PG8_LAS bf16x8*)(lds + PG8_SB(b, h) + boff + n * 2048 + k * 1024); } while (0)
#define PG8_MMA(ai, bj, At, Bt) do { __builtin_amdgcn_s_setprio(1); _Pragma("unroll") for (int m = 0; m < 4; ++m) _Pragma("unroll") for (int n = 0; n < 2; ++n) _Pragma("unroll") for (int k = 0; k < 2; ++k) \
        acc[ai][bj][m][n] = __builtin_amdgcn_mfma_f32_16x16x32_bf16(Bt[n][k], At[m][k], acc[ai][bj][m][n], 0, 0, 0); __builtin_amdgcn_s_setprio(0); } while (0)
#define PG8_WAIT_V(n) asm volatile("s_waitcnt vmcnt(" #n ")" ::: "memory")
#define PG8_WAIT_L(n) asm volatile("s_waitcnt lgkmcnt(" #n ")" ::: "memory")
#define PG8_BAR __builtin_amdgcn_s_barrier()
#define PG8_SCHED __builtin_amdgcn_sched_barrier(0)
    Unit cur, nxt; int ui = 0;
    if (!S.next(0, cur)) return;
    f32x4 acc[2][2][4][2];
#pragma unroll
    for (int a = 0; a < 2; ++a)
#pragma unroll
        for (int b = 0; b < 2; ++b)
#pragma unroll
            for (int m = 0; m < 4; ++m)
#pragma unroll
                for (int n = 0; n < 2; ++n) acc[a][b][m][n] = (f32x4){0.f, 0.f, 0.f, 0.f};
    bf16x8 At[4][2], B0[2][2], B1[2][2];
    const char* cA = (const char*)g.A + (GATHER ? (size_t)0 : (size_t)cur.pm * tstep); const char* cB = (const char*)g.Bt + (size_t)cur.pn * tstep;
    PG8_AOFF(vAc, cur.pm);
    S.a_ready(cur);
    PG8_STAGE(PG8_SB(0, 0), cB, voffB); PG8_STAGE(PG8_SB(0, 1), cB + hstep, voffB); PG8_STAGE(PG8_SA(0, 0), cA, vAc[0]); PG8_STAGE(PG8_SA(0, 1), cA, vAc[1]);
    if (wr == 1) PG8_BAR;
    PG8_WAIT_V(2); PG8_BAR;
    PG8_STAGE(PG8_SB(1, 0), cB + kstep, voffB); PG8_STAGE(PG8_SA(1, 0), cA + kstep, vAc[0]); PG8_STAGE(PG8_SB(1, 1), cB + hstep + kstep, voffB);
    PG8_WAIT_V(6); PG8_BAR;
    for (;;) {
        const bool has_next = S.next(ui + 1, nxt);
        const char* nA = (has_next && !GATHER) ? (const char*)g.A + (size_t)nxt.pm * tstep : cA; const char* nB = has_next ? (const char*)g.Bt + (size_t)nxt.pn * tstep : cB;
        if (has_next) PG8_AOFF(vAn, nxt.pm); else { _Pragma("unroll") for (int h_ = 0; h_ < 2; ++h_) _Pragma("unroll") for (int i_ = 0; i_ < 2; ++i_) vAn[h_][i_] = vAc[h_][i_]; }
        for (int t = 0; t < nt; t += 2) {
            const bool last = (t == nt - 2);
            const char* a1 = cA + (size_t)(t + 1) * kstep;
            const char* a2 = last ? nA : cA + (size_t)(t + 2) * kstep; const char* b2 = last ? nB : cB + (size_t)(t + 2) * kstep;
            const char* a3 = a2 + kstep; const char* b3 = b2 + kstep;
            unsigned v2[2][2];
#pragma unroll
            for (int h_ = 0; h_ < 2; ++h_)
#pragma unroll
                for (int i_ = 0; i_ < 2; ++i_) v2[h_][i_] = last ? vAn[h_][i_] : vAc[h_][i_];
            if (last && has_next) S.a_ready(nxt);
            PG8_LDB(B0, 0, 0); PG8_LDB(B1, 0, 1); PG8_SCHED; PG8_LDA(At, 0, 0); PG8_STAGE(PG8_SA(1, 1), a1, vAc[1]);
            PG8_WAIT_V(8); PG8_WAIT_L(0); PG8_BAR; PG8_MMA(0, 0, At, B0); PG8_MMA(0, 1, At, B1); PG8_BAR; PG8_SCHED;
            PG8_LDA(At, 0, 1); PG8_STAGE(PG8_SB(0, 0), b2, voffB); PG8_STAGE(PG8_SB(0, 1), b2 + hstep, voffB); PG8_STAGE(PG8_SA(0, 0), a2, v2[0]);
            PG8_WAIT_V(8); PG8_WAIT_L(0); PG8_BAR; PG8_MMA(1, 0, At, B0); PG8_MMA(1, 1, At, B1); PG8_BAR; PG8_SCHED;
            PG8_LDB(B0, 1, 0); PG8_LDB(B1, 1, 1); PG8_SCHED; PG8_LDA(At, 1, 0); PG8_STAGE(PG8_SA(0, 1), a2, v2[1]);
            PG8_WAIT_V(8); PG8_WAIT_L(0); PG8_BAR; PG8_MMA(0, 0, At, B0); PG8_MMA(0, 1, At, B1); PG8_BAR; PG8_SCHED;
            PG8_LDA(At, 1, 1); PG8_STAGE(PG8_SB(1, 0), b3, voffB); PG8_STAGE(PG8_SB(1, 1), b3 + hstep, voffB); PG8_STAGE(PG8_SA(1, 0), a3, v2[0]);
            PG8_WAIT_V(8); PG8_WAIT_L(0); PG8_BAR; PG8_MMA(1, 0, At, B0); PG8_MMA(1, 1, At, B1); PG8_BAR; PG8_SCHED;
            if constexpr (Epi::MID) { if (t == nt / 2 - 2) { E.mid(acc, cur, wr, wc, fr, fq); PG8_SCHED; } }
        }
        if constexpr (ALIGN_EPI) { if (wr == 0) PG8_BAR; }
        if constexpr (!Epi::AFTER_DRAIN) { E(acc, cur, wr, wc, fr, fq); S.done(cur); }
        if (!has_next) break;
#pragma unroll
        for (int a = 0; a < 2; ++a)
#pragma unroll
            for (int b = 0; b < 2; ++b)
#pragma unroll
                for (int m = 0; m < 4; ++m)
#pragma unroll
                    for (int n = 0; n < 2; ++n) acc[a][b][m][n] = (f32x4){0.f, 0.f, 0.f, 0.f};
        cur = nxt; cA = nA; cB = nB; ++ui;
#pragma unroll
        for (int h_ = 0; h_ < 2; ++h_)
#pragma unroll
            for (int i_ = 0; i_ < 2; ++i_) vAc[h_][i_] = vAn[h_][i_];
        if constexpr (ALIGN_EPI) { if (wr == 1) PG8_BAR; }
    }
    PG8_WAIT_V(0);
    if constexpr (!ALIGN_EPI) { if (wr == 0) PG8_BAR; }
    PG8_BAR;
    if constexpr (Epi::AFTER_DRAIN) { E.fused(acc, cur, wr, wc, fr, fq, lds, wid, lane); S.done(cur); }
#undef PG8_AOFF
#undef PG8_SA
#undef PG8_SB
#undef PG8_STAGE
#undef PG8_LDA
#undef PG8_LDB
#undef PG8_MMA
#undef PG8_WAIT_V
#undef PG8_WAIT_L
#undef PG8_BAR
#undef PG8_SCHED
}
}
#define GAS __attribute__((address_space(1)))
#define LAS __attribute__((address_space(3)))
typedef unsigned short bf16;
typedef unsigned v4u __attribute__((ext_vector_type(4)));
typedef float f32x4 __attribute__((ext_vector_type(4)));
typedef short bf16x8 __attribute__((ext_vector_type(8)));
typedef GAS unsigned gu32;
typedef GAS unsigned long long gu64;
#define RLX_AGENT __ATOMIC_RELAXED, __HIP_MEMORY_SCOPE_AGENT
#define LDS_WAIT() asm volatile("s_waitcnt lgkmcnt(0)" ::: "memory")
#define VM_WAIT() asm volatile("s_waitcnt vmcnt(0)" ::: "memory")
__device__ __forceinline__ unsigned long long rt() { return __builtin_amdgcn_s_memrealtime(); }
__device__ __forceinline__ unsigned f2bf(float f) { unsigned u = __builtin_bit_cast(unsigned, f); return (u + 0x7fffu + ((u >> 16) & 1u)) >> 16; }
__device__ __forceinline__ unsigned pk2(float lo, float hi) { return f2bf(lo) | (f2bf(hi) << 16); }

#define XB_TMO      128
#define XB_XCNT(j)  (256  + 64 * (j))
#define XB_XSUB(j)  (1280 + 64 * (j))
#define XB_XGEN(j)  (2304 + 64 * (j))
#define XB_TOP      3328
#define XB_TOPGEN   3392
#define XCD_BAR_WORDS 3456
#define XB_SPIN_CAP (1u << 18)

__device__ __forceinline__ unsigned xb_ld(unsigned* p)              { return __hip_atomic_load(p, __ATOMIC_RELAXED, __HIP_MEMORY_SCOPE_AGENT); }
__device__ __forceinline__ unsigned xb_add(unsigned* p, unsigned v) { return __hip_atomic_fetch_add(p, v, __ATOMIC_RELAXED, __HIP_MEMORY_SCOPE_AGENT); }
__device__ __forceinline__ unsigned xb_xcc_id() { return (unsigned)__builtin_amdgcn_s_getreg((3 << 11) | 20) & 0xFu; }
#define XB_SPIN(cond, bar) do { unsigned _sp = 0; while (cond) { __builtin_amdgcn_s_sleep(1); \
    if ((++_sp & 255u) == 0u) { if (xb_ld(&(bar)[XB_TMO])) break; if (_sp > XB_SPIN_CAP) { atomicAdd(&(bar)[XB_TMO], 1u); break; } } } } while (0)

struct XcdBarrier {
    unsigned* bar; unsigned x;
    volatile LAS unsigned* st;
};

__device__ __forceinline__ XcdBarrier xcd_barrier_post(unsigned* bar, volatile LAS unsigned* st) {
    XcdBarrier b; b.bar = bar; b.x = xb_xcc_id(); b.st = st;
    if (threadIdx.x == 0) (void)xb_add(&bar[XB_XCNT(b.x)], 1u);
    return b;
}
__device__ __forceinline__ void xcd_barrier_complete(unsigned* bar, unsigned x, unsigned& nloc, unsigned& nx) {
    const unsigned G = gridDim.x * gridDim.y * gridDim.z;
    unsigned sum, cnt, mine, sp = 0u;
    for (;;) {
        sum = 0u; cnt = 0u; mine = 0u;
#pragma unroll
        for (unsigned j = 0; j < 16; ++j) { const unsigned c = xb_ld(&bar[XB_XCNT(j)]); sum += c; cnt += (c > 0u) ? 1u : 0u; mine = (j == x) ? c : mine; }
        if (sum == G) break;
        __builtin_amdgcn_s_sleep(1);
        if ((++sp & 255u) == 0u) { if (xb_ld(&bar[XB_TMO])) break; if (sp > XB_SPIN_CAP) { atomicAdd(&bar[XB_TMO], 1u); break; } }
    }
    nloc = mine > 0u ? mine : 1u; nx = cnt > 0u ? cnt : 1u;
}

__device__ __forceinline__ void xcd_barrier(const XcdBarrier& b) {
    asm volatile("s_waitcnt vmcnt(0)" ::: "memory");
    __syncthreads();
    if (threadIdx.x == 0) {
        unsigned* bar = b.bar;
        __builtin_amdgcn_s_waitcnt(0);
        unsigned nloc = b.st[0], nx = b.st[1];
        if (nloc == 0u) { xcd_barrier_complete(bar, b.x, nloc, nx); b.st[0] = nloc; b.st[1] = nx; }
        const unsigned old = xb_add(&bar[XB_XSUB(b.x)], 1u);
        const unsigned gen = old / nloc;
        if (old + 1u == (gen + 1u) * nloc) {
            __builtin_amdgcn_fence(__ATOMIC_RELEASE, "agent");
            asm volatile("s_waitcnt vmcnt(0)" ::: "memory");
            const unsigned og = xb_add(&bar[XB_TOP], 1u);
            const unsigned tg = og / nx;
            if (og + 1u == (tg + 1u) * nx) xb_add(&bar[XB_TOPGEN], 1u);
            else XB_SPIN(xb_ld(&bar[XB_TOPGEN]) == tg, bar);
            __builtin_amdgcn_fence(__ATOMIC_ACQUIRE, "agent");
            xb_add(&bar[XB_XGEN(b.x)], 1u);
            asm volatile("s_waitcnt vmcnt(0)" ::: "memory");
        } else {
            XB_SPIN(xb_ld(&bar[XB_XGEN(b.x)]) == gen, bar);
            __builtin_amdgcn_fence(__ATOMIC_ACQUIRE, "agent");
            asm volatile("s_waitcnt vmcnt(0)" ::: "memory");
        }
    }
    __syncthreads();
}

#ifndef PROBE_MASK
#define PROBE_MASK 0
#endif
#ifndef PROBE_VARIANT
#define PROBE_VARIANT 7
#endif
#ifndef PROBE_REPS
#define PROBE_REPS 4
#endif
constexpr int NWAVES = 8;
constexpr size_t MiB = 1u << 20;
constexpr size_t WS_CTL = 0, CTL_ZERO_BYTES = 256 * 1024;
constexpr int CW_TMO = 0, CW_CODE = 1, CW_BAR = 4096;
constexpr size_t WS_MOD = 160 * 1024;
constexpr size_t WS_AFF = 1 * MiB, WS_IDX = 2 * MiB, WS_GSEL = 2 * MiB + 256 * 1024, WS_SLOT = 3 * MiB;
constexpr size_t WS_H = 4 * MiB;
constexpr size_t WS_BG = 38 * MiB;
constexpr size_t WS_U = WS_BG, WS_V = WS_BG + 17 * MiB, WS_K = WS_BG + 34 * MiB, WS_Q = WS_BG + 51 * MiB, WS_SGA = WS_BG + 68 * MiB, WS_SGB = WS_BG + 100 * MiB;
constexpr size_t WS_YS = WS_BG + 132 * MiB, WS_YAB = WS_BG + 156 * MiB;
constexpr size_t WS_M = WS_BG;
constexpr size_t WS_XE = WS_BG, WS_HID = WS_BG + 132 * MiB;
constexpr size_t WS_WIN = 226 * MiB, WS_WGLU = 234 * MiB, WS_WPA = 235 * MiB, WS_WOUT = 237 * MiB;
constexpr size_t WS_WD = 239 * MiB;
constexpr int WGU_NLO = 8;
constexpr size_t WS_WGU = 271 * MiB, WS_WGU_HI = 107 * MiB, WS_END = 303 * MiB;
constexpr int WGU_HI_PN = (int)(((long)WS_WGU_HI - (long)WS_WGU) / (512 * 1024)) - 8 * WGU_NLO;
static_assert(((long)WS_WGU - (long)WS_WGU_HI) % (4 * (long)MiB) == 0 && WS_WGU_HI + (16 - WGU_NLO) * 4 * MiB <= WS_HID && WS_XE + 64 * MiB <= WS_WGU_HI && WS_WD + 32 * MiB <= WS_WGU, "gate|up halves");
static_assert(WS_YAB + 32 * MiB <= WS_WIN && WS_HID + 64 * MiB <= WS_WD && WS_WOUT + 2 * MiB <= WS_WD, "d_ws map");
static_assert(CW_BAR * 4 + 8 * XCD_BAR_WORDS * 4 <= (int)WS_MOD && WS_MOD + 3 * 6144 * 4 <= CTL_ZERO_BYTES, "control region");

constexpr int RING_OFF = 0, RING_BYTES = 131072;
constexpr int LDSCTL_OFF = RING_BYTES, MISC_OFF = LDSCTL_OFF + 320;
constexpr int LDS_BYTES = 147456;

__device__ __forceinline__ float wave_sum(float v) {
#pragma unroll
    for (int o = 1; o < 64; o <<= 1) v += __shfl_xor(v, o);
    return v;
}
template <int MODE> __device__ __forceinline__ int wrow(int n) {
    if (MODE == 1) { const int t = n >> 8, cl = n & 255; return (t >= 2 && t < 6) ? (t * 256 + 128 * ((cl >> 5) & 1) + 32 * (cl >> 6) + (cl & 31)) : n; }
    if (MODE == 2) return (n >> 2) * 8 + (n & 3);
    if (MODE == 3) return (n >> 2) * 8 + 4 + (n & 3);
    return n;
}
struct TItem { const float* W; bf16* WT; int N, ldw, item; };
__device__ __forceinline__ void titem_load(const TItem& t, f32x4 (&ld)[8], int lane) {
    const int nblk = t.N / 32, k0 = 64 * (t.item / nblk), n0 = 32 * (t.item % nblk);
#pragma unroll
    for (int i = 0; i < 8; ++i) ld[i] = *(const f32x4*)(t.W + (size_t)(k0 + 8 * i + (lane >> 3)) * t.N + n0 + 4 * (lane & 7));
}
template <int MODE> __device__ __forceinline__ void titem_finish(const TItem& t, const f32x4 (&ld)[8], LAS float* scr, int lane) {
    const int nblk = t.N / 32, k0 = 64 * (t.item / nblk), n0 = 32 * (t.item % nblk);
#pragma unroll
    for (int i = 0; i < 8; ++i) { LAS float* d = scr + (8 * i + (lane >> 3)) * 33 + 4 * (lane & 7); d[0] = ld[i][0]; d[1] = ld[i][1]; d[2] = ld[i][2]; d[3] = ld[i][3]; }
    LDS_WAIT(); asm volatile("" ::: "memory");
    const int c = lane & 7;
#pragma unroll
    for (int j = 0; j < 4; ++j) { const int n = (lane >> 3) + 8 * j; const LAS float* s = scr + (8 * c) * 33 + n;
        v4u o; o.x = pk2(s[0 * 33], s[1 * 33]); o.y = pk2(s[2 * 33], s[3 * 33]); o.z = pk2(s[4 * 33], s[5 * 33]); o.w = pk2(s[6 * 33], s[7 * 33]);
        *(GAS v4u*)(t.WT + (size_t)wrow<MODE>(n0 + n) * t.ldw + k0 + 8 * c) = o; }
    LDS_WAIT(); asm volatile("" ::: "memory");
}
template <int MODE> __device__ __forceinline__ void transpose_item(const float* W, int K, int N, bf16* WT, int ldw, LAS float* scr, int item, int lane) {
    const TItem t{W, WT, N, ldw, item}; f32x4 ld[8]; titem_load(t, ld, lane); titem_finish<MODE>(t, ld, scr, lane);
}
__device__ __forceinline__ void norm1_rows(const float* src0, bf16* dst0, int nrow, const float* gwt, const float* md, int lane) {
    f32x4 ca[4], cb[4];
#pragma unroll
    for (int j = 0; j < 4; ++j) { const int col = j * 256 + lane * 4; ca[j] = *(const f32x4*)(gwt + col) * (*(const f32x4*)(md + 1024 + col) + 1.f); cb[j] = *(const f32x4*)(md + col); }
    f32x4 na[4], nb[4];
#pragma unroll
    for (int j = 0; j < 4; ++j) { na[j] = *(const f32x4*)(src0 + j * 256 + lane * 4); nb[j] = *(const f32x4*)(src0 + (size_t)(nrow > 1 ? 1 : 0) * D + j * 256 + lane * 4); }
#pragma unroll 1
    for (int rr = 0; rr < nrow; rr += 2) {
        const int rb_ = (rr + 1 < nrow) ? rr + 1 : rr;
        f32x4 va[4], vb[4]; float ssa = 0.f, ssb = 0.f;
#pragma unroll
        for (int j = 0; j < 4; ++j) { va[j] = na[j]; vb[j] = nb[j]; }
        if (rr + 2 < nrow) { const int r2 = rr + 2, r3 = (rr + 3 < nrow) ? rr + 3 : rr + 2;
#pragma unroll
            for (int j = 0; j < 4; ++j) { na[j] = *(const f32x4*)(src0 + (size_t)r2 * D + j * 256 + lane * 4); nb[j] = *(const f32x4*)(src0 + (size_t)r3 * D + j * 256 + lane * 4); } }
#pragma unroll
        for (int j = 0; j < 4; ++j) { ssa += (va[j][0] * va[j][0] + va[j][1] * va[j][1]) + (va[j][2] * va[j][2] + va[j][3] * va[j][3]); ssb += (vb[j][0] * vb[j][0] + vb[j][1] * vb[j][1]) + (vb[j][2] * vb[j][2] + vb[j][3] * vb[j][3]); }
        const float ra = rsqrtf(wave_sum(ssa) * (1.f / D) + EPS), rb = rsqrtf(wave_sum(ssb) * (1.f / D) + EPS);
#pragma unroll
        for (int j = 0; j < 4; ++j) {
            const int col = j * 256 + lane * 4;
            const f32x4 oa = va[j] * ra * ca[j] + cb[j], ob = vb[j] * rb * ca[j] + cb[j];
            pg8::u32x2 w; w.x = pk2(oa[0], oa[1]); w.y = pk2(oa[2], oa[3]); *(pg8::u32x2*)(dst0 + (size_t)rr * D + col) = w;
            w.x = pk2(ob[0], ob[1]); w.y = pk2(ob[2], ob[3]); *(pg8::u32x2*)(dst0 + (size_t)rb_ * D + col) = w;
        }
    }
}

struct Args { const float* in[29]; float* out; unsigned char* ws; int ph_lo, ph_hi, li, pad; };
enum { I_X = 0, I_C, I_CTX, I_CCTX, I_WADA, I_BADA, I_NMIX, I_NFFN, I_WIN, I_LRE, I_LIM, I_LDT, I_BRE, I_BIM, I_CRE, I_CIM, I_SD, I_WGLU, I_BGLU, I_QN, I_KN, I_RPB, I_WPA, I_WPB, I_WOUT, I_WR, I_WEG, I_WEU, I_WED };

typedef float f32x16 __attribute__((ext_vector_type(16)));
constexpr int S5_CH = 64, S5_NCH = 132, S5_NST = S5_CH / 16, S5_NPAIR = S5_NCH / 2, S5_NLAT = SEQ / S5_CH, S5_NCC = NCTX / S5_CH;
constexpr size_t WS_LAM = 512 * 1024, WS_LAMP = 512 * 1024 + 32768;
constexpr size_t WS_S5B = 2 * MiB + 512 * 1024, WS_S5C = 2 * MiB + 768 * 1024;
constexpr size_t WS_SEND = WS_YS, WS_HIN = WS_YS + 12 * MiB;

__device__ __forceinline__ void s5_prep(const Args& args, unsigned char* ws, int dg, int lane) {
    const float* lam_re = args.in[I_LRE]; const float* lam_im = args.in[I_LIM]; const float* b_re = args.in[I_BRE]; const float* b_im = args.in[I_BIM];
    const float* c_re = args.in[I_CRE]; const float* c_im = args.in[I_CIM];
    const float dt = expf(args.in[I_LDT][dg]);
    {
        const int p = lane; const float lre = lam_re[dg * 64 + p], lim = lam_im[dg * 64 + p];
        const float er = expf(lre * dt); float xr = er * cosf(lim * dt), xi = er * sinf(lim * dt);
        float* L = (float*)(ws + WS_LAM) + (dg * 64 + p) * 2; L[0] = xr; L[1] = xi;
#pragma unroll
        for (int s = 0; s < 6; ++s) { const float nr = xr * xr - xi * xi, ni = 2.f * xr * xi; xr = nr; xi = ni; }
        float* LP = (float*)(ws + WS_LAMP) + (dg * 64 + p) * 2; LP[0] = xr; LP[1] = xi;
    }
    const int r = lane & 31, h = lane >> 5;
#pragma unroll
    for (int q = 0; q < 4; ++q) {
        const int p = 2 * r + (q >> 1); const float lre = lam_re[dg * 64 + p], lim = lam_im[dg * 64 + p];
        const float er = expf(lre * dt), lbr = er * cosf(lim * dt), lbi = er * sinf(lim * dt);
        const float nr = lbr - 1.f, ni = lbi, den = lre * lre + lim * lim, cr = (nr * lre + ni * lim) / den, ci = (ni * lre - nr * lim) / den;
        unsigned w[4];
#pragma unroll
        for (int jj = 0; jj < 8; jj += 2) {
            float v[2];
#pragma unroll
            for (int e = 0; e < 2; ++e) { const int c = 8 * h + jj + e; const float br = b_re[(dg * 64 + p) * 16 + c], bi = b_im[(dg * 64 + p) * 16 + c]; v[e] = (q & 1) ? (cr * bi + ci * br) : (cr * br - ci * bi); }
            w[jj >> 1] = pk2(v[0], v[1]);
        }
        *(v4u*)(ws + WS_S5B + ((size_t)(dg * 4 + q) * 64 + lane) * 16) = (v4u){w[0], w[1], w[2], w[3]};
    }
    const int ch = lane & 15, fq = lane >> 4;
#pragma unroll
    for (int ks = 0; ks < 4; ++ks) {
        unsigned w[4];
#pragma unroll
        for (int jj = 0; jj < 8; jj += 2) { const int st = (32 * ks + 8 * fq + jj) >> 1;
            w[jj >> 1] = pk2(c_re[(dg * 16 + ch) * 64 + st], -c_im[(dg * 16 + ch) * 64 + st]); }
        *(v4u*)(ws + WS_S5C + ((size_t)(dg * 4 + ks) * 64 + lane) * 16) = (v4u){w[0], w[1], w[2], w[3]};
    }
}
__device__ __forceinline__ int s5_row(int b, int dir, int pos) {
    if (pos < NCTX) return MLAT + b * NCTX + (dir ? NCTX - 1 - pos : pos);
    const int t = pos - NCTX; return b * SEQ + (dir ? SEQ - 1 - t : t);
}
#define S5_SCAN16(D0, D1, D2, D3) do { _Pragma("unroll") for (int r_ = 0; r_ < 16; ++r_) { \
        const float n0r = fmaf(lm[0], x[0], fmaf(-lm[1], x[1], D0[r_])), n0i = fmaf(lm[0], x[1], fmaf(lm[1], x[0], D1[r_])); \
        const float n1r = fmaf(lm[2], x[2], fmaf(-lm[3], x[3], D2[r_])), n1i = fmaf(lm[2], x[3], fmaf(lm[3], x[2], D3[r_])); \
        x[0] = n0r; x[1] = n0i; x[2] = n1r; x[3] = n1i; D0[r_] = n0r; D1[r_] = n0i; D2[r_] = n1r; D3[r_] = n1i; } } while (0)

#define S5_SCAN16_ONE(Dr, Di, LR, LI, XR, XI) do { _Pragma("unroll") for (int r_ = 0; r_ < 16; ++r_) { \
        const float nr_ = fmaf(LR, XR, fmaf(-(LI), XI, Dr[r_])), ni_ = fmaf(LR, XI, fmaf(LI, XR, Di[r_])); XR = nr_; XI = ni_; Dr[r_] = nr_; Di[r_] = ni_; } } while (0)
__device__ __forceinline__ void s5_pass1(unsigned char* ws, int task, int lane) {
    const int chain = task / S5_NPAIR, w = task % S5_NPAIR, g = chain & 31, dir = (chain >> 5) & 1, b = chain >> 6, dg = dir * 32 + g;
    const bf16* U = (const bf16*)(ws + WS_U);
    bf16x8 Bf[4];
#pragma unroll
    for (int q = 0; q < 4; ++q) Bf[q] = *(const bf16x8*)(ws + WS_S5B + ((size_t)(dg * 4 + q) * 64 + lane) * 16);
    const f32x4 lm = *(const f32x4*)((const float*)(ws + WS_LAM) + (dg * 64 + 2 * (lane & 31)) * 2);
    const int i = lane & 31, hhA = (i >> 2) & 1, ti = (i & 3) + 4 * (i >> 3), h = lane >> 5;
    float x[4] = {0.f, 0.f, 0.f, 0.f};
    const f32x16 z = {0.f, 0.f, 0.f, 0.f, 0.f, 0.f, 0.f, 0.f, 0.f, 0.f, 0.f, 0.f, 0.f, 0.f, 0.f, 0.f};
    bf16x8 an = *(const bf16x8*)(U + (size_t)s5_row(b, dir, (2 * w + hhA) * S5_CH + ti) * 512 + g * 16 + 8 * h);
#pragma unroll 1
    for (int step = 0; step < S5_NST; ++step) {
        const bf16x8 a = an;
        if (step + 1 < S5_NST) an = *(const bf16x8*)(U + (size_t)s5_row(b, dir, (2 * w + hhA) * S5_CH + (step + 1) * 16 + ti) * 512 + g * 16 + 8 * h);
        f32x16 D0 = __builtin_amdgcn_mfma_f32_32x32x16_bf16(a, Bf[0], z, 0, 0, 0), D1 = __builtin_amdgcn_mfma_f32_32x32x16_bf16(a, Bf[1], z, 0, 0, 0);
        f32x16 D2 = __builtin_amdgcn_mfma_f32_32x32x16_bf16(a, Bf[2], z, 0, 0, 0), D3 = __builtin_amdgcn_mfma_f32_32x32x16_bf16(a, Bf[3], z, 0, 0, 0);
        S5_SCAN16(D0, D1, D2, D3);
    }
    float* S = (float*)(ws + WS_SEND) + ((size_t)chain * S5_NCH + 2 * w + h) * 128 + 4 * (lane & 31);
    *(f32x4*)S = (f32x4){x[0], x[1], x[2], x[3]};
}
static_assert(S5_NCH % 6 == 0, "pass 2 batches");
__device__ __forceinline__ void s5_pass2(unsigned char* ws, int gid) {
    const int chain = gid >> 6, p = gid & 63, dg = chain & 63;
    const float lr = ((const float*)(ws + WS_LAMP))[(dg * 64 + p) * 2], li = ((const float*)(ws + WS_LAMP))[(dg * 64 + p) * 2 + 1];
    const float* S = (const float*)(ws + WS_SEND) + (size_t)chain * S5_NCH * 128 + 2 * p; float* H = (float*)(ws + WS_HIN) + (size_t)chain * S5_NCH * 128 + 2 * p;
    float xr = 0.f, xi = 0.f;
#pragma unroll 1
    for (int q0 = 0; q0 < S5_NCH; q0 += 6) {
        float sr[6], si[6];
#pragma unroll
        for (int e = 0; e < 6; ++e) { sr[e] = S[(q0 + e) * 128]; si[e] = S[(q0 + e) * 128 + 1]; }
#pragma unroll
        for (int e = 0; e < 6; ++e) { H[(q0 + e) * 128] = xr; H[(q0 + e) * 128 + 1] = xi;
            const float nr = fmaf(lr, xr, fmaf(-li, xi, sr[e])), ni = fmaf(lr, xi, fmaf(li, xr, si[e])); xr = nr; xi = ni; }
    }
}
__device__ __forceinline__ void s5_pass3(const Args& args, unsigned char* ws, LAS unsigned char* xt  , int task, int lane, int mode = 7  ) {
    const int w = task & 63, g = (task >> 6) & 31, b = task >> 11;
    const bf16* U = (const bf16*)(ws + WS_U); bf16* Ao = (bf16*)(ws + WS_H);
    const int i = lane & 31, hhA = (i >> 2) & 1, ti = (i & 3) + 4 * (i >> 3), h = lane >> 5, j = lane & 31, fq = lane >> 4, ch = lane & 15;
    f32x4 yacc[S5_NST][2];
    const f32x16 z = {0.f, 0.f, 0.f, 0.f, 0.f, 0.f, 0.f, 0.f, 0.f, 0.f, 0.f, 0.f, 0.f, 0.f, 0.f, 0.f};
#pragma unroll
    for (int dir = 0; dir < 2; ++dir) {
        const int dg = dir * 32 + g, chain = (b * 2 + dir) * 32 + g;
        bf16x8 Bf[4], Cf[4];
#pragma unroll
        for (int q = 0; q < 4; ++q) { Bf[q] = *(const bf16x8*)(ws + WS_S5B + ((size_t)(dg * 4 + q) * 64 + lane) * 16); Cf[q] = *(const bf16x8*)(ws + WS_S5C + ((size_t)(dg * 4 + q) * 64 + lane) * 16); }
        const f32x4 lm = *(const f32x4*)((const float*)(ws + WS_LAM) + (dg * 64 + 2 * j) * 2);
        const int cl = 2 * w + h, qc = dir ? (S5_NCC + S5_NLAT - 1 - cl) : (cl + S5_NCC);
        const f32x4 x0 = *(const f32x4*)((const float*)(ws + WS_HIN) + ((size_t)chain * S5_NCH + qc) * 128 + 4 * j);
        float x[4] = {x0[0], x0[1], x0[2], x0[3]};
        bf16x8 an = *(const bf16x8*)(U + ((size_t)b * SEQ + (2 * w + hhA) * S5_CH + (dir ? S5_CH - 1 - ti : ti)) * 512 + g * 16 + 8 * h);
#pragma unroll
        for (int step = 0; step < S5_NST; ++step) {
            const bf16x8 a = an;
            if (step + 1 < S5_NST) { const int n = (step + 1) * 16 + ti, t = (2 * w + hhA) * S5_CH + (dir ? S5_CH - 1 - n : n); an = *(const bf16x8*)(U + ((size_t)b * SEQ + t) * 512 + g * 16 + 8 * h); }
            if (mode & 1) {   f32x16 D0 = __builtin_amdgcn_mfma_f32_32x32x16_bf16(a, Bf[0], z, 0, 0, 0), D1 = __builtin_amdgcn_mfma_f32_32x32x16_bf16(a, Bf[1], z, 0, 0, 0);
                S5_SCAN16_ONE(D0, D1, lm[0], lm[1], x[0], x[1]);
#pragma unroll
                for (int r = 0; r < 16; ++r) *(LAS unsigned*)(xt + (h * 16 + r) * 272 + 8 * j) = pg8::cvt_pk_bf16(D0[r], D1[r]); }
            if (mode & 1) {   f32x16 D2 = __builtin_amdgcn_mfma_f32_32x32x16_bf16(a, Bf[2], z, 0, 0, 0), D3 = __builtin_amdgcn_mfma_f32_32x32x16_bf16(a, Bf[3], z, 0, 0, 0);
                S5_SCAN16_ONE(D2, D3, lm[2], lm[3], x[2], x[3]);
#pragma unroll
                for (int r = 0; r < 16; ++r) *(LAS unsigned*)(xt + (h * 16 + r) * 272 + 8 * j + 4) = pg8::cvt_pk_bf16(D2[r], D3[r]); }
            asm volatile("s_waitcnt lgkmcnt(0)" ::: "memory");
            const int rs = dir ? 15 - ch : ch;
#pragma unroll
            for (int hr = 0; hr < 2; ++hr) {
                f32x4 acc = {0.f, 0.f, 0.f, 0.f};
#pragma unroll
                for (int ks = 0; ks < ((mode & 2) ? 4 : 0); ++ks) { const bf16x8 af = *(const LAS bf16x8*)(xt + (hr * 16 + rs) * 272 + ks * 64 + 16 * fq);
                    acc = __builtin_amdgcn_mfma_f32_16x16x32_bf16(af, Cf[ks], acc, 0, 0, 0); }
                if (dir == 0) yacc[step][hr] = acc; else yacc[S5_NST - 1 - step][hr] += acc;
            }
            asm volatile("s_waitcnt lgkmcnt(0)" ::: "memory");
            __builtin_amdgcn_sched_barrier(0);
        }
    }
    if (mode & 4) {
        asm volatile("s_waitcnt lgkmcnt(0)" ::: "memory");
#pragma unroll
        for (int s = 0; s < S5_NST; ++s)
#pragma unroll
            for (int hr = 0; hr < 2; ++hr)
#pragma unroll
                for (int e = 0; e < 4; ++e) *(LAS float*)(xt + ((hr * S5_CH + 16 * s + 4 * fq + e) * 16 + ch) * 4) = yacc[s][hr][e];
        asm volatile("s_waitcnt lgkmcnt(0)" ::: "memory");
        f32x4 dk[4];
#pragma unroll
        for (int q = 0; q < 4; ++q) dk[q] = *(const f32x4*)(args.in[I_SD] + g * 16 + 4 * q);
#pragma unroll
        for (int hr = 0; hr < 2; ++hr) {
            const size_t o = ((size_t)b * SEQ + (2 * w + hr) * S5_CH + lane) * 512 + g * 16;
            const v4u u0 = *(const v4u*)(U + o), u1 = *(const v4u*)(U + o + 8);
            const unsigned uw[8] = {u0.x, u0.y, u0.z, u0.w, u1.x, u1.y, u1.z, u1.w};
            unsigned ow[8];
#pragma unroll
            for (int q = 0; q < 4; ++q) {
                const f32x4 y4 = *(const LAS f32x4*)(xt + ((hr * S5_CH + lane) * 16 + 4 * q) * 4);
                float r[4];
#pragma unroll
                for (int e = 0; e < 4; ++e) { const unsigned wv = uw[2 * q + (e >> 1)]; const float uu = (e & 1) ? __uint_as_float(wv & 0xffff0000u) : __uint_as_float(wv << 16);
                    const float y = y4[e] + uu * dk[q][e];
                    r[e] = y * __builtin_amdgcn_rcpf(1.f + __expf(-1.5957691216057308f * (y + 0.044715f * y * y * y))); }
                ow[2 * q] = pk2(r[0], r[1]); ow[2 * q + 1] = pk2(r[2], r[3]);
            }
            *(v4u*)(Ao + o) = (v4u){ow[0], ow[1], ow[2], ow[3]}; *(v4u*)(Ao + o + 8) = (v4u){ow[4], ow[5], ow[6], ow[7]};
        }
        asm volatile("s_waitcnt lgkmcnt(0)" ::: "memory");
    }
}
__device__ __forceinline__ int block_incl_scan(int v, int* scr, int lane, int wave, int& total) {
    int x = v;
#pragma unroll
    for (int o = 1; o < 64; o <<= 1) { const int y = __shfl_up(x, o); if (lane >= o) x += y; }
    if (lane == 63) scr[wave] = x;
    __syncthreads();
    int base = 0, tot = 0;
#pragma unroll
    for (int w = 0; w < 8; ++w) { const int s = scr[w]; if (w < wave) base += s; tot += s; }
    __syncthreads();
    total = tot; return x + base;
}
__device__ __forceinline__ void topk_select(unsigned char* ws, unsigned char* lds_g, int be, int tid, int lane, int wave) {
    unsigned* vals = (unsigned*)lds_g; int* hist = (int*)(lds_g + 32768); int* scr = (int*)(lds_g + 49152);
    const int b = be >> 4, e = be & 15;
    const float* AFF = (const float*)(ws + WS_AFF); int* IDX = (int*)(ws + WS_IDX); float* GSEL = (float*)(ws + WS_GSEL); int* SLOT = (int*)(ws + WS_SLOT);
    for (int i = tid; i < 8192; i += 512) vals[i] = __float_as_uint(AFF[((size_t)b * SEQ + i) * 16 + e]);
    __syncthreads();
    unsigned long long prefix = 0ull; int krem = 1024;
#pragma unroll
    for (int pass = 0; pass < 4; ++pass) {
        const int wdt = pass == 3 ? 12 : 11, shift = pass == 0 ? 34 : (pass == 1 ? 23 : (pass == 2 ? 12 : 0)), nb = 1 << wdt, B = nb / 512;
        for (int i = tid; i < nb; i += 512) hist[i] = 0;
        __syncthreads();
        for (int k = 0; k < 16; ++k) { const int i = tid + 512 * k; const unsigned long long key = ((unsigned long long)vals[i] << 13) | (unsigned)(8191 - i);
            if ((key >> (shift + wdt)) == prefix) atomicAdd(&hist[(int)(key >> shift) & (nb - 1)], 1); }
        __syncthreads();
        int cnt = 0;
        for (int d = 0; d < B; ++d) cnt += hist[tid * B + d];
        int total; const int incl = block_incl_scan(cnt, scr, lane, wave, total);
        int running = total - incl;
        for (int d = tid * B + B - 1; d >= tid * B; --d) { const int hh = hist[d]; if (running < krem && running + hh >= krem) { scr[16] = d; scr[17] = krem - running; } running += hh; }
        __syncthreads();
        const int dstar = scr[16]; krem = scr[17]; prefix = (prefix << wdt) | (unsigned long long)dstar;
        __syncthreads();
    }
    int cnt = 0;
    for (int k = 0; k < 16; ++k) { const int i = tid + 512 * k; const unsigned long long key = ((unsigned long long)vals[i] << 13) | (unsigned)(8191 - i); cnt += key >= prefix ? 1 : 0; }
    int total; int slot = block_incl_scan(cnt, scr, lane, wave, total) - cnt;
    for (int k = 0; k < 16; ++k) { const int i = tid + 512 * k; const unsigned long long key = ((unsigned long long)vals[i] << 13) | (unsigned)(8191 - i);
        if (key >= prefix) { if (slot < 1024) { IDX[be * 1024 + slot] = i; GSEL[be * 1024 + slot] = __uint_as_float(vals[i]); SLOT[be * 8192 + i] = slot; } else SLOT[be * 8192 + i] = -1; ++slot; }
        else SLOT[be * 8192 + i] = -1; }
    __syncthreads();
}
typedef short s16x4 __attribute__((ext_vector_type(4)));
constexpr int AT_ROW = 144;
constexpr int AT_KC = 0, AT_VC = 256 * AT_ROW, AT_RING = 2 * 256 * AT_ROW, AT_RBUF = 2 * 64 * AT_ROW, AT_BIAS = 132096;
static_assert(AT_RING + 3 * AT_RBUF <= RING_BYTES && AT_BIAS >= MISC_OFF + 128 && AT_BIAS + (512 + 640) * 4 <= LDS_BYTES, "attention LDS map");
constexpr float LOG2E = 1.4426950408889634f;

template <int MODE> __device__ __forceinline__ void attn_tile32(const LAS unsigned char* K32, const LAS unsigned char* V32, const bf16x8 q0, const bf16x8 q1, f32x4 (&O)[4], float& lsum,
                                                              int lane, const LAS float* brow, int kc0, int q_cs, float shiftl) {
    const int r16 = lane & 15, fq = lane >> 4;
    f32x4 st[2];
#pragma unroll
    for (int tt = 0; tt < 2; ++tt) {
        const LAS unsigned char* kp = K32 + (16 * tt + r16) * AT_ROW + 16 * fq;
        const bf16x8 k0 = *(const LAS bf16x8*)kp, k1 = *(const LAS bf16x8*)(kp + 64);
        f32x4 c0;
        if (MODE == 0) c0 = (f32x4){shiftl, shiftl, shiftl, shiftl};
        else { const LAS float* bp = brow + 16 * tt + 4 * fq; c0 = (f32x4){bp[0], bp[1], bp[2], bp[3]}; }
        st[tt] = __builtin_amdgcn_mfma_f32_16x16x32_bf16(k0, q0, c0, 0, 0, 0);
        st[tt] = __builtin_amdgcn_mfma_f32_16x16x32_bf16(k1, q1, st[tt], 0, 0, 0);
    }
    float p[2][4];
#pragma unroll
    for (int tt = 0; tt < 2; ++tt)
#pragma unroll
        for (int e = 0; e < 4; ++e) {
            float v = __builtin_amdgcn_exp2f(st[tt][e]);
            if (MODE == 2) { const int kc = kc0 + 16 * tt + 4 * fq + e; v = (kc >= q_cs && kc < q_cs + 16) ? v : 0.f; }
            p[tt][e] = v; lsum += v;
        }
    bf16x8 Pf; { pg8::u32x4 w; w.x = pg8::cvt_pk_bf16(p[0][0], p[0][1]); w.y = pg8::cvt_pk_bf16(p[0][2], p[0][3]); w.z = pg8::cvt_pk_bf16(p[1][0], p[1][1]); w.w = pg8::cvt_pk_bf16(p[1][2], p[1][3]); Pf = __builtin_bit_cast(bf16x8, w); }
    const LAS unsigned char* vp = V32 + (4 * fq + (r16 >> 2)) * AT_ROW + 8 * (r16 & 3);
#pragma unroll
    for (int dt = 0; dt < 4; ++dt) {
        const s16x4 lo = __builtin_amdgcn_ds_read_tr16_b64_v4i16((LAS s16x4*)(vp + 32 * dt)), hi = __builtin_amdgcn_ds_read_tr16_b64_v4i16((LAS s16x4*)(vp + 32 * dt + 16 * AT_ROW));
        const bf16x8 Vf = __builtin_shufflevector(lo, hi, 0, 1, 2, 3, 4, 5, 6, 7);
        O[dt] = __builtin_amdgcn_mfma_f32_16x16x32_bf16(Vf, Pf, O[dt], 0, 0, 0);
    }
}

__device__ __forceinline__ void attn_unit(const Args& args, unsigned char* ws, LAS unsigned char* lds, int unit, int tid, int lane, int wave, int mode  ) {
    const int b = unit >> 7, head = (unit >> 4) & 7, r0 = (unit & 15) * 8, r = r0 + wave;
    const bf16* Q = (const bf16*)(ws + WS_Q); const bf16* Kg = (const bf16*)(ws + WS_K); const bf16* Vg = (const bf16*)(ws + WS_V); bf16* YB = (bf16*)(ws + WS_YAB) + 512;
    const int r16 = lane & 15, fq = lane >> 4;
    float mq = fabsf(args.in[I_QN][lane]), mk = fabsf(args.in[I_KN][lane]);
#pragma unroll
    for (int o = 1; o < 64; o <<= 1) { mq = fmaxf(mq, __shfl_xor(mq, o)); mk = fmaxf(mk, __shfl_xor(mk, o)); }
    const float shiftl = -8.f * mq * mk * LOG2E;
    __syncthreads();
    {
        const bf16* kc = Kg + ((size_t)MLAT + b * NCTX) * 512 + head * 64; const bf16* vc = Vg + ((size_t)MLAT + b * NCTX) * 512 + head * 64;
#pragma unroll
        for (int i = 0; i < 4; ++i) { const int idx = tid + 512 * i, row = idx >> 3, c = idx & 7;
            const v4u kv = *(const v4u*)(kc + (size_t)row * 512 + c * 8), vv = *(const v4u*)(vc + (size_t)row * 512 + c * 8);
            *(LAS v4u*)(lds + AT_KC + row * AT_ROW + c * 16) = kv; *(LAS v4u*)(lds + AT_VC + row * AT_ROW + c * 16) = vv; }
        LAS float* bl = (LAS float*)(lds + AT_BIAS);
        {
            bl[tid] = tid < 465 ? fmaf(args.in[I_RPB][head * 465 + tid], LOG2E, shiftl) : 0.f;
            for (int i = tid; i < 640; i += 512) { const int dr = i / 40, dc = i % 40 - 8; bl[512 + i] = (dr < 15 && dc >= 7 && dc < 23) ? fmaf(args.in[I_RPB][head * 465 + dr * 31 + dc], LOG2E, shiftl) : -30000.f; }
        }
    }
    const int kr_lo = min(max(r0 - 4, 0), 120), kr_hi = min(max(r0 + 3, 0), 120) + 7;
    const int lcol = tid >> 3, lc = tid & 7;
    v4u kv, vv;
    {   const size_t g0 = ((size_t)b * SEQ + kr_lo * 64 + lcol) * 512 + head * 64 + lc * 8;
        const v4u k0 = *(const v4u*)(Kg + g0), v0 = *(const v4u*)(Vg + g0);
        *(LAS v4u*)(lds + AT_RING + lcol * AT_ROW + lc * 16) = k0; *(LAS v4u*)(lds + AT_RING + 64 * AT_ROW + lcol * AT_ROW + lc * 16) = v0;
        kv = *(const v4u*)(Kg + g0 + 64 * 512); vv = *(const v4u*)(Vg + g0 + 64 * 512); }
    bf16x8 Qf[4][2];
#pragma unroll
    for (int j = 0; j < 4; ++j) { const bf16* qp = Q + ((size_t)b * SEQ + r * 64 + 16 * j + r16) * 512 + head * 64 + 8 * fq; Qf[j][0] = *(const bf16x8*)qp; Qf[j][1] = *(const bf16x8*)(qp + 32); }
    f32x4 O[4][4]; float lsum[4];
#pragma unroll
    for (int j = 0; j < 4; ++j) { lsum[j] = 0.f;
#pragma unroll
        for (int dt = 0; dt < 4; ++dt) O[j][dt] = (f32x4){0.f, 0.f, 0.f, 0.f}; }
    __syncthreads();
#pragma unroll 1
    for (int grp = 0; grp < ((mode & 1) ? 8 : 0); ++grp) {
#pragma unroll
        for (int j = 0; j < 4; ++j) attn_tile32<0>(lds + AT_KC + 32 * grp * AT_ROW, lds + AT_VC + 32 * grp * AT_ROW, Qf[j][0], Qf[j][1], O[j], lsum[j], lane, nullptr, 0, 0, shiftl);
    }
    const int rs = min(max(r - 4, 0), 120);
    int buf = 0;
#pragma unroll 1
    for (int kr = kr_lo; kr <= ((mode & 2) ? kr_hi : kr_lo - 1); ++kr) {
        if (kr + 1 <= kr_hi) { const int nbuf = buf == 2 ? 0 : buf + 1; LAS unsigned char* nb = lds + AT_RING + nbuf * AT_RBUF;
            *(LAS v4u*)(nb + lcol * AT_ROW + lc * 16) = kv; *(LAS v4u*)(nb + 64 * AT_ROW + lcol * AT_ROW + lc * 16) = vv; }
        if (kr + 2 <= kr_hi) { const size_t g0 = ((size_t)b * SEQ + (kr + 2) * 64 + lcol) * 512 + head * 64 + lc * 8; kv = *(const v4u*)(Kg + g0); vv = *(const v4u*)(Vg + g0); }
        if (kr >= rs && kr < rs + 8 && (mode & 4)) {
            const LAS unsigned char* kb = lds + AT_RING + buf * AT_RBUF; const LAS unsigned char* vb = kb + 64 * AT_ROW;
            const LAS float* bl = (const LAS float*)(lds + AT_BIAS) + (kr - r + 7) * 31 + 15; const LAS float* bl1 = (const LAS float*)(lds + AT_BIAS) + 512 + (kr - r + 7) * 40 + 8 + 15;
#pragma unroll
            for (int j = 0; j < 4; ++j) { const int cs = j == 0 ? 0 : (j == 3 ? 32 : 16 * j - 8), qc = 16 * j + r16, q_cs = min(max(qc - 8, 0), 48);
                if (j == 0 || j == 3) attn_tile32<2>(kb + cs * AT_ROW, vb + cs * AT_ROW, Qf[j][0], Qf[j][1], O[j], lsum[j], lane, bl + cs - qc, cs, q_cs, shiftl);
                else attn_tile32<1>(kb + cs * AT_ROW, vb + cs * AT_ROW, Qf[j][0], Qf[j][1], O[j], lsum[j], lane, bl1 + cs - qc, cs, q_cs, shiftl); }
        }
        __syncthreads();
        buf = buf == 2 ? 0 : buf + 1;
    }
#pragma unroll
    for (int j = 0; j < 4; ++j) {
        float l = lsum[j]; l += __shfl_xor(l, 16); l += __shfl_xor(l, 32);
        const float inv = 1.f / l;
        bf16* op = YB + ((size_t)b * SEQ + r * 64 + 16 * j + r16) * 1024 + head * 64 + 4 * fq;
#pragma unroll
        for (int dt = 0; dt < 4; ++dt) { pg8::u32x2 w; w.x = pg8::cvt_pk_bf16(O[j][dt][0] * inv, O[j][dt][1] * inv); w.y = pg8::cvt_pk_bf16(O[j][dt][2] * inv, O[j][dt][3] * inv); *(pg8::u32x2*)(op + 16 * dt) = w; }
    }
}
__global__ void __launch_bounds__(NWAVES * 64, 2) mega(Args args) {
    extern __shared__ __attribute__((aligned(16))) unsigned char lds_raw[];
    LAS unsigned char* lds = (LAS unsigned char*)lds_raw;
    volatile LAS unsigned* MISC = (volatile LAS unsigned*)(lds + MISC_OFF);
    const int tid = threadIdx.x, lane = tid & 63, wave = __builtin_amdgcn_readfirstlane(tid >> 6);
    const int G = gridDim.x; const int bx = blockIdx.x; const int vcu = (G % 8 == 0) ? (bx % 8) * (G / 8) + bx / 8 : bx;
    const int gw = vcu * NWAVES + wave, NGW = G * NWAVES;
    unsigned char* ws = args.ws;
    gu32* ctl = (gu32*)(ws + WS_CTL);
    for (int u = tid; u < (LDS_BYTES - LDSCTL_OFF) / 4; u += NWAVES * 64) ((LAS unsigned*)(lds + LDSCTL_OFF))[u] = 0u;
    __syncthreads();
    XcdBarrier bar = xcd_barrier_post((unsigned*)(ctl + CW_BAR) + args.li * XCD_BAR_WORDS, MISC + 8);
    const int lo = args.ph_lo, hi = args.ph_hi;
#define IN(k) (lo <= (k) && (k) < hi)
#define BOTH(k) (IN(k) && IN((k) + 1))
#if defined(TIME_MASK)
    unsigned long long tacc_ = 0ull, tbeg_ = 0ull;
#define TBEG(k) do { if ((TIME_MASK >> (k)) & 1) tbeg_ = __builtin_amdgcn_s_memrealtime(); } while (0)
#define TEND(k) do { if ((TIME_MASK >> (k)) & 1) tacc_ += __builtin_amdgcn_s_memrealtime() - tbeg_; } while (0)
#else
#define TBEG(k) do {} while (0)
#define TEND(k) do {} while (0)
#endif
    float* mod = (float*)(ws + WS_MOD);
    bf16* Hb = (bf16*)(ws + WS_H);

    TBEG(0);
    if (IN(0)) for (int rep_ = 0; rep_ <= ((PROBE_MASK >> 0) & 1) * PROBE_REPS; ++rep_) {
        const float* c = args.in[I_C]; const float* cctx = args.in[I_CCTX]; const float* w_ada = args.in[I_WADA]; const float* b_ada = args.in[I_BADA];
        if (args.li == 0) for (int it = gw; it < 24 * 16; it += NGW) {
            const int cc = it % 24, ks = it / 24, col = cc * 256 + lane * 4;
            f32x4 a0 = {0.f, 0.f, 0.f, 0.f}, a1 = a0, a2 = a0;
#pragma unroll 1
            for (int k0 = ks * 64; k0 < ks * 64 + 64; k0 += 16) {
                f32x4 w[16];
#pragma unroll
                for (int i = 0; i < 16; ++i) w[i] = *(const f32x4*)(w_ada + (size_t)(k0 + i) * 6144 + col);
#pragma unroll
                for (int i = 0; i < 16; ++i) { const float s0 = silu_f(c[k0 + i]), s1 = silu_f(c[1024 + k0 + i]), s2 = silu_f(cctx[k0 + i]); a0 += w[i] * s0; a1 += w[i] * s1; a2 += w[i] * s2; }
            }
            if (ks == 0) { const f32x4 bb = *(const f32x4*)(b_ada + col); a0 += bb; a1 += bb; a2 += bb; }
#pragma unroll
            for (int i = 0; i < 4; ++i) { atomicAdd(mod + col + i, a0[i]); atomicAdd(mod + 6144 + col + i, a1[i]); atomicAdd(mod + 2 * 6144 + col + i, a2[i]); }
        }
        LAS float* scr = (LAS float*)(lds + RING_OFF + wave * 16384);
        constexpr int I_IN = 16 * 128, I_GLU = 8 * 16, I_PA = 8 * 32, I_OUT = 16 * 32, NIT = I_IN + I_GLU + 2 * I_PA + I_OUT;
        for (int it = gw; it < NIT; it += NGW) {
            int r = it;
            if (r < I_IN) { transpose_item<1>(args.in[I_WIN], 1024, 4096, (bf16*)(ws + WS_WIN), 1024, scr, r, lane); continue; } r -= I_IN;
            if (r < I_GLU) { transpose_item<0>(args.in[I_WGLU], 512, 512, (bf16*)(ws + WS_WGLU), 512, scr, r, lane); continue; } r -= I_GLU;
            if (r < I_PA) { transpose_item<0>(args.in[I_WPA], 512, 1024, (bf16*)(ws + WS_WPA), 1024, scr, r, lane); continue; } r -= I_PA;
            if (r < I_PA) { transpose_item<0>(args.in[I_WPB], 512, 1024, (bf16*)(ws + WS_WPA) + 512, 1024, scr, r, lane); continue; } r -= I_PA;
            transpose_item<0>(args.in[I_WOUT], 1024, 1024, (bf16*)(ws + WS_WOUT), 1024, scr, r, lane);
        }
        for (int dg = gw; dg < 64; dg += NGW) s5_prep(args, ws, dg, lane);
        if (BOTH(0)) xcd_barrier(bar);
    }
    TEND(0);
    TBEG(1);
    if (IN(1)) for (int rep_ = 0; rep_ <= ((PROBE_MASK >> 1) & 1) * PROBE_REPS; ++rep_) {
        const float* x = args.in[I_X]; const float* ctx = args.in[I_CTX]; const float* gwt = args.in[I_NMIX];
        for (int blk = gw; blk < MLAT / 8 + MCTX / 2; blk += NGW) {
            if (blk < MLAT / 8) norm1_rows(x + (size_t)blk * 8 * D, Hb + (size_t)blk * 8 * D, 8, gwt, mod + ((blk * 8) >> 13) * 6144, lane);
            else { const int r = (blk - MLAT / 8) * 2; norm1_rows(ctx + (size_t)r * D, Hb + (size_t)(MLAT + r) * D, 2, gwt, mod + 2 * 6144, lane); }
        }
        if (BOTH(1)) xcd_barrier(bar);
    }
    TEND(1);
    TBEG(2);
    if (IN(2)) for (int rep_ = 0; rep_ <= ((PROBE_MASK >> 2) & 1) * PROBE_REPS; ++rep_) {
        pg8::Gemm g{Hb, (const bf16*)(ws + WS_WIN), MALL, 4096, 1024};
        pg8::InprojOrder S; S.init(G, bx, true);
        pg8::EpiInproj E{(bf16*)(ws + WS_U), (bf16*)(ws + WS_Q), (bf16*)(ws + WS_K), (bf16*)(ws + WS_V), (bf16*)(ws + WS_SGA), (bf16*)(ws + WS_SGB), args.in[I_QN], args.in[I_KN]};
        pg8::gemm_phase<pg8::EpiInproj, pg8::InprojOrder, true>(lds + RING_OFF, g, S, E);
        {
            const int maxun = (1036 + G - 1) / G, heavy = 1036 - (maxun - 1) * G, light = heavy < G ? G - heavy : G;
            if (light == G || bx >= heavy) {
                LAS float* scr = (LAS float*)(lds + RING_OFF + wave * 16384);
                for (int it = (light == G ? bx : bx - heavy) * NWAVES + wave; it < 16 * 512; it += light * NWAVES)
                    transpose_item<0>(args.in[I_WED] + (size_t)(it >> 9) * 1048576, 1024, 1024, (bf16*)(ws + WS_WD) + (size_t)(it >> 9) * 1048576, 1024, scr, it & 511, lane);
            }
        }
        if (BOTH(2)) xcd_barrier(bar);
    }
    TEND(2);
#if defined(EXTRA_BARRIERS)
    if (IN(3)) for (int xb_ = 0; xb_ < EXTRA_BARRIERS; ++xb_) xcd_barrier(bar);
#endif
    TBEG(3);
    if (IN(3)) for (int rep_ = 0; rep_ <= ((PROBE_MASK >> 3) & 1) * PROBE_REPS; ++rep_) {
        for (int task = gw; task < 128 * S5_NPAIR; task += NGW) s5_pass1(ws, task, lane);
        if (BOTH(3)) xcd_barrier(bar);
    }
    TEND(3);
    TBEG(4);
    if (IN(4)) for (int rep_ = 0; rep_ <= ((PROBE_MASK >> 4) & 1) * PROBE_REPS; ++rep_) {
        { const int gid = gw * 64 + lane; if (gid < 8192 && (PROBE_VARIANT != 0 || rep_ == ((PROBE_MASK >> 4) & 1) * PROBE_REPS)) s5_pass2(ws, gid); }
        for (int unit = bx; unit < 256; unit += G) attn_unit(args, ws, lds + RING_OFF, unit, tid, lane, wave, rep_ < ((PROBE_MASK >> 4) & 1) * PROBE_REPS ? PROBE_VARIANT : 7);
        if (BOTH(4)) xcd_barrier(bar);
    }
    TEND(4);
    TBEG(5);
    if (IN(5)) for (int rep_ = 0; rep_ <= ((PROBE_MASK >> 5) & 1) * PROBE_REPS; ++rep_) {
        for (int task = gw; task < 4096; task += NGW) s5_pass3(args, ws, lds + RING_OFF + wave * 16384, task, lane, rep_ < ((PROBE_MASK >> 5) & 1) * PROBE_REPS ? PROBE_VARIANT : 7);
        if (BOTH(5)) xcd_barrier(bar);
    }
    TEND(5);
    TBEG(6);
    if (IN(6)) for (int rep_ = 0; rep_ <= ((PROBE_MASK >> 6) & 1) * PROBE_REPS; ++rep_) {
        pg8::Gemm g{(const bf16*)(ws + WS_H), (const bf16*)(ws + WS_WGLU), MLAT, 512, 512};
        pg8::StaticOrder S; S.init(MLAT, 512, G, bx);
        pg8::EpiGlu E{(const bf16*)(ws + WS_H), args.in[I_BGLU], (bf16*)(ws + WS_YAB), 1024};
        pg8::gemm_phase<pg8::EpiGlu, pg8::StaticOrder, true>(lds + RING_OFF, g, S, E);
        if (G > 128 && bx >= 128) {
            LAS float* scr = (LAS float*)(lds + RING_OFF + wave * 16384);
            for (int it = (bx - 128) * NWAVES + wave; it < WGU_NLO * 1024; it += (G - 128) * NWAVES) { const int e = it >> 10, which = (it >> 9) & 1;
                if (which == 0) transpose_item<2>(args.in[I_WEG] + (size_t)e * 1048576, 1024, 1024, (bf16*)(ws + WS_WGU) + (size_t)e * 2097152, 1024, scr, it & 511, lane);
                else transpose_item<3>(args.in[I_WEU] + (size_t)e * 1048576, 1024, 1024, (bf16*)(ws + WS_WGU) + (size_t)e * 2097152, 1024, scr, it & 511, lane); }
        }
        if (BOTH(6)) xcd_barrier(bar);
    }
    TEND(6);
    TBEG(7);
    if (IN(7)) for (int rep_ = 0; rep_ <= ((PROBE_MASK >> 7) & 1) * PROBE_REPS; ++rep_) {
        pg8::Gemm g{(const bf16*)(ws + WS_YAB), (const bf16*)(ws + WS_WPA), MLAT, 1024, 1024};
        pg8::StaticOrder S; S.init(MLAT, 1024, G, bx);
        pg8::EpiMerge E{(const bf16*)(ws + WS_SGA), (const bf16*)(ws + WS_SGB), (bf16*)(ws + WS_M)};
        pg8::gemm_phase<pg8::EpiMerge, pg8::StaticOrder, true>(lds + RING_OFF, g, S, E);
        if (BOTH(7)) xcd_barrier(bar);
    }
    TEND(7);
    TBEG(8);
    if (IN(8)) for (int rep_ = 0; rep_ <= ((PROBE_MASK >> 8) & 1) * PROBE_REPS; ++rep_) {
        pg8::Gemm g{(const bf16*)(ws + WS_M), (const bf16*)(ws + WS_WOUT), MLAT, 1024, 1024};
        pg8::StaticOrder S; S.init(MLAT, 1024, G, bx);
        pg8::EpiOut E{args.in[I_X], mod, args.out};
        pg8::gemm_phase<pg8::EpiOut, pg8::StaticOrder, true>(lds + RING_OFF, g, S, E);
        if (BOTH(8)) xcd_barrier(bar);
    }
    TEND(8);
    TBEG(9);
    if (IN(9)) for (int rep_ = 0; rep_ <= ((PROBE_MASK >> 9) & 1) * PROBE_REPS; ++rep_) {
        const float* gwt = args.in[I_NFFN]; const float* w_router = args.in[I_WR]; float* AFF = (float*)(ws + WS_AFF);
        __syncthreads();
#pragma unroll
        for (int k = 0; k < 8; ++k) { const int idx4 = tid + 512 * k, c = idx4 >> 2, e4 = idx4 & 3;
            *(LAS f32x4*)(lds + RING_OFF + (((c >> 8) * 4 + (c & 3)) * 64 + ((c & 255) >> 2)) * 80 + e4 * 16) = *(const f32x4*)(w_router + (size_t)c * 16 + e4 * 4); }
        __syncthreads();
        for (int blk = gw; blk < MLAT / 8; blk += NGW) {
            const int row0 = blk * 8; const float* md = mod + (row0 >> 13) * 6144;
            f32x4 ca[4], cb[4];
#pragma unroll
            for (int j = 0; j < 4; ++j) { const int col = j * 256 + lane * 4; ca[j] = *(const f32x4*)(gwt + col) * (*(const f32x4*)(md + 4096 + col) + 1.f); cb[j] = *(const f32x4*)(md + 3072 + col); }
#pragma unroll 1
            for (int rr = 0; rr < 8; rr += 2) {
                const int rowa = row0 + rr, rowb = rowa + 1;
                const float* sa = args.out + (size_t)rowa * D; const float* sb = sa + D;
                f32x4 va[4], vb[4]; float ssa = 0.f, ssb = 0.f;
#pragma unroll
                for (int j = 0; j < 4; ++j) { va[j] = *(const f32x4*)(sa + j * 256 + lane * 4); vb[j] = *(const f32x4*)(sb + j * 256 + lane * 4); }
#pragma unroll
                for (int j = 0; j < 4; ++j) { ssa += (va[j][0] * va[j][0] + va[j][1] * va[j][1]) + (va[j][2] * va[j][2] + va[j][3] * va[j][3]); ssb += (vb[j][0] * vb[j][0] + vb[j][1] * vb[j][1]) + (vb[j][2] * vb[j][2] + vb[j][3] * vb[j][3]); }
                const float ra = rsqrtf(wave_sum(ssa) * (1.f / D) + EPS), rb = rsqrtf(wave_sum(ssb) * (1.f / D) + EPS);
                float la[16], lb[16];
#pragma unroll
                for (int e = 0; e < 16; ++e) { la[e] = 0.f; lb[e] = 0.f; }
#pragma unroll
                for (int j = 0; j < 4; ++j) {
                    const int col = j * 256 + lane * 4;
                    const f32x4 oa = va[j] * ra * ca[j] + cb[j], ob = vb[j] * rb * ca[j] + cb[j];
                    pg8::u32x2 w; w.x = pk2(oa[0], oa[1]); w.y = pk2(oa[2], oa[3]); *(pg8::u32x2*)(Hb + (size_t)rowa * D + col) = w;
                    w.x = pk2(ob[0], ob[1]); w.y = pk2(ob[2], ob[3]); *(pg8::u32x2*)(Hb + (size_t)rowb * D + col) = w;
#pragma unroll
                    for (int i = 0; i < 4; ++i) {
                        const LAS f32x4* wr = (const LAS f32x4*)(lds + RING_OFF + ((j * 4 + i) * 64 + lane) * 80);
#pragma unroll
                        for (int e4 = 0; e4 < 4; ++e4) { const f32x4 wv = wr[e4];
#pragma unroll
                            for (int e = 0; e < 4; ++e) { la[e4 * 4 + e] = fmaf(oa[i], wv[e], la[e4 * 4 + e]); lb[e4 * 4 + e] = fmaf(ob[i], wv[e], lb[e4 * 4 + e]); } }
                        __builtin_amdgcn_sched_barrier(0);
                    }
                }
#define FOLD_STEP(arr, n, mask) do { const bool hi_ = (lane & (mask)) != 0; _Pragma("unroll") for (int k_ = 0; k_ < (n); ++k_) { \
            const float send_ = hi_ ? arr[k_] : arr[(n) + k_], keep_ = hi_ ? arr[(n) + k_] : arr[k_]; arr[k_] = keep_ + __shfl_xor(send_, (mask)); } } while (0)
                FOLD_STEP(la, 8, 32); FOLD_STEP(lb, 8, 32); FOLD_STEP(la, 4, 16); FOLD_STEP(lb, 4, 16); FOLD_STEP(la, 2, 8); FOLD_STEP(lb, 2, 8); FOLD_STEP(la, 1, 4); FOLD_STEP(lb, 1, 4);
#undef FOLD_STEP
                float xa = la[0], xb = lb[0];
                xa += __shfl_xor(xa, 2); xb += __shfl_xor(xb, 2); xa += __shfl_xor(xa, 1); xb += __shfl_xor(xb, 1);
                float ma = xa, mb = xb;
#pragma unroll
                for (int o = 4; o < 64; o <<= 1) { ma = fmaxf(ma, __shfl_xor(ma, o)); mb = fmaxf(mb, __shfl_xor(mb, o)); }
                const float ea = expf(xa - ma), eb = expf(xb - mb); float sua = ea, sub = eb;
#pragma unroll
                for (int o = 4; o < 64; o <<= 1) { sua += __shfl_xor(sua, o); sub += __shfl_xor(sub, o); }
                if ((lane & 3) == 0) { const int e = ((lane >> 5) & 1) * 8 + ((lane >> 4) & 1) * 4 + ((lane >> 3) & 1) * 2 + ((lane >> 2) & 1);
                    AFF[(size_t)rowa * 16 + e] = ea / sua; AFF[(size_t)rowb * 16 + e] = eb / sub; }
            }
        }
        if (BOTH(9)) xcd_barrier(bar);
    }
    TEND(9);
    TBEG(10);
    if (IN(10)) for (int rep_ = 0; rep_ <= ((PROBE_MASK >> 10) & 1) * PROBE_REPS; ++rep_) {
        const bool split = G >= 64;
        if (!split || bx >= 32) {
            const int w2 = split ? (bx - 32) * NWAVES + wave : bx * NWAVES + wave, NW2 = (split ? G - 32 : G) * NWAVES;
            LAS float* scr = (LAS float*)(lds + RING_OFF + wave * 16384);
            auto mk = [&](int it) { const int e = it >> 10, which = (it >> 9) & 1; return TItem{(which ? args.in[I_WEU] : args.in[I_WEG]) + (size_t)e * 1048576, (bf16*)(ws + (e < WGU_NLO ? WS_WGU : WS_WGU_HI)) + (size_t)(e < WGU_NLO ? e : e - WGU_NLO) * 2097152, 1024, 1024, it & 511}; };
            int it = (G > 128 ? WGU_NLO * 1024 : 0) + w2; f32x4 lda[8], ldb[8];
            if (it < 16 * 2 * 512) titem_load(mk(it), lda, lane);
            while (it < 16 * 2 * 512) {
                const int itn = it + NW2, it2 = itn + NW2;
                if (itn < 16 * 2 * 512) titem_load(mk(itn), ldb, lane);
                if ((it >> 9) & 1) titem_finish<3>(mk(it), lda, scr, lane); else titem_finish<2>(mk(it), lda, scr, lane);
                if (itn >= 16 * 2 * 512) break;
                if (it2 < 16 * 2 * 512) titem_load(mk(it2), lda, lane);
                if ((itn >> 9) & 1) titem_finish<3>(mk(itn), ldb, scr, lane); else titem_finish<2>(mk(itn), ldb, scr, lane);
                it = it2;
            }
        }
        if (split) { if (bx < 32) topk_select(ws, lds_raw, bx, tid, lane, wave); }
        else { __syncthreads(); for (int be = bx; be < 32; be += G) topk_select(ws, lds_raw, be, tid, lane, wave); }
        if (BOTH(10)) xcd_barrier(bar);
    }
    TEND(10);
    TBEG(12);
    if (IN(12)) for (int rep_ = 0; rep_ <= ((PROBE_MASK >> 12) & 1) * PROBE_REPS; ++rep_) {
        pg8::Gemm g{Hb, (const bf16*)(ws + WS_WGU), 32768, 2048, 1024};
        pg8::ExpertOrder<8> S; S.init(G, bx, WGU_NLO, WGU_HI_PN);
        pg8::EpiHid E{(bf16*)(ws + WS_HID)};
        pg8::gemm_phase<pg8::EpiHid, pg8::ExpertOrder<8>, true, true, pg8::ExpertGather>(lds + RING_OFF, g, S, E, pg8::ExpertGather{(const int*)(ws + WS_IDX)});
        if (BOTH(12)) xcd_barrier(bar);
    }
    TEND(12);
    TBEG(13);
    if (IN(13)) for (int rep_ = 0; rep_ <= ((PROBE_MASK >> 13) & 1) * PROBE_REPS; ++rep_) {
        pg8::Gemm g{(const bf16*)(ws + WS_HID), (const bf16*)(ws + WS_WD), 32768, 1024, 1024};
        pg8::ExpertOrder<4> S; S.init(G, bx);
        pg8::EpiDown E{(const float*)(ws + WS_GSEL), (bf16*)(ws + WS_XE)};
        pg8::gemm_phase<pg8::EpiDown, pg8::ExpertOrder<4>, true>(lds + RING_OFF, g, S, E);
        if (BOTH(13)) xcd_barrier(bar);
    }
    TEND(13);
    TBEG(14);
    if (IN(14)) for (int rep_ = 0; rep_ <= ((PROBE_MASK >> 14) & 1) * PROBE_REPS; ++rep_) {
        const int* SLOT = (const int*)(ws + WS_SLOT); const bf16* Y = (const bf16*)(ws + WS_XE);
        for (int blk = gw; blk < MLAT / 8; blk += NGW) {
            const int row0 = blk * 8, b = row0 >> 13, t0 = row0 & 8191;
            const int sv0 = SLOT[(b * 16 + (lane & 15)) * 8192 + t0 + (lane >> 4)], sv1 = SLOT[(b * 16 + (lane & 15)) * 8192 + t0 + 4 + (lane >> 4)];
            f32x4 cg[4];
#pragma unroll
            for (int j = 0; j < 4; ++j) cg[j] = *(const f32x4*)(mod + b * 6144 + 5120 + j * 256 + lane * 4);
#pragma unroll 1
            for (int rp = 0; rp < 4; ++rp) {
                const int sv = rp < 2 ? sv0 : sv1, lbase = (rp & 1) * 32;
                unsigned mask = (unsigned)__builtin_amdgcn_readfirstlane((int)(unsigned)(__ballot(sv >= 0) >> lbase));
                float* oa = args.out + (size_t)(row0 + 2 * rp) * D + lane * 4; float* ob = oa + D;
                f32x4 xa[4], xb[4], aa[4], ab[4];
#pragma unroll
                for (int j = 0; j < 4; ++j) { xa[j] = *(const f32x4*)(oa + j * 256); xb[j] = *(const f32x4*)(ob + j * 256); aa[j] = (f32x4){0.f, 0.f, 0.f, 0.f}; ab[j] = aa[j]; }
                for (;;) {
                    const bf16* p[4]; float fa[4], fb[4];
#pragma unroll
                    for (int q = 0; q < 4; ++q) {
                        if (mask) { const int bit = __builtin_ctz(mask); mask &= mask - 1u; const int s = __builtin_amdgcn_readlane(sv, lbase + bit), e = bit & 15;
                            p[q] = Y + ((size_t)(b * 16 + e) * 1024 + s) * D; fa[q] = bit < 16 ? 1.f : 0.f; fb[q] = 1.f - fa[q]; }
                        else { p[q] = Y; fa[q] = 0.f; fb[q] = 0.f; }
                    }
                    pg8::u32x2 w[4][4];
#pragma unroll
                    for (int q = 0; q < 4; ++q)
#pragma unroll
                        for (int j = 0; j < 4; ++j) w[q][j] = *(const pg8::u32x2*)(p[q] + j * 256 + lane * 4);
#pragma unroll
                    for (int q = 0; q < 4; ++q)
#pragma unroll
                        for (int j = 0; j < 4; ++j) { const f32x4 v = {__uint_as_float(w[q][j].x << 16), __uint_as_float(w[q][j].x & 0xffff0000u), __uint_as_float(w[q][j].y << 16), __uint_as_float(w[q][j].y & 0xffff0000u)};
                            aa[j] += v * fa[q]; ab[j] += v * fb[q]; }
                    if (!mask) break;
                }
#pragma unroll
                for (int j = 0; j < 4; ++j) { *(f32x4*)(oa + j * 256) = xa[j] + cg[j] * aa[j]; *(f32x4*)(ob + j * 256) = xb[j] + cg[j] * ab[j]; }
            }
        }
    }
    TEND(14);
#if defined(TIME_MASK)
    if (bx == 0 && tid == 0) { const unsigned long long te_ = __builtin_amdgcn_s_memrealtime(); while (__builtin_amdgcn_s_memrealtime() - te_ < tacc_) __builtin_amdgcn_s_sleep(4); }
#endif
#undef IN
#undef BOTH
}
extern "C" void kernel_launch(void* const* d_in, const int* in_sizes, int n_in, void* d_out, int out_size, void* d_ws, size_t ws_size, hipStream_t stream) {
    static int grid = 0;
    if (grid == 0) {
        if (n_in != 29 || ws_size < WS_END) { fprintf(stderr, "kernel_launch: bad arguments (n_in %d, ws %zu)\n", n_in, ws_size); grid = -1; return; }
        int dev = 0, cus = 0;
        if (hipGetDevice(&dev) != hipSuccess || hipDeviceGetAttribute(&cus, hipDeviceAttributeMultiprocessorCount, dev) != hipSuccess) { grid = -1; return; }
        if (hipFuncSetAttribute((const void*)mega, hipFuncAttributeMaxDynamicSharedMemorySize, LDS_BYTES) != hipSuccess) { fprintf(stderr, "kernel_launch: hipFuncSetAttribute failed\n"); grid = -1; return; }
        (void)hipGetLastError();
        grid = cus;
    }
    if (grid < 0) return;
    float* out = (float*)d_out; unsigned char* ws = (unsigned char*)d_ws;
    (void)hipMemsetAsync(ws + WS_CTL, 0, CTL_ZERO_BYTES, stream);
    Args a{};
    for (int i = 0; i < 29; ++i) a.in[i] = (const float*)d_in[i];
    a.out = out; a.ws = ws;
#if defined(PROBE_LO)
    a.ph_lo = 0; a.ph_hi = PROBE_HI; a.li = 0;
    hipLaunchKernelGGL(mega, dim3(grid), dim3(NWAVES * 64), LDS_BYTES, stream, a);
    a.ph_lo = PROBE_LO; a.ph_hi = PROBE_HI; a.li = 1;
    hipLaunchKernelGGL(mega, dim3(grid), dim3(NWAVES * 64), LDS_BYTES, stream, a);
    a.ph_lo = PROBE_HI; a.ph_hi = 15; a.li = 2;
    hipLaunchKernelGGL(mega, dim3(grid), dim3(NWAVES * 64), LDS_BYTES, stream, a);
#elif defined(PER_PHASE)
    for (int k = 0; k < 15; ++k) { if (k == 11) continue; a.ph_lo = k; a.ph_hi = k + 1; a.li = 0; hipLaunchKernelGGL(mega, dim3(grid), dim3(NWAVES * 64), LDS_BYTES, stream, a); }
#else
    a.ph_lo = 0; a.ph_hi = 15; a.li = 0;
    hipLaunchKernelGGL(mega, dim3(grid), dim3(NWAVES * 64), LDS_BYTES, stream, a);
#endif
}
```

```cpp
#include <hip/hip_runtime.h>
#include <cstdio>
#include <cstdint>
#include <stdint.h>

__device__ __forceinline__ float bf2f(unsigned short v) { return __uint_as_float(((unsigned)v) << 16); }
__device__ __forceinline__ float silu_f(float x) { return x * __builtin_amdgcn_rcpf(1.f + __expf(-x)); }
__device__ __forceinline__ float sigmoid_f(float x) { return __builtin_amdgcn_rcpf(1.f + __expf(-x)); }
__device__ __forceinline__ float gelu_tanh(float y) { return 0.5f * y * (1.f + tanhf(0.7978845608028654f * (y + 0.044715f * y * y * y))); }

constexpr int D = 1024, SEQ = 8192, MLAT = 16384, NCTX = 256, MCTX = 512, MALL = MLAT + MCTX;
constexpr float EPS = 1e-6f;
namespace pg8 {
#define PG8_LAS __attribute__((address_space(3)))
typedef unsigned short bf16_t;
typedef short bf16x8 __attribute__((ext_vector_type(8)));
typedef float f32x4 __attribute__((ext_vector_type(4)));
typedef unsigned u32x4 __attribute__((ext_vector_type(4)));
constexpr int BM = 256, BK = 64, HALF = 128, HTB = HALF * BK * 2  , STAGE_BYTES = 8 * HTB, NXCD = 8, WGM = 8;

__host__ __device__ __forceinline__ int lds_byte(int r, int c) { const int st = (r >> 4) * 2 + (c >> 5), rr = r & 15, cc = c & 31, ob = rr * 64 + cc * 2; return st * 1024 + (ob ^ (((ob >> 9) & 1) << 5)); }
__host__ __device__ __forceinline__ void stage_rc(int b, int& R, int& C) { const int st = b / 1024, sb = b % 1024, swz = sb ^ (((sb >> 9) & 1) << 5); R = (st >> 1) * 16 + swz / 64; C = (st & 1) * 32 + (swz % 64) / 2; }
__host__ __device__ __forceinline__ int perm32(int rho) { const int n = rho >> 4, i = rho & 15; return 8 * (i >> 2) + 4 * n + (i & 3); }

struct Unit { int pm, pn; };
struct Gemm { const bf16_t* A; const bf16_t* Bt; int M, N, K; };

struct StaticOrder {
    int nM, nN, nwg, G, c;
    __host__ __device__ void init(int M, int N, int G_, int c_) { nM = M / BM; nN = N / BM; nwg = nM * nN; G = G_; c = c_; }
    __host__ __device__ bool next(int i, Unit& u) const {
        const long L = (long)i * G + c; if (L >= nwg) return false;
        int wgid = (int)L; { const int q = nwg / NXCD, r = nwg % NXCD, xcd = wgid % NXCD, off = wgid / NXCD; wgid = (xcd < r ? xcd * (q + 1) : r * (q + 1) + (xcd - r) * q) + off; }
        const int nig = WGM * nN, gid = wgid / nig, fm = gid * WGM, gsz = (nM - fm) < WGM ? (nM - fm) : WGM;
        u.pm = fm + ((wgid % nig) % gsz); u.pn = (wgid % nig) / gsz; return true;
    }
    __device__ __forceinline__ void a_ready(const Unit&) const {}
    __device__ __forceinline__ void done(const Unit&) const {}
};

typedef float f32x2_cv __attribute__((ext_vector_type(2)));
typedef __bf16 bf16x2_cv __attribute__((ext_vector_type(2)));
__device__ __forceinline__ unsigned cvt_pk_bf16(float lo, float hi) { const f32x2_cv v = {lo, hi}; return __builtin_bit_cast(unsigned, __builtin_convertvector(v, bf16x2_cv)); }
typedef float f32x2 __attribute__((ext_vector_type(2)));
typedef unsigned u32x2 __attribute__((ext_vector_type(2)));
__device__ __forceinline__ u32x4 pack8(const f32x4 a, const f32x4 b) { u32x4 w; w.x = cvt_pk_bf16(a[0], a[1]); w.y = cvt_pk_bf16(a[2], a[3]); w.z = cvt_pk_bf16(b[0], b[1]); w.w = cvt_pk_bf16(b[2], b[3]); return w; }
__device__ __forceinline__ f32x4 sig4(const f32x4 v) { f32x4 r; r[0] = sigmoid_f(v[0]); r[1] = sigmoid_f(v[1]); r[2] = sigmoid_f(v[2]); r[3] = sigmoid_f(v[3]); return r; }
__device__ __forceinline__ void unpack8(const u32x4 w, f32x4& a, f32x4& b) {
    a[0] = __uint_as_float(w.x << 16); a[1] = __uint_as_float(w.x & 0xffff0000u); a[2] = __uint_as_float(w.y << 16); a[3] = __uint_as_float(w.y & 0xffff0000u);
    b[0] = __uint_as_float(w.z << 16); b[1] = __uint_as_float(w.z & 0xffff0000u); b[2] = __uint_as_float(w.w << 16); b[3] = __uint_as_float(w.w & 0xffff0000u); }

struct OneUnit {
    int pm, pn;
    __device__ bool next(int i, Unit& u) const { u.pm = pm; u.pn = pn; return i == 0; }
    __device__ __forceinline__ void a_ready(const Unit&) const {}
    __device__ __forceinline__ void done(const Unit&) const {}
};
struct InprojOrder {
    StaticOrder so; int G, c; bool with_ctx;
    __device__ void init(int G_, int c_, bool wc_) { so.init(MLAT, 4096, G_, c_); G = G_; c = c_; with_ctx = wc_; }
    __device__ bool next(int i, Unit& u) const {
        const long L = (long)i * G + c; if (L < 1024) return so.next(i, u);
        const int r = (int)(L - 1024); if (r >= 12 || !with_ctx) return false;
        const int j = r % 6; u.pm = 64 + r / 6; u.pn = j < 2 ? j : j + 2; return true;
    }
    __device__ __forceinline__ void a_ready(const Unit&) const {}
    __device__ __forceinline__ void done(const Unit&) const {}
};
struct EpiInproj {
    static constexpr bool PERM = true, AFTER_DRAIN = false, MID = false;
    bf16_t *U, *Q, *K, *V, *SGA, *SGB; const float *qn, *kn;
    __device__ __forceinline__ void operator()(const f32x4 (&acc)[2][2][4][2], const Unit& u, int wr, int wc, int fr, int fq) const {
        const int row0 = u.pm * BM + wr * 64 + fr, pn = u.pn;
        if (pn < 2 || pn == 6 || pn == 7) {
            bf16_t* base = (pn < 2 ? U : V) + (pn & 1) * 256 + wc * 32 + 8 * fq;
#pragma unroll
            for (int ai = 0; ai < 2; ++ai)
#pragma unroll
                for (int m = 0; m < 4; ++m) { bf16_t* rowp = base + (size_t)(row0 + ai * HALF + m * 16) * 512;
#pragma unroll
                    for (int bj = 0; bj < 2; ++bj) *(u32x4*)(rowp + bj * HALF) = pack8(acc[ai][bj][m][0], acc[ai][bj][m][1]); }
        } else if (pn < 6) {
            const bool isq = pn < 4; const float* wn = isq ? qn : kn; const float sc = isq ? 0.125f * 1.4426950408889634f : 1.f;
            bf16_t* base = (isq ? Q : K) + ((pn & 1) * 4 + wc) * 64 + 8 * fq;
            f32x4 wv[2][2];
#pragma unroll
            for (int bj = 0; bj < 2; ++bj)
#pragma unroll
                for (int n = 0; n < 2; ++n) wv[bj][n] = *(const f32x4*)(wn + 32 * bj + 8 * fq + 4 * n);
#pragma unroll
            for (int ai = 0; ai < 2; ++ai)
#pragma unroll
                for (int m = 0; m < 4; ++m) {
                    float ss = 0.f;
#pragma unroll
                    for (int bj = 0; bj < 2; ++bj)
#pragma unroll
                        for (int n = 0; n < 2; ++n) { const f32x4 x = acc[ai][bj][m][n]; ss += (x[0] * x[0] + x[1] * x[1]) + (x[2] * x[2] + x[3] * x[3]); }
                    ss += __shfl_xor(ss, 16); ss += __shfl_xor(ss, 32);
                    const float r = rsqrtf(ss * (1.f / 64.f) + EPS) * sc;
                    bf16_t* rowp = base + (size_t)(row0 + ai * HALF + m * 16) * 512;
#pragma unroll
                    for (int bj = 0; bj < 2; ++bj) *(u32x4*)(rowp + bj * 32) = pack8(acc[ai][bj][m][0] * r * wv[bj][0], acc[ai][bj][m][1] * r * wv[bj][1]);
                }
        } else {
            bf16_t* base = (pn < 12 ? SGA : SGB) + ((pn - 8) & 3) * 256 + wc * 32 + 8 * fq;
#pragma unroll
            for (int ai = 0; ai < 2; ++ai)
#pragma unroll
                for (int m = 0; m < 4; ++m) { bf16_t* rowp = base + (size_t)(row0 + ai * HALF + m * 16) * 1024;
#pragma unroll
                    for (int bj = 0; bj < 2; ++bj) __builtin_nontemporal_store(pack8(sig4(acc[ai][bj][m][0]), sig4(acc[ai][bj][m][1])), (u32x4*)(rowp + bj * HALF)); }
        }
    }
};
struct EpiGlu {
    static constexpr bool PERM = true, AFTER_DRAIN = false, MID = false;
    const bf16_t* Ain; const float* bglu; bf16_t* YA; int ldo;
    __device__ __forceinline__ void operator()(const f32x4 (&acc)[2][2][4][2], const Unit& u, int wr, int wc, int fr, int fq) const {
        const int row0 = u.pm * BM + wr * 64 + fr, col0 = u.pn * BM + wc * 32 + 8 * fq;
        f32x4 bv[2][2];
#pragma unroll
        for (int bj = 0; bj < 2; ++bj)
#pragma unroll
            for (int n = 0; n < 2; ++n) bv[bj][n] = *(const f32x4*)(bglu + col0 + bj * HALF + 4 * n);
#pragma unroll
        for (int ai = 0; ai < 2; ++ai)
#pragma unroll
            for (int m = 0; m < 4; ++m) { const size_t off = (size_t)(row0 + ai * HALF + m * 16) * 512 + col0, offo = (size_t)(row0 + ai * HALF + m * 16) * ldo + col0;
#pragma unroll
                for (int bj = 0; bj < 2; ++bj) { f32x4 a0, a1; unpack8(*(const u32x4*)(Ain + off + bj * HALF), a0, a1);
                    *(u32x4*)(YA + offo + bj * HALF) = pack8(a0 * sig4(acc[ai][bj][m][0] + bv[bj][0]), a1 * sig4(acc[ai][bj][m][1] + bv[bj][1])); } }
    }
};
struct EpiMerge {
    static constexpr bool PERM = true, AFTER_DRAIN = false, MID = true;
    const bf16_t* SGA; const bf16_t* SGB; bf16_t* Mo;
    __device__ __forceinline__ void mid(f32x4 (&acc)[2][2][4][2], const Unit& u, int wr, int wc, int fr, int fq) const {
        int row0_ = u.pm * BM + wr * 64 + fr, col0_ = u.pn * BM + wc * 32 + 8 * fq;
        asm volatile("" : "+v"(row0_), "+v"(col0_));
        const int row0 = row0_, col0 = col0_;
#pragma unroll
        for (int ai = 0; ai < 2; ++ai)
#pragma unroll
            for (int m = 0; m < 4; ++m) { const size_t off = (size_t)(row0 + ai * HALF + m * 16) * 1024 + col0;
#pragma unroll
                for (int bj = 0; bj < 2; ++bj) { f32x4 a0, a1, b0, b1; unpack8(*(const u32x4*)(SGA + off + bj * HALF), a0, a1); unpack8(*(const u32x4*)(SGB + off + bj * HALF), b0, b1);
#pragma unroll
                    for (int e = 0; e < 4; ++e) { acc[ai][bj][m][0][e] *= a0[e] * __builtin_amdgcn_rcpf(b0[e]); acc[ai][bj][m][1][e] *= a1[e] * __builtin_amdgcn_rcpf(b1[e]); } }
                if (m == 3) __builtin_amdgcn_sched_barrier(0); }
    }
    __device__ __forceinline__ void operator()(const f32x4 (&acc)[2][2][4][2], const Unit& u, int wr, int wc, int fr, int fq) const {
        int row0_ = u.pm * BM + wr * 64 + fr, col0_ = u.pn * BM + wc * 32 + 8 * fq;
        asm volatile("" : "+v"(row0_), "+v"(col0_));
        const int row0 = row0_, col0 = col0_;
#pragma unroll
        for (int ai = 0; ai < 2; ++ai)
#pragma unroll
            for (int m = 0; m < 4; ++m) { const size_t off = (size_t)(row0 + ai * HALF + m * 16) * 1024 + col0;
#pragma unroll
                for (int bj = 0; bj < 2; ++bj) { f32x4 b0, b1; unpack8(*(const u32x4*)(SGB + off + bj * HALF), b0, b1);
                    *(u32x4*)(Mo + off + bj * HALF) = pack8(acc[ai][bj][m][0] * b0, acc[ai][bj][m][1] * b1); } }
    }
};
struct ExpertGather { const int* idx; __device__ __forceinline__ unsigned row(int pm, int r) const { return (unsigned)((pm >> 6) * SEQ + idx[pm * BM + r]); } };
struct EpiOut {
    static constexpr bool PERM = true, AFTER_DRAIN = false, MID = false;
    const float* mod; bf16_t* Dr;
    __device__ __forceinline__ void operator()(const f32x4 (&acc)[2][2][4][2], const Unit& u, int wr, int wc, int fr, int fq) const {
        const int row0 = u.pm * BM + wr * 64 + fr, col0 = u.pn * BM + wc * 32 + 8 * fq;
        const float* g1 = mod + ((u.pm * BM) >> 13) * 6144 + 2048;
        f32x4 gv[2][2];
#pragma unroll
        for (int bj = 0; bj < 2; ++bj)
#pragma unroll
            for (int n = 0; n < 2; ++n) gv[bj][n] = *(const f32x4*)(g1 + col0 + bj * HALF + 4 * n);
#pragma unroll
        for (int ai = 0; ai < 2; ++ai)
#pragma unroll
            for (int m = 0; m < 4; ++m) { bf16_t* rowp = Dr + (size_t)(row0 + ai * HALF + m * 16) * 2048 + col0;
#pragma unroll
                for (int bj = 0; bj < 2; ++bj) *(u32x4*)(rowp + bj * HALF) = pack8(acc[ai][bj][m][0] * gv[bj][0], acc[ai][bj][m][1] * gv[bj][1]); }
    }
};
struct EpiHid {
    static constexpr bool PERM = true, AFTER_DRAIN = false, MID = false;
    bf16_t* HID;
    __device__ __forceinline__ void operator()(const f32x4 (&acc)[2][2][4][2], const Unit& u, int wr, int wc, int fr, int fq) const {
        const int row0 = u.pm * BM + wr * 64 + fr, f0 = (u.pn & 7) * 128 + wc * 16 + 4 * fq;
#pragma unroll
        for (int ai = 0; ai < 2; ++ai)
#pragma unroll
            for (int m = 0; m < 4; ++m) { bf16_t* rowp = HID + (size_t)(row0 + ai * HALF + m * 16) * 1024 + f0;
#pragma unroll
                for (int bj = 0; bj < 2; ++bj) { const f32x4 g = acc[ai][bj][m][0], up = acc[ai][bj][m][1];
                    u32x2 w; w.x = cvt_pk_bf16(silu_f(g[0]) * up[0], silu_f(g[1]) * up[1]); w.y = cvt_pk_bf16(silu_f(g[2]) * up[2], silu_f(g[3]) * up[3]);
                    *(u32x2*)(rowp + bj * 64) = w; } }
    }
};
struct EpiDown {
    static constexpr bool PERM = true, AFTER_DRAIN = false, MID = false;
    const float* GSEL; bf16_t* Y;
    __device__ __forceinline__ void operator()(const f32x4 (&acc)[2][2][4][2], const Unit& u, int wr, int wc, int fr, int fq) const {
        const int row0 = u.pm * BM + wr * 64 + fr, col0 = (u.pn & 3) * BM + wc * 32 + 8 * fq;
#pragma unroll
        for (int ai = 0; ai < 2; ++ai)
#pragma unroll
            for (int m = 0; m < 4; ++m) { const int row = row0 + ai * HALF + m * 16; const float gs = GSEL[row]; bf16_t* rowp = Y + (size_t)row * 1024 + col0;
#pragma unroll
                for (int bj = 0; bj < 2; ++bj) *(u32x4*)(rowp + bj * HALF) = pack8(acc[ai][bj][m][0] * gs, acc[ai][bj][m][1] * gs); }
    }
};
template <int NT  > struct ExpertOrder {
    int G, c, e_hi, pn_hi;
    __device__ void init(int G_, int c_, int e_hi_ = 16, int pn_hi_ = 0) { G = G_; c = c_; e_hi = e_hi_; pn_hi = pn_hi_; }
    __device__ bool next(int i, Unit& u) const {
        constexpr int UPE = 8 * NT;
        long L = (long)i * G + c; if (L >= 16 * UPE) return false;
        if (G == 256) { const int xcd = c & 7, local = c >> 3, rpe = UPE / 32  ; L = (long)(xcd + 8 * (i / rpe)) * UPE + (i % rpe) * 32 + local; }
        const int e = (int)(L / UPE), uu = (int)(L % UPE), b = uu / (4 * NT), m = (uu / NT) & 3, j = uu % NT;
        u.pm = (b * 16 + e) * 4 + m; u.pn = e * NT + j + (e >= e_hi ? pn_hi : 0); return true;
    }
    __device__ __forceinline__ void a_ready(const Unit&) const {}
    __device__ __forceinline__ void done(const Unit&) const {}
};
struct NoGather { __device__ __forceinline__ unsigned row(int, int r) const { return (unsigned)r; } };
template <class Epi, class Sched, bool ALIGN_EPI = false, bool GATHER = false, class Gat = NoGather>
__device__ __forceinline__ void gemm_phase(PG8_LAS unsigned char* lds, const Gemm g, const Sched& S, const Epi& E, const Gat gat = Gat()) {
    const int tid = threadIdx.x, wid = __builtin_amdgcn_readfirstlane(tid >> 6), lane = tid & 63, wr = wid >> 2, wc = wid & 3, fr = lane & 15, fq = lane >> 4;
    const int K = g.K, nt = K / BK;
    const size_t kstep = (size_t)(BK * 2);
    const size_t hstep = (size_t)HALF * K * 2;
    const size_t tstep = 2 * hstep;
    unsigned voffB[2]; int Ra[2], Ca[2];
#pragma unroll
    for (int i = 0; i < 2; ++i) { int R, C; stage_rc(tid * 16 + i * 8192, R, C); const int Rb = Epi::PERM ? ((R & ~31) + perm32(R & 31)) : R;
        Ra[i] = R; Ca[i] = C; voffB[i] = (unsigned)(Rb * K + C) * 2u; }
    unsigned vAc[2][2], vAn[2][2];
#define PG8_AOFF(dst, pm) do { _Pragma("unroll") for (int h_ = 0; h_ < 2; ++h_) _Pragma("unroll") for (int i_ = 0; i_ < 2; ++i_) \
        dst[h_][i_] = GATHER ? (gat.row((pm), h_ * HALF + Ra[i_]) * (unsigned)K + (unsigned)Ca[i_]) * 2u : (unsigned)((h_ * HALF + Ra[i_]) * K + Ca[i_]) * 2u; } while (0)
    const unsigned ldsw = (unsigned)wid * 1024u;
    const int aoff = lds_byte(wr * 64 + fr, fq * 8), boff = lds_byte(wc * 32 + fr, fq * 8);
#define PG8_SA(b, h) (((b) * 2 + (h)) * HTB)
#define PG8_SB(b, h) ((4 + (b) * 2 + (h)) * HTB)
#define PG8_STAGE(bufoff, gbase, voff) do { _Pragma("unroll") for (int _i = 0; _i < 2; ++_i) \
        __builtin_amdgcn_global_load_lds((const unsigned*)((const char*)(gbase) + (voff)[_i]), (PG8_LAS unsigned*)(lds + (bufoff) + ldsw + _i * 8192), 16, 0, 0); } while (0)
#define PG8_LDA(dst, b, h) do { _Pragma("unroll") for (int m = 0; m < 4; ++m) _Pragma("unroll") for (int k = 0; k < 2; ++k) dst[m][k] = *(const PG8_LAS bf16x8*)(lds + PG8_SA(b, h) + aoff + m * 2048 + k * 1024); } while (0)
#define PG8_LDB(dst, b, h) do { _Pragma("unroll") for (int n = 0; n < 2; ++n) _Pragma("unroll") for (int k = 0; k < 2; ++k) dst[n][k] = *(const PG8_LAS bf16x8*)(lds + PG8_SB(b, h) + boff + n * 2048 + k * 1024); } while (0)
#define PG8_MMA(ai, bj, At, Bt) do { __builtin_amdgcn_s_setprio(1); _Pragma("unroll") for (int m = 0; m < 4; ++m) _Pragma("unroll") for (int n = 0; n < 2; ++n) _Pragma("unroll") for (int k = 0; k < 2; ++k) \
        acc[ai][bj][m][n] = __builtin_amdgcn_mfma_f32_16x16x32_bf16(Bt[n][k], At[m][k], acc[ai][bj][m][n], 0, 0, 0); __builtin_amdgcn_s_setprio(0); } while (0)
#define PG8_WAIT_V(n) asm volatile("s_waitcnt vmcnt(" #n ")" ::: "memory")
#define PG8_WAIT_L(n) asm volatile("s_waitcnt lgkmcnt(" #n ")" ::: "memory")
#define PG8_BAR __builtin_amdgcn_s_barrier()
#define PG8_SCHED __builtin_amdgcn_sched_barrier(0)
    Unit cur, nxt; int ui = 0;
    if (!S.next(0, cur)) return;
    f32x4 acc[2][2][4][2];
#pragma unroll
    for (int a = 0; a < 2; ++a)
#pragma unroll
        for (int b = 0; b < 2; ++b)
#pragma unroll
            for (int m = 0; m < 4; ++m)
#pragma unroll
                for (int n = 0; n < 2; ++n) acc[a][b][m][n] = (f32x4){0.f, 0.f, 0.f, 0.f};
    bf16x8 At[4][2], B0[2][2], B1[2][2];
    const char* cA = (const char*)g.A + (GATHER ? (size_t)0 : (size_t)cur.pm * tstep); const char* cB = (const char*)g.Bt + (size_t)cur.pn * tstep;
    PG8_AOFF(vAc, cur.pm);
    S.a_ready(cur);
    PG8_STAGE(PG8_SB(0, 0), cB, voffB); PG8_STAGE(PG8_SB(0, 1), cB + hstep, voffB); PG8_STAGE(PG8_SA(0, 0), cA, vAc[0]); PG8_STAGE(PG8_SA(0, 1), cA, vAc[1]);
    if (wr == 1) PG8_BAR;
    PG8_WAIT_V(2); PG8_BAR;
    PG8_STAGE(PG8_SB(1, 0), cB + kstep, voffB); PG8_STAGE(PG8_SA(1, 0), cA + kstep, vAc[0]); PG8_STAGE(PG8_SB(1, 1), cB + hstep + kstep, voffB);
    PG8_WAIT_V(6); PG8_BAR;
    for (;;) {
        const bool has_next = S.next(ui + 1, nxt);
        const char* nA = (has_next && !GATHER) ? (const char*)g.A + (size_t)nxt.pm * tstep : cA; const char* nB = has_next ? (const char*)g.Bt + (size_t)nxt.pn * tstep : cB;
        if (has_next) PG8_AOFF(vAn, nxt.pm); else { _Pragma("unroll") for (int h_ = 0; h_ < 2; ++h_) _Pragma("unroll") for (int i_ = 0; i_ < 2; ++i_) vAn[h_][i_] = vAc[h_][i_]; }
        for (int t = 0; t < nt; t += 2) {
            const bool last = (t == nt - 2);
            const char* a1 = cA + (size_t)(t + 1) * kstep;
            const char* a2 = last ? nA : cA + (size_t)(t + 2) * kstep; const char* b2 = last ? nB : cB + (size_t)(t + 2) * kstep;
            const char* a3 = a2 + kstep; const char* b3 = b2 + kstep;
            unsigned v2[2][2];
#pragma unroll
            for (int h_ = 0; h_ < 2; ++h_)
#pragma unroll
                for (int i_ = 0; i_ < 2; ++i_) v2[h_][i_] = last ? vAn[h_][i_] : vAc[h_][i_];
            if (last && has_next) S.a_ready(nxt);
            PG8_LDB(B0, 0, 0); PG8_LDB(B1, 0, 1); PG8_SCHED; PG8_LDA(At, 0, 0); PG8_STAGE(PG8_SA(1, 1), a1, vAc[1]);
            PG8_WAIT_V(8); PG8_WAIT_L(0); PG8_BAR; PG8_MMA(0, 0, At, B0); PG8_MMA(0, 1, At, B1); PG8_BAR; PG8_SCHED;
            PG8_LDA(At, 0, 1); PG8_STAGE(PG8_SB(0, 0), b2, voffB); PG8_STAGE(PG8_SB(0, 1), b2 + hstep, voffB); PG8_STAGE(PG8_SA(0, 0), a2, v2[0]);
            PG8_WAIT_V(8); PG8_WAIT_L(0); PG8_BAR; PG8_MMA(1, 0, At, B0); PG8_MMA(1, 1, At, B1); PG8_BAR; PG8_SCHED;
            PG8_LDB(B0, 1, 0); PG8_LDB(B1, 1, 1); PG8_SCHED; PG8_LDA(At, 1, 0); PG8_STAGE(PG8_SA(0, 1), a2, v2[1]);
            PG8_WAIT_V(8); PG8_WAIT_L(0); PG8_BAR; PG8_MMA(0, 0, At, B0); PG8_MMA(0, 1, At, B1); PG8_BAR; PG8_SCHED;
            PG8_LDA(At, 1, 1); PG8_STAGE(PG8_SB(1, 0), b3, voffB); PG8_STAGE(PG8_SB(1, 1), b3 + hstep, voffB); PG8_STAGE(PG8_SA(1, 0), a3, v2[0]);
            PG8_WAIT_V(8); PG8_WAIT_L(0); PG8_BAR; PG8_MMA(1, 0, At, B0); PG8_MMA(1, 1, At, B1); PG8_BAR; PG8_SCHED;
            if constexpr (Epi::MID) { if (t == nt / 2 - 2) { E.mid(acc, cur, wr, wc, fr, fq); PG8_SCHED; } }
        }
        if constexpr (ALIGN_EPI) { if (wr == 0) PG8_BAR; }
        if constexpr (!Epi::AFTER_DRAIN) { E(acc, cur, wr, wc, fr, fq); S.done(cur); }
        if (!has_next) break;
#pragma unroll
        for (int a = 0; a < 2; ++a)
#pragma unroll
            for (int b = 0; b < 2; ++b)
#pragma unroll
                for (int m = 0; m < 4; ++m)
#pragma unroll
                    for (int n = 0; n < 2; ++n) acc[a][b][m][n] = (f32x4){0.f, 0.f, 0.f, 0.f};
        cur = nxt; cA = nA; cB = nB; ++ui;
#pragma unroll
        for (int h_ = 0; h_ < 2; ++h_)
#pragma unroll
            for (int i_ = 0; i_ < 2; ++i_) vAc[h_][i_] = vAn[h_][i_];
        if constexpr (ALIGN_EPI) { if (wr == 1) PG8_BAR; }
    }
    PG8_WAIT_V(0);
    if constexpr (!ALIGN_EPI) { if (wr == 0) PG8_BAR; }
    PG8_BAR;
    if constexpr (Epi::AFTER_DRAIN) { E.fused(acc, cur, wr, wc, fr, fq, lds, wid, lane); S.done(cur); }
#undef PG8_AOFF
#undef PG8_SA
#undef PG8_SB
#undef PG8_STAGE
#undef PG8_LDA
#undef PG8_LDB
#undef PG8_MMA
#undef PG8_WAIT_V
#undef PG8_WAIT_L
#undef PG8_BAR
#undef PG8_SCHED
}
}
#define GAS __attribute__((address_space(1)))
#define LAS __attribute__((address_space(3)))
typedef unsigned short bf16;
typedef unsigned v4u __attribute__((ext_vector_type(4)));
typedef float f32x4 __attribute__((ext_vector_type(4)));
typedef short bf16x8 __attribute__((ext_vector_type(8)));
typedef GAS unsigned gu32;
typedef GAS unsigned long long gu64;
#define RLX_AGENT __ATOMIC_RELAXED, __HIP_MEMORY_SCOPE_AGENT
#define LDS_WAIT() asm volatile("s_waitcnt lgkmcnt(0)" ::: "memory")
#define VM_WAIT() asm volatile("s_waitcnt vmcnt(0)" ::: "memory")
__device__ __forceinline__ unsigned long long rt() { return __builtin_amdgcn_s_memrealtime(); }
__device__ __forceinline__ unsigned f2bf(float f) { unsigned u = __builtin_bit_cast(unsigned, f); return (u + 0x7fffu + ((u >> 16) & 1u)) >> 16; }
__device__ __forceinline__ unsigned pk2(float lo, float hi) { return pg8::cvt_pk_bf16(lo, hi); }

#define XB_TMO      128
#define XB_XCNT(j)  (256  + 64 * (j))
#define XB_XSUB(j)  (1280 + 64 * (j))
#define XB_XGEN(j)  (2304 + 64 * (j))
#define XB_TOP      3328
#define XB_TOPGEN   3392
#define XCD_BAR_WORDS 3456
#define XB_SPIN_CAP (1u << 18)

__device__ __forceinline__ unsigned xb_ld(unsigned* p)              { return __hip_atomic_load(p, __ATOMIC_RELAXED, __HIP_MEMORY_SCOPE_AGENT); }
__device__ __forceinline__ unsigned xb_add(unsigned* p, unsigned v) { return __hip_atomic_fetch_add(p, v, __ATOMIC_RELAXED, __HIP_MEMORY_SCOPE_AGENT); }
__device__ __forceinline__ unsigned xb_xcc_id() { return (unsigned)__builtin_amdgcn_s_getreg((3 << 11) | 20) & 0xFu; }
#define XB_SPIN(cond, bar) do { unsigned _sp = 0; while (cond) { __builtin_amdgcn_s_sleep(1); \
    if ((++_sp & 255u) == 0u) { if (xb_ld(&(bar)[XB_TMO])) break; if (_sp > XB_SPIN_CAP) { atomicAdd(&(bar)[XB_TMO], 1u); break; } } } } while (0)

struct XcdBarrier {
    unsigned* bar; unsigned x;
    volatile LAS unsigned* st;
};

__device__ __forceinline__ XcdBarrier xcd_barrier_post(unsigned* bar, volatile LAS unsigned* st) {
    XcdBarrier b; b.bar = bar; b.x = xb_xcc_id(); b.st = st;
    if (threadIdx.x == 0) (void)xb_add(&bar[XB_XCNT(b.x)], 1u);
    return b;
}
__device__ __forceinline__ void xcd_barrier_complete(unsigned* bar, unsigned x, unsigned& nloc, unsigned& nx) {
    const unsigned G = gridDim.x * gridDim.y * gridDim.z;
    unsigned sum, cnt, mine, sp = 0u;
    for (;;) {
        sum = 0u; cnt = 0u; mine = 0u;
#pragma unroll
        for (unsigned j = 0; j < 16; ++j) { const unsigned c = xb_ld(&bar[XB_XCNT(j)]); sum += c; cnt += (c > 0u) ? 1u : 0u; mine = (j == x) ? c : mine; }
        if (sum == G) break;
        __builtin_amdgcn_s_sleep(1);
        if ((++sp & 255u) == 0u) { if (xb_ld(&bar[XB_TMO])) break; if (sp > XB_SPIN_CAP) { atomicAdd(&bar[XB_TMO], 1u); break; } }
    }
    nloc = mine > 0u ? mine : 1u; nx = cnt > 0u ? cnt : 1u;
}

__device__ __forceinline__ void xcd_barrier(const XcdBarrier& b) {
    asm volatile("s_waitcnt vmcnt(0)" ::: "memory");
    __syncthreads();
    if (threadIdx.x == 0) {
        unsigned* bar = b.bar;
        __builtin_amdgcn_s_waitcnt(0);
        unsigned nloc = b.st[0], nx = b.st[1];
        if (nloc == 0u) { xcd_barrier_complete(bar, b.x, nloc, nx); b.st[0] = nloc; b.st[1] = nx; }
        const unsigned old = xb_add(&bar[XB_XSUB(b.x)], 1u);
        const unsigned gen = old / nloc;
        if (old + 1u == (gen + 1u) * nloc) {
            __builtin_amdgcn_fence(__ATOMIC_RELEASE, "agent");
            asm volatile("s_waitcnt vmcnt(0)" ::: "memory");
            const unsigned og = xb_add(&bar[XB_TOP], 1u);
            const unsigned tg = og / nx;
            if (og + 1u == (tg + 1u) * nx) xb_add(&bar[XB_TOPGEN], 1u);
            else XB_SPIN(xb_ld(&bar[XB_TOPGEN]) == tg, bar);
            __builtin_amdgcn_fence(__ATOMIC_ACQUIRE, "agent");
            xb_add(&bar[XB_XGEN(b.x)], 1u);
            asm volatile("s_waitcnt vmcnt(0)" ::: "memory");
        } else {
            XB_SPIN(xb_ld(&bar[XB_XGEN(b.x)]) == gen, bar);
            __builtin_amdgcn_fence(__ATOMIC_ACQUIRE, "agent");
            asm volatile("s_waitcnt vmcnt(0)" ::: "memory");
        }
    }
    __syncthreads();
}

#ifndef PROBE_MASK
#define PROBE_MASK 0
#endif
#ifndef PROBE_VARIANT
#define PROBE_VARIANT 7
#endif
#ifndef PROBE_REPS
#define PROBE_REPS 4
#endif
constexpr int NWAVES = 8;
constexpr size_t MiB = 1u << 20;
constexpr size_t WS_CTL = 0, CTL_ZERO_BYTES = 256 * 1024;
constexpr int CW_TMO = 0, CW_CODE = 1, CW_ADA = 2048  , CW_XTAB = 2560  , CW_GRP = 3072  , CW_BAR = 4096;
constexpr int NKP = 4;
constexpr size_t WS_MOD = 303 * MiB;
constexpr int MODP = 3 * 6144;
constexpr size_t WS_MODF = WS_MOD + NKP * MODP * 4;
constexpr size_t WS_AFF = 1 * MiB, WS_IDX = 2 * MiB, WS_GSEL = 2 * MiB + 256 * 1024, WS_SLOT = 3 * MiB;
constexpr size_t WS_H = 4 * MiB;
constexpr size_t WS_BG = 38 * MiB;
constexpr size_t WS_U = WS_BG, WS_V = WS_BG + 17 * MiB, WS_K = WS_BG + 34 * MiB, WS_Q = WS_BG + 51 * MiB, WS_SGA = WS_BG + 68 * MiB, WS_SGB = WS_BG + 100 * MiB;
constexpr size_t WS_YS = WS_BG + 132 * MiB, WS_YAB = WS_BG + 156 * MiB;
constexpr size_t WS_M = WS_BG;
constexpr size_t WS_XE = WS_BG, WS_HID = WS_BG + 132 * MiB;
constexpr size_t WS_WIN = 226 * MiB, WS_WGLU = 234 * MiB, WS_WPA = 235 * MiB, WS_WOUT = 237 * MiB;
constexpr size_t WS_WD = 239 * MiB;
constexpr int WGU_NLO = 8, WGU_NP2 = 4;
constexpr size_t WS_WGU = 271 * MiB, WS_WGU_HI = 103 * MiB, WS_END = 304 * MiB;
constexpr int DR_OFF = 1024, DR_LD = 2048;
constexpr size_t WS_A = WS_K;
constexpr int WGU_HI_PN = (int)(((long)WS_WGU_HI - (long)WS_WGU) / (512 * 1024)) - 8 * WGU_NLO;
static_assert(((long)WS_WGU - (long)WS_WGU_HI) % (4 * (long)MiB) == 0 && WS_WGU_HI + (16 - WGU_NLO) * 4 * MiB <= WS_HID && WS_XE + 64 * MiB <= WS_WGU_HI && WS_WD + 32 * MiB <= WS_WGU, "gate|up halves");
static_assert(WS_YAB + 32 * MiB <= WS_WIN && WS_HID + 64 * MiB <= WS_WD && WS_WOUT + 2 * MiB <= WS_WD, "d_ws map");
static_assert(CW_BAR * 4 + 8 * XCD_BAR_WORDS * 4 <= (int)CTL_ZERO_BYTES && WS_MODF + MODP * 4 <= WS_END && WS_MOD >= WS_WGU + 32 * MiB, "control region");
__device__ __forceinline__ f32x4 mod4(const float* p) { f32x4 s = *(const f32x4*)p;
#pragma unroll
    for (int q = 1; q < NKP; ++q) s += *(const f32x4*)(p + q * MODP);
    return s; }

constexpr int RING_OFF = 0, RING_BYTES = 131072;
constexpr int LDSCTL_OFF = RING_BYTES, MISC_OFF = LDSCTL_OFF + 320;
constexpr int LDS_BYTES = 147456;

__device__ __forceinline__ float wave_sum(float v) {
#pragma unroll
    for (int o = 1; o < 64; o <<= 1) v += __shfl_xor(v, o);
    return v;
}
template <int MODE> __device__ __forceinline__ int wrow(int n) {
    if (MODE == 1) { const int t = n >> 8, cl = n & 255; return (t >= 2 && t < 6) ? (t * 256 + 128 * ((cl >> 5) & 1) + 32 * (cl >> 6) + (cl & 31)) : n; }
    if (MODE == 2) return (n >> 2) * 8 + (n & 3);
    if (MODE == 3) return (n >> 2) * 8 + 4 + (n & 3);
    return n;
}
struct TItem { const float* W; bf16* WT; int N, ldw, item; };
__device__ __forceinline__ void titem_load(const TItem& t, f32x4 (&ld)[8], int lane) {
    const int nblk = t.N / 32, k0 = 64 * (t.item / nblk), n0 = 32 * (t.item % nblk);
#pragma unroll
    for (int i = 0; i < 8; ++i) ld[i] = __builtin_nontemporal_load((const f32x4*)(t.W + (size_t)(k0 + 8 * i + (lane >> 3)) * t.N + n0 + 4 * (lane & 7)));
}
template <int MODE> __device__ __forceinline__ void titem_finish(const TItem& t, const f32x4 (&ld)[8], LAS float* scr, int lane) {
    const int nblk = t.N / 32, k0 = 64 * (t.item / nblk), n0 = 32 * (t.item % nblk);
#pragma unroll
    for (int i = 0; i < 8; ++i) { LAS float* d = scr + (8 * i + (lane >> 3)) * 33 + 4 * (lane & 7); d[0] = ld[i][0]; d[1] = ld[i][1]; d[2] = ld[i][2]; d[3] = ld[i][3]; }
    LDS_WAIT(); asm volatile("" ::: "memory");
    const int c = lane & 7;
#pragma unroll
    for (int j = 0; j < 4; ++j) { const int n = (lane >> 3) + 8 * j; const LAS float* s = scr + (8 * c) * 33 + n;
        v4u o; o.x = pk2(s[0 * 33], s[1 * 33]); o.y = pk2(s[2 * 33], s[3 * 33]); o.z = pk2(s[4 * 33], s[5 * 33]); o.w = pk2(s[6 * 33], s[7 * 33]);
        *(GAS v4u*)(t.WT + (size_t)wrow<MODE>(n0 + n) * t.ldw + k0 + 8 * c) = o; }
    LDS_WAIT(); asm volatile("" ::: "memory");
}
template <int MODE> __device__ __forceinline__ void transpose_item(const float* W, int K, int N, bf16* WT, int ldw, LAS float* scr, int item, int lane) {
    const TItem t{W, WT, N, ldw, item}; f32x4 ld[8]; titem_load(t, ld, lane); titem_finish<MODE>(t, ld, scr, lane);
}
__device__ __forceinline__ void norm1_rows(const float* src0, bf16* dst0, int nrow, const float* gwt, const LAS f32x4* sm  , int lane) {
    f32x4 ca[4], cb[4];
#pragma unroll
    for (int j = 0; j < 4; ++j) { const int col = j * 256 + lane * 4; ca[j] = *(const f32x4*)(gwt + col) * (sm[256 + j * 64 + lane] + 1.f); cb[j] = sm[j * 64 + lane]; }
    f32x4 na[4], nb[4];
#pragma unroll
    for (int j = 0; j < 4; ++j) { na[j] = __builtin_nontemporal_load((const f32x4*)(src0 + j * 256 + lane * 4)); nb[j] = __builtin_nontemporal_load((const f32x4*)(src0 + (size_t)(nrow > 1 ? 1 : 0) * D + j * 256 + lane * 4)); }
#pragma unroll 1
    for (int rr = 0; rr < nrow; rr += 2) {
        const int rb_ = (rr + 1 < nrow) ? rr + 1 : rr;
        f32x4 va[4], vb[4]; float ssa = 0.f, ssb = 0.f;
#pragma unroll
        for (int j = 0; j < 4; ++j) { va[j] = na[j]; vb[j] = nb[j]; }
        if (rr + 2 < nrow) { const int r2 = rr + 2, r3 = (rr + 3 < nrow) ? rr + 3 : rr + 2;
#pragma unroll
            for (int j = 0; j < 4; ++j) { na[j] = __builtin_nontemporal_load((const f32x4*)(src0 + (size_t)r2 * D + j * 256 + lane * 4)); nb[j] = __builtin_nontemporal_load((const f32x4*)(src0 + (size_t)r3 * D + j * 256 + lane * 4)); } }
#pragma unroll
        for (int j = 0; j < 4; ++j) { ssa += (va[j][0] * va[j][0] + va[j][1] * va[j][1]) + (va[j][2] * va[j][2] + va[j][3] * va[j][3]); ssb += (vb[j][0] * vb[j][0] + vb[j][1] * vb[j][1]) + (vb[j][2] * vb[j][2] + vb[j][3] * vb[j][3]); }
        const float ra = rsqrtf(wave_sum(ssa) * (1.f / D) + EPS), rb = rsqrtf(wave_sum(ssb) * (1.f / D) + EPS);
#pragma unroll
        for (int j = 0; j < 4; ++j) {
            const int col = j * 256 + lane * 4;
            const f32x4 oa = va[j] * ra * ca[j] + cb[j], ob = vb[j] * rb * ca[j] + cb[j];
            pg8::u32x2 w; w.x = pk2(oa[0], oa[1]); w.y = pk2(oa[2], oa[3]); *(pg8::u32x2*)(dst0 + (size_t)rr * D + col) = w;
            w.x = pk2(ob[0], ob[1]); w.y = pk2(ob[2], ob[3]); *(pg8::u32x2*)(dst0 + (size_t)rb_ * D + col) = w;
        }
    }
}

__device__ __forceinline__ void grp_barrier(gu32* ctl, int bx, unsigned my_xcc, unsigned target, volatile LAS unsigned* st) {
    asm volatile("s_waitcnt vmcnt(0)" ::: "memory");
    __syncthreads();
    if (threadIdx.x == 0) {
        __builtin_amdgcn_s_waitcnt(0);
        unsigned f = st[0];
        if (f == 0u) { f = 2u;
            for (int m = 0; m < 32; ++m) if (__hip_atomic_load(ctl + CW_XTAB + (bx & 7) + 8 * m, RLX_AGENT) != my_xcc + 1u) f = 1u;
            st[0] = f; }
        if (f != 2u) { __builtin_amdgcn_fence(__ATOMIC_RELEASE, "agent"); asm volatile("s_waitcnt vmcnt(0)" ::: "memory"); }
        gu32* cnt = ctl + CW_GRP + 64 * (bx & 7);
        __hip_atomic_fetch_add(cnt, 1u, RLX_AGENT);
        unsigned sp = 0u;
        while (__hip_atomic_load(cnt, RLX_AGENT) < target) { __builtin_amdgcn_s_sleep(1); if (++sp > (1u << 22)) { __hip_atomic_store(ctl + CW_TMO, 1u, RLX_AGENT); break; } }
        __builtin_amdgcn_fence(__ATOMIC_ACQUIRE, "agent");
        asm volatile("s_waitcnt vmcnt(0)" ::: "memory");
    }
    __syncthreads();
}

struct Args { const float* in[29]; float* out; unsigned char* ws; int ph_lo, ph_hi, li, pad; };
enum { I_X = 0, I_C, I_CTX, I_CCTX, I_WADA, I_BADA, I_NMIX, I_NFFN, I_WIN, I_LRE, I_LIM, I_LDT, I_BRE, I_BIM, I_CRE, I_CIM, I_SD, I_WGLU, I_BGLU, I_QN, I_KN, I_RPB, I_WPA, I_WPB, I_WOUT, I_WR, I_WEG, I_WEU, I_WED };

typedef float f32x16 __attribute__((ext_vector_type(16)));
constexpr int S5_CH = 64, S5_NCH = 132, S5_NST = S5_CH / 16, S5_NPAIR = S5_NCH / 2, S5_NLAT = SEQ / S5_CH, S5_NCC = NCTX / S5_CH;
constexpr size_t WS_LAM = 512 * 1024, WS_LAMP = 512 * 1024 + 32768;
constexpr size_t WS_S5B = 2 * MiB + 512 * 1024, WS_S5C = 2 * MiB + 768 * 1024;
constexpr size_t WS_SEND = WS_YS, WS_HIN = WS_YS + 12 * MiB;

__device__ __forceinline__ void s5_prep(const Args& args, unsigned char* ws, int dg, int lane) {
    const float* lam_re = args.in[I_LRE]; const float* lam_im = args.in[I_LIM]; const float* b_re = args.in[I_BRE]; const float* b_im = args.in[I_BIM];
    const float* c_re = args.in[I_CRE]; const float* c_im = args.in[I_CIM];
    const float dt = expf(args.in[I_LDT][dg]);
    {
        const int p = lane; const float lre = lam_re[dg * 64 + p], lim = lam_im[dg * 64 + p];
        const float er = expf(lre * dt); float xr = er * cosf(lim * dt), xi = er * sinf(lim * dt);
        float* L = (float*)(ws + WS_LAM) + (dg * 64 + p) * 2; L[0] = xr; L[1] = xi;
#pragma unroll
        for (int s = 0; s < 6; ++s) { const float nr = xr * xr - xi * xi, ni = 2.f * xr * xi; xr = nr; xi = ni; }
        float* LP = (float*)(ws + WS_LAMP) + (dg * 64 + p) * 2; LP[0] = xr; LP[1] = xi;
    }
    const int r = lane & 31, h = lane >> 5;
#pragma unroll
    for (int q = 0; q < 4; ++q) {
        const int p = 2 * r + (q >> 1); const float lre = lam_re[dg * 64 + p], lim = lam_im[dg * 64 + p];
        const float er = expf(lre * dt), lbr = er * cosf(lim * dt), lbi = er * sinf(lim * dt);
        const float nr = lbr - 1.f, ni = lbi, den = lre * lre + lim * lim, cr = (nr * lre + ni * lim) / den, ci = (ni * lre - nr * lim) / den;
        unsigned w[4];
#pragma unroll
        for (int jj = 0; jj < 8; jj += 2) {
            float v[2];
#pragma unroll
            for (int e = 0; e < 2; ++e) { const int c = 8 * h + jj + e; const float br = b_re[(dg * 64 + p) * 16 + c], bi = b_im[(dg * 64 + p) * 16 + c]; v[e] = (q & 1) ? (cr * bi + ci * br) : (cr * br - ci * bi); }
            w[jj >> 1] = pk2(v[0], v[1]);
        }
        *(v4u*)(ws + WS_S5B + ((size_t)(dg * 4 + q) * 64 + lane) * 16) = (v4u){w[0], w[1], w[2], w[3]};
    }
    const int ch = lane & 15, fq = lane >> 4;
#pragma unroll
    for (int ks = 0; ks < 4; ++ks) {
        unsigned w[4];
#pragma unroll
        for (int jj = 0; jj < 8; jj += 2) { const int st = (32 * ks + 8 * fq + jj) >> 1;
            w[jj >> 1] = pk2(c_re[(dg * 16 + ch) * 64 + st], -c_im[(dg * 16 + ch) * 64 + st]); }
        *(v4u*)(ws + WS_S5C + ((size_t)(dg * 4 + ks) * 64 + lane) * 16) = (v4u){w[0], w[1], w[2], w[3]};
    }
}
__device__ __forceinline__ int s5_row(int b, int dir, int pos) {
    if (pos < NCTX) return MLAT + b * NCTX + (dir ? NCTX - 1 - pos : pos);
    const int t = pos - NCTX; return b * SEQ + (dir ? SEQ - 1 - t : t);
}
#define S5_SCAN16(D0, D1, D2, D3) do { _Pragma("unroll") for (int r_ = 0; r_ < 16; ++r_) { \
        const float n0r = fmaf(lm[0], x[0], fmaf(-lm[1], x[1], D0[r_])), n0i = fmaf(lm[0], x[1], fmaf(lm[1], x[0], D1[r_])); \
        const float n1r = fmaf(lm[2], x[2], fmaf(-lm[3], x[3], D2[r_])), n1i = fmaf(lm[2], x[3], fmaf(lm[3], x[2], D3[r_])); \
        x[0] = n0r; x[1] = n0i; x[2] = n1r; x[3] = n1i; D0[r_] = n0r; D1[r_] = n0i; D2[r_] = n1r; D3[r_] = n1i; } } while (0)

#define S5_SCAN16_ONE(Dr, Di, LR, LI, XR, XI) do { _Pragma("unroll") for (int r_ = 0; r_ < 16; ++r_) { \
        const float nr_ = fmaf(LR, XR, fmaf(-(LI), XI, Dr[r_])), ni_ = fmaf(LR, XI, fmaf(LI, XR, Di[r_])); XR = nr_; XI = ni_; Dr[r_] = nr_; Di[r_] = ni_; } } while (0)
__device__ __forceinline__ void s5_pass1(unsigned char* ws, int task, int lane) {
    const int chain = task / S5_NPAIR, w = task % S5_NPAIR, g = chain & 31, dir = (chain >> 5) & 1, b = chain >> 6, dg = dir * 32 + g;
    const bf16* U = (const bf16*)(ws + WS_U);
    bf16x8 Bf[4];
#pragma unroll
    for (int q = 0; q < 4; ++q) Bf[q] = *(const bf16x8*)(ws + WS_S5B + ((size_t)(dg * 4 + q) * 64 + lane) * 16);
    const f32x4 lm = *(const f32x4*)((const float*)(ws + WS_LAM) + (dg * 64 + 2 * (lane & 31)) * 2);
    const int i = lane & 31, hhA = (i >> 2) & 1, ti = (i & 3) + 4 * (i >> 3), h = lane >> 5;
    float x[4] = {0.f, 0.f, 0.f, 0.f};
    const f32x16 z = {0.f, 0.f, 0.f, 0.f, 0.f, 0.f, 0.f, 0.f, 0.f, 0.f, 0.f, 0.f, 0.f, 0.f, 0.f, 0.f};
    bf16x8 an = *(const bf16x8*)(U + (size_t)s5_row(b, dir, (2 * w + hhA) * S5_CH + ti) * 512 + g * 16 + 8 * h);
#pragma unroll 1
    for (int step = 0; step < S5_NST; ++step) {
        const bf16x8 a = an;
        if (step + 1 < S5_NST) an = *(const bf16x8*)(U + (size_t)s5_row(b, dir, (2 * w + hhA) * S5_CH + (step + 1) * 16 + ti) * 512 + g * 16 + 8 * h);
        f32x16 D0 = __builtin_amdgcn_mfma_f32_32x32x16_bf16(a, Bf[0], z, 0, 0, 0), D1 = __builtin_amdgcn_mfma_f32_32x32x16_bf16(a, Bf[1], z, 0, 0, 0);
        f32x16 D2 = __builtin_amdgcn_mfma_f32_32x32x16_bf16(a, Bf[2], z, 0, 0, 0), D3 = __builtin_amdgcn_mfma_f32_32x32x16_bf16(a, Bf[3], z, 0, 0, 0);
        S5_SCAN16(D0, D1, D2, D3);
    }
    float* S = (float*)(ws + WS_SEND) + ((size_t)chain * S5_NCH + 2 * w + h) * 128 + 4 * (lane & 31);
    *(f32x4*)S = (f32x4){x[0], x[1], x[2], x[3]};
}
static_assert(S5_NCH % 6 == 0, "pass 2 batches");
__device__ __forceinline__ void s5_pass2(unsigned char* ws, int gid) {
    const int chain = gid >> 6, p = gid & 63, dg = chain & 63;
    const float lr = ((const float*)(ws + WS_LAMP))[(dg * 64 + p) * 2], li = ((const float*)(ws + WS_LAMP))[(dg * 64 + p) * 2 + 1];
    const float* S = (const float*)(ws + WS_SEND) + (size_t)chain * S5_NCH * 128 + 2 * p; float* H = (float*)(ws + WS_HIN) + (size_t)chain * S5_NCH * 128 + 2 * p;
    float xr = 0.f, xi = 0.f;
#pragma unroll 1
    for (int q0 = 0; q0 < S5_NCH; q0 += 6) {
        float sr[6], si[6];
#pragma unroll
        for (int e = 0; e < 6; ++e) { sr[e] = S[(q0 + e) * 128]; si[e] = S[(q0 + e) * 128 + 1]; }
#pragma unroll
        for (int e = 0; e < 6; ++e) { H[(q0 + e) * 128] = xr; H[(q0 + e) * 128 + 1] = xi;
            const float nr = fmaf(lr, xr, fmaf(-li, xi, sr[e])), ni = fmaf(lr, xi, fmaf(li, xr, si[e])); xr = nr; xi = ni; }
    }
}
__device__ __forceinline__ void s5_pass2_wg(unsigned char* ws, LAS unsigned char* lds, int chain, int lane, int wave) {
    static_assert(S5_NCH == 4 * 17 + 4 * 16, "segments");
    const int p = lane, dg = chain & 63, q0 = wave < 4 ? 17 * wave : 68 + 16 * (wave - 4), len = wave < 4 ? 17 : 16;
    const float lr = ((const float*)(ws + WS_LAMP))[(dg * 64 + p) * 2], li = ((const float*)(ws + WS_LAMP))[(dg * 64 + p) * 2 + 1];
    const float* S = (const float*)(ws + WS_SEND) + ((size_t)chain * S5_NCH + q0) * 128 + 2 * p; float* H = (float*)(ws + WS_HIN) + ((size_t)chain * S5_NCH + q0) * 128 + 2 * p;
    float sr[17], si[17], er[17], ei[17];
#pragma unroll
    for (int e = 0; e < 17; ++e) { const bool on = e < len; sr[e] = on ? S[e * 128] : 0.f; si[e] = on ? S[e * 128 + 1] : 0.f; }
    float xr = 0.f, xi = 0.f, pr = 1.f, pi = 0.f;
#pragma unroll
    for (int e = 0; e < 17; ++e) { er[e] = xr; ei[e] = xi;
        if (e < len) { const float nr = fmaf(lr, xr, fmaf(-li, xi, sr[e])), ni = fmaf(lr, xi, fmaf(li, xr, si[e])); xr = nr; xi = ni;
            const float qr = pr * lr - pi * li, qi = pr * li + pi * lr; pr = qr; pi = qi; } }
    LAS f32x4* ex = (LAS f32x4*)lds;
    ex[wave * 64 + p] = (f32x4){xr, xi, pr, pi};
    __syncthreads();
    float cr = 0.f, ci = 0.f;
#pragma unroll
    for (int v = 0; v < 7; ++v) if (v < wave) { const f32x4 t = ex[v * 64 + p]; const float nr = t[2] * cr - t[3] * ci + t[0], ni = t[2] * ci + t[3] * cr + t[1]; cr = nr; ci = ni; }
    float qr = 1.f, qi = 0.f;
#pragma unroll
    for (int e = 0; e < 17; ++e) if (e < len) { H[e * 128] = er[e] + qr * cr - qi * ci; H[e * 128 + 1] = ei[e] + qr * ci + qi * cr;
        const float nr = qr * lr - qi * li, ni = qr * li + qi * lr; qr = nr; qi = ni; }
    __syncthreads();
}
__device__ __forceinline__ void s5_pass3(const Args& args, unsigned char* ws, LAS unsigned char* xt  , int task, int lane, int mode = 7  ) {
    const int w = task & 63, g = (task >> 6) & 31, b = task >> 11;
    const bf16* U = (const bf16*)(ws + WS_U); bf16* Ao = (bf16*)(ws + WS_A);
    const int i = lane & 31, hhA = (i >> 2) & 1, ti = (i & 3) + 4 * (i >> 3), h = lane >> 5, j = lane & 31, fq = lane >> 4, ch = lane & 15;
    f32x4 yacc[S5_NST][2];
    const f32x16 z = {0.f, 0.f, 0.f, 0.f, 0.f, 0.f, 0.f, 0.f, 0.f, 0.f, 0.f, 0.f, 0.f, 0.f, 0.f, 0.f};
#pragma unroll
    for (int dir = 0; dir < 2; ++dir) {
        const int dg = dir * 32 + g, chain = (b * 2 + dir) * 32 + g;
        bf16x8 Bf[4], Cf[4];
#pragma unroll
        for (int q = 0; q < 4; ++q) { Bf[q] = *(const bf16x8*)(ws + WS_S5B + ((size_t)(dg * 4 + q) * 64 + lane) * 16); Cf[q] = *(const bf16x8*)(ws + WS_S5C + ((size_t)(dg * 4 + q) * 64 + lane) * 16); }
        const f32x4 lm = *(const f32x4*)((const float*)(ws + WS_LAM) + (dg * 64 + 2 * j) * 2);
        const int cl = 2 * w + h, qc = dir ? (S5_NCC + S5_NLAT - 1 - cl) : (cl + S5_NCC);
        const f32x4 x0 = *(const f32x4*)((const float*)(ws + WS_HIN) + ((size_t)chain * S5_NCH + qc) * 128 + 4 * j);
        float x[4] = {x0[0], x0[1], x0[2], x0[3]};
        bf16x8 an = *(const bf16x8*)(U + ((size_t)b * SEQ + (2 * w + hhA) * S5_CH + (dir ? S5_CH - 1 - ti : ti)) * 512 + g * 16 + 8 * h);
#pragma unroll
        for (int step = 0; step < S5_NST; ++step) {
            const bf16x8 a = an;
            if (step + 1 < S5_NST) { const int n = (step + 1) * 16 + ti, t = (2 * w + hhA) * S5_CH + (dir ? S5_CH - 1 - n : n); an = *(const bf16x8*)(U + ((size_t)b * SEQ + t) * 512 + g * 16 + 8 * h); }
            if (mode & 1) {   f32x16 D0 = __builtin_amdgcn_mfma_f32_32x32x16_bf16(a, Bf[0], z, 0, 0, 0), D1 = __builtin_amdgcn_mfma_f32_32x32x16_bf16(a, Bf[1], z, 0, 0, 0);
                S5_SCAN16_ONE(D0, D1, lm[0], lm[1], x[0], x[1]);
#pragma unroll
                for (int r = 0; r < 16; ++r) *(LAS unsigned*)(xt + (h * 16 + r) * 272 + 8 * j) = pg8::cvt_pk_bf16(D0[r], D1[r]); }
            if (mode & 1) {   f32x16 D2 = __builtin_amdgcn_mfma_f32_32x32x16_bf16(a, Bf[2], z, 0, 0, 0), D3 = __builtin_amdgcn_mfma_f32_32x32x16_bf16(a, Bf[3], z, 0, 0, 0);
                S5_SCAN16_ONE(D2, D3, lm[2], lm[3], x[2], x[3]);
#pragma unroll
                for (int r = 0; r < 16; ++r) *(LAS unsigned*)(xt + (h * 16 + r) * 272 + 8 * j + 4) = pg8::cvt_pk_bf16(D2[r], D3[r]); }
            asm volatile("s_waitcnt lgkmcnt(0)" ::: "memory");
            const int rs = dir ? 15 - ch : ch;
#pragma unroll
            for (int hr = 0; hr < 2; ++hr) {
                f32x4 acc = {0.f, 0.f, 0.f, 0.f};
#pragma unroll
                for (int ks = 0; ks < ((mode & 2) ? 4 : 0); ++ks) { const bf16x8 af = *(const LAS bf16x8*)(xt + (hr * 16 + rs) * 272 + ks * 64 + 16 * fq);
                    acc = __builtin_amdgcn_mfma_f32_16x16x32_bf16(af, Cf[ks], acc, 0, 0, 0); }
                if (dir == 0) yacc[step][hr] = acc; else yacc[S5_NST - 1 - step][hr] += acc;
            }
            asm volatile("s_waitcnt lgkmcnt(0)" ::: "memory");
            __builtin_amdgcn_sched_barrier(0);
        }
    }
    if (mode & 4) {
        asm volatile("s_waitcnt lgkmcnt(0)" ::: "memory");
#pragma unroll
        for (int s = 0; s < S5_NST; ++s)
#pragma unroll
            for (int hr = 0; hr < 2; ++hr)
#pragma unroll
                for (int e = 0; e < 4; ++e) *(LAS float*)(xt + ((hr * S5_CH + 16 * s + 4 * fq + e) * 16 + ch) * 4) = yacc[s][hr][e];
        asm volatile("s_waitcnt lgkmcnt(0)" ::: "memory");
        f32x4 dk[4];
#pragma unroll
        for (int q = 0; q < 4; ++q) dk[q] = *(const f32x4*)(args.in[I_SD] + g * 16 + 4 * q);
#pragma unroll
        for (int hr = 0; hr < 2; ++hr) {
            const size_t o = ((size_t)b * SEQ + (2 * w + hr) * S5_CH + lane) * 512 + g * 16;
            const v4u u0 = *(const v4u*)(U + o), u1 = *(const v4u*)(U + o + 8);
            const unsigned uw[8] = {u0.x, u0.y, u0.z, u0.w, u1.x, u1.y, u1.z, u1.w};
            unsigned ow[8];
#pragma unroll
            for (int q = 0; q < 4; ++q) {
                const f32x4 y4 = *(const LAS f32x4*)(xt + ((hr * S5_CH + lane) * 16 + 4 * q) * 4);
                float r[4];
#pragma unroll
                for (int e = 0; e < 4; ++e) { const unsigned wv = uw[2 * q + (e >> 1)]; const float uu = (e & 1) ? __uint_as_float(wv & 0xffff0000u) : __uint_as_float(wv << 16);
                    const float y = y4[e] + uu * dk[q][e];
                    r[e] = y * __builtin_amdgcn_rcpf(1.f + __expf(-1.5957691216057308f * (y + 0.044715f * y * y * y))); }
                ow[2 * q] = pk2(r[0], r[1]); ow[2 * q + 1] = pk2(r[2], r[3]);
            }
            *(v4u*)(Ao + o) = (v4u){ow[0], ow[1], ow[2], ow[3]}; *(v4u*)(Ao + o + 8) = (v4u){ow[4], ow[5], ow[6], ow[7]};
        }
        asm volatile("s_waitcnt lgkmcnt(0)" ::: "memory");
    }
}
__device__ __forceinline__ int block_incl_scan(int v, int* scr, int lane, int wave, int& total) {
    int x = v;
#pragma unroll
    for (int o = 1; o < 64; o <<= 1) { const int y = __shfl_up(x, o); if (lane >= o) x += y; }
    if (lane == 63) scr[wave] = x;
    __syncthreads();
    int base = 0, tot = 0;
#pragma unroll
    for (int w = 0; w < 8; ++w) { const int s = scr[w]; if (w < wave) base += s; tot += s; }
    __syncthreads();
    total = tot; return x + base;
}
__device__ __forceinline__ void topk_select(unsigned char* ws, unsigned char* lds_g, int be, int tid, int lane, int wave) {
    unsigned* vals = (unsigned*)lds_g; int* hist = (int*)(lds_g + 32768); int* scr = (int*)(lds_g + 49152);
    const int b = be >> 4, e = be & 15;
    const float* AFF = (const float*)(ws + WS_AFF); int* IDX = (int*)(ws + WS_IDX); float* GSEL = (float*)(ws + WS_GSEL); int* SLOT = (int*)(ws + WS_SLOT);
    unsigned mine[16];
    (void)b; (void)e;
#pragma unroll
    for (int q = 0; q < 4; ++q) { const v4u v = *(const v4u*)(AFF + (size_t)be * SEQ + 4 * tid + 2048 * q); mine[4 * q] = v.x; mine[4 * q + 1] = v.y; mine[4 * q + 2] = v.z; mine[4 * q + 3] = v.w; }
    for (int i = tid; i < 4096; i += 512) hist[i] = 0;
#pragma unroll
    for (int q = 0; q < 4; ++q) { v4u v; v.x = mine[4 * q]; v.y = mine[4 * q + 1]; v.z = mine[4 * q + 2]; v.w = mine[4 * q + 3]; *(v4u*)(vals + 4 * tid + 2048 * q) = v; }
    __syncthreads();
    unsigned prefix = 0u; int krem = 1024;
#pragma unroll
    for (int pass = 0; pass < 3; ++pass) {
        const int wdt = pass == 2 ? 8 : 12, shift = pass == 0 ? 20 : (pass == 1 ? 8 : 0), nb = 1 << wdt;
#pragma unroll
        for (int k = 0; k < 16; ++k) { const unsigned key = mine[k]; if (pass == 0 || (key >> (shift + wdt)) == prefix) atomicAdd(&hist[(key >> shift) & (nb - 1)], 1); }
        __syncthreads();
        int cnt = 0, hv[8];
        if (nb == 4096) {
#pragma unroll
            for (int d = 0; d < 8; ++d) { hv[d] = hist[tid * 8 + d]; cnt += hv[d]; }
        } else { hv[0] = tid < 256 ? hist[tid] : 0; cnt = hv[0]; }
        int total; const int incl = block_incl_scan(cnt, scr, lane, wave, total);
        int running = total - incl;
        if (nb == 4096) {
#pragma unroll
            for (int d = 7; d >= 0; --d) { const int hh = hv[d]; if (running < krem && running + hh >= krem) { scr[16] = tid * 8 + d; scr[17] = krem - running; } running += hh; hist[tid * 8 + d] = 0; }
        } else if (tid < 256) { if (running < krem && running + hv[0] >= krem) { scr[16] = tid; scr[17] = krem - running; } hist[tid] = 0; }
        __syncthreads();
        const int dstar = scr[16]; krem = scr[17]; prefix = (prefix << wdt) | (unsigned)dstar;
    }
    const unsigned T = prefix; int ngt = 0, neq = 0; unsigned own[16];
#pragma unroll
    for (int k = 0; k < 16; ++k) { own[k] = vals[tid * 16 + k]; ngt += own[k] > T ? 1 : 0; neq += own[k] == T ? 1 : 0; }
    int tot1; const int eq_before = block_incl_scan(neq, scr, lane, wave, tot1) - neq;
    int nsel = ngt, eqr = eq_before;
#pragma unroll
    for (int k = 0; k < 16; ++k) if (own[k] == T) { nsel += eqr < krem ? 1 : 0; ++eqr; }
    int tot2; int slot = block_incl_scan(nsel, scr, lane, wave, tot2) - nsel;
    eqr = eq_before;
    int sl[16];
#pragma unroll
    for (int k = 0; k < 16; ++k) { const int i = tid * 16 + k; bool sel = own[k] > T;
        if (own[k] == T) { sel = eqr < krem; ++eqr; }
        sel = sel && slot < 1024;
        if (sel) { IDX[be * 1024 + slot] = i; GSEL[be * 1024 + slot] = __uint_as_float(own[k]); }
        sl[k] = sel ? slot : -1; slot += sel ? 1 : 0; }
#pragma unroll
    for (int q = 0; q < 4; ++q) { v4u v; v.x = (unsigned)sl[4 * q]; v.y = (unsigned)sl[4 * q + 1]; v.z = (unsigned)sl[4 * q + 2]; v.w = (unsigned)sl[4 * q + 3]; *(v4u*)(SLOT + be * 8192 + tid * 16 + 4 * q) = v; }
    __syncthreads();
}
typedef short s16x4 __attribute__((ext_vector_type(4)));
constexpr int AT_ROW = 144;
constexpr int AT_KC = 0, AT_VC = 256 * AT_ROW, AT_RING = 2 * 256 * AT_ROW, AT_RBUF = 2 * 64 * AT_ROW, AT_BIAS = 132096;
static_assert(AT_RING + 3 * AT_RBUF <= RING_BYTES && AT_BIAS >= MISC_OFF + 128 && AT_BIAS + (512 + 640) * 4 <= LDS_BYTES, "attention LDS map");
constexpr float LOG2E = 1.4426950408889634f;

template <int MODE> __device__ __forceinline__ void attn_tile32(const LAS unsigned char* K32, const LAS unsigned char* V32, const bf16x8 q0, const bf16x8 q1, f32x4 (&O)[4], float& lsum,
                                                              int lane, const LAS float* brow, int kc0, int q_cs, float shiftl) {
    const int r16 = lane & 15, fq = lane >> 4;
    f32x4 st[2];
#pragma unroll
    for (int tt = 0; tt < 2; ++tt) {
        const LAS unsigned char* kp = K32 + (16 * tt + r16) * AT_ROW + 16 * fq;
        const bf16x8 k0 = *(const LAS bf16x8*)kp, k1 = *(const LAS bf16x8*)(kp + 64);
        f32x4 c0;
        if (MODE == 0) c0 = (f32x4){shiftl, shiftl, shiftl, shiftl};
        else { const LAS float* bp = brow + 16 * tt + 4 * fq; c0 = (f32x4){bp[0], bp[1], bp[2], bp[3]}; }
        st[tt] = __builtin_amdgcn_mfma_f32_16x16x32_bf16(k0, q0, c0, 0, 0, 0);
        st[tt] = __builtin_amdgcn_mfma_f32_16x16x32_bf16(k1, q1, st[tt], 0, 0, 0);
    }
    float p[2][4];
    if (MODE == 0) {
#pragma unroll
        for (int tt = 0; tt < 2; ++tt)
#pragma unroll
            for (int e = 0; e < 4; ++e) { const float v = __builtin_amdgcn_exp2f(st[tt][e]); p[tt][e] = v; lsum += v; }
    } else {
        const int t = q_cs - kc0;
#pragma unroll
        for (int e = 0; e < 4; ++e) { const bool lo = 4 * fq + e >= t; const float v = __builtin_amdgcn_exp2f(lo ? st[0][e] : st[1][e]); p[0][e] = lo ? v : 0.f; p[1][e] = lo ? 0.f : v; lsum += v; }
    }
    bf16x8 Pf; { pg8::u32x4 w; w.x = pg8::cvt_pk_bf16(p[0][0], p[0][1]); w.y = pg8::cvt_pk_bf16(p[0][2], p[0][3]); w.z = pg8::cvt_pk_bf16(p[1][0], p[1][1]); w.w = pg8::cvt_pk_bf16(p[1][2], p[1][3]); Pf = __builtin_bit_cast(bf16x8, w); }
    const LAS unsigned char* vp = V32 + (4 * fq + (r16 >> 2)) * AT_ROW + 8 * (r16 & 3);
#pragma unroll
    for (int dt = 0; dt < 4; ++dt) {
        const s16x4 lo = __builtin_amdgcn_ds_read_tr16_b64_v4i16((LAS s16x4*)(vp + 32 * dt)), hi = __builtin_amdgcn_ds_read_tr16_b64_v4i16((LAS s16x4*)(vp + 32 * dt + 16 * AT_ROW));
        const bf16x8 Vf = __builtin_shufflevector(lo, hi, 0, 1, 2, 3, 4, 5, 6, 7);
        O[dt] = __builtin_amdgcn_mfma_f32_16x16x32_bf16(Vf, Pf, O[dt], 0, 0, 0);
    }
}

__device__ __forceinline__ void attn_unit(const Args& args, unsigned char* ws, LAS unsigned char* lds, int unit, int tid, int lane, int wave, int mode  ) {
    const int b = unit >> 7, head = (unit >> 4) & 7, r0 = (unit & 15) * 8, r = r0 + wave;
    const bf16* Q = (const bf16*)(ws + WS_Q); const bf16* Kg = (const bf16*)(ws + WS_K); const bf16* Vg = (const bf16*)(ws + WS_V); bf16* YB = (bf16*)(ws + WS_YAB) + 512;
    const int r16 = lane & 15, fq = lane >> 4;
    float mq = fabsf(args.in[I_QN][lane]), mk = fabsf(args.in[I_KN][lane]);
#pragma unroll
    for (int o = 1; o < 64; o <<= 1) { mq = fmaxf(mq, __shfl_xor(mq, o)); mk = fmaxf(mk, __shfl_xor(mk, o)); }
    const float shiftl = -8.f * mq * mk * LOG2E;
    __syncthreads();
    {
        const bf16* kc = Kg + ((size_t)MLAT + b * NCTX) * 512 + head * 64; const bf16* vc = Vg + ((size_t)MLAT + b * NCTX) * 512 + head * 64;
#pragma unroll
        for (int i = 0; i < 4; ++i) { const int idx = tid + 512 * i, row = idx >> 3, c = idx & 7;
            const v4u kv = *(const v4u*)(kc + (size_t)row * 512 + c * 8), vv = *(const v4u*)(vc + (size_t)row * 512 + c * 8);
            *(LAS v4u*)(lds + AT_KC + row * AT_ROW + c * 16) = kv; *(LAS v4u*)(lds + AT_VC + row * AT_ROW + c * 16) = vv; }
        LAS float* bl = (LAS float*)(lds + AT_BIAS);
        {
            bl[tid] = tid < 465 ? fmaf(args.in[I_RPB][head * 465 + tid], LOG2E, shiftl) : 0.f;
            for (int i = tid; i < 640; i += 512) { const int dr = i / 40, dc = i % 40 - 8; bl[512 + i] = (dr < 15 && dc >= 7 && dc < 23) ? fmaf(args.in[I_RPB][head * 465 + dr * 31 + dc], LOG2E, shiftl) : -30000.f; }
        }
    }
    const int kr_lo = min(max(r0 - 4, 0), 120), kr_hi = min(max(r0 + 3, 0), 120) + 7;
    const int lcol = tid >> 3, lc = tid & 7;
    v4u kv, vv;
    {   const size_t g0 = ((size_t)b * SEQ + kr_lo * 64 + lcol) * 512 + head * 64 + lc * 8;
        const v4u k0 = *(const v4u*)(Kg + g0), v0 = *(const v4u*)(Vg + g0);
        *(LAS v4u*)(lds + AT_RING + lcol * AT_ROW + lc * 16) = k0; *(LAS v4u*)(lds + AT_RING + 64 * AT_ROW + lcol * AT_ROW + lc * 16) = v0;
        kv = *(const v4u*)(Kg + g0 + 64 * 512); vv = *(const v4u*)(Vg + g0 + 64 * 512); }
    bf16x8 Qf[4][2];
#pragma unroll
    for (int j = 0; j < 4; ++j) { const bf16* qp = Q + ((size_t)b * SEQ + r * 64 + 16 * j + r16) * 512 + head * 64 + 8 * fq; Qf[j][0] = *(const bf16x8*)qp; Qf[j][1] = *(const bf16x8*)(qp + 32); }
    f32x4 O[4][4]; float lsum[4];
#pragma unroll
    for (int j = 0; j < 4; ++j) { lsum[j] = 0.f;
#pragma unroll
        for (int dt = 0; dt < 4; ++dt) O[j][dt] = (f32x4){0.f, 0.f, 0.f, 0.f}; }
    __syncthreads();
#pragma unroll 1
    for (int grp = 0; grp < ((mode & 1) ? 8 : 0); ++grp) {
#pragma unroll
        for (int j = 0; j < 4; ++j) attn_tile32<0>(lds + AT_KC + 32 * grp * AT_ROW, lds + AT_VC + 32 * grp * AT_ROW, Qf[j][0], Qf[j][1], O[j], lsum[j], lane, nullptr, 0, 0, shiftl);
    }
    const int rs = min(max(r - 4, 0), 120);
    int buf = 0;
#pragma unroll 1
    for (int kr = kr_lo; kr <= ((mode & 2) ? kr_hi : kr_lo - 1); ++kr) {
        if (kr + 1 <= kr_hi) { const int nbuf = buf == 2 ? 0 : buf + 1; LAS unsigned char* nb = lds + AT_RING + nbuf * AT_RBUF;
            *(LAS v4u*)(nb + lcol * AT_ROW + lc * 16) = kv; *(LAS v4u*)(nb + 64 * AT_ROW + lcol * AT_ROW + lc * 16) = vv; }
        if (kr + 2 <= kr_hi) { const size_t g0 = ((size_t)b * SEQ + (kr + 2) * 64 + lcol) * 512 + head * 64 + lc * 8; kv = *(const v4u*)(Kg + g0); vv = *(const v4u*)(Vg + g0); }
        if (kr >= rs && kr < rs + 8 && (mode & 4)) {
            const LAS unsigned char* kb = lds + AT_RING + buf * AT_RBUF; const LAS unsigned char* vb = kb + 64 * AT_ROW;
            const LAS float* bl = (const LAS float*)(lds + AT_BIAS) + (kr - r + 7) * 31 + 15; const LAS float* bl1 = (const LAS float*)(lds + AT_BIAS) + 512 + (kr - r + 7) * 40 + 8 + 15;
#pragma unroll
            for (int j = 0; j < 4; ++j) { const int cs = j == 0 ? 0 : (j == 3 ? 32 : 16 * j - 8), qc = 16 * j + r16, q_cs = min(max(qc - 8, 0), 48);
                if (j == 0 || j == 3) attn_tile32<2>(kb + cs * AT_ROW, vb + cs * AT_ROW, Qf[j][0], Qf[j][1], O[j], lsum[j], lane, bl + cs - qc, cs, q_cs, shiftl);
                else attn_tile32<1>(kb + cs * AT_ROW, vb + cs * AT_ROW, Qf[j][0], Qf[j][1], O[j], lsum[j], lane, bl1 + cs - qc, cs, q_cs, shiftl); }
        }
        __syncthreads();
        buf = buf == 2 ? 0 : buf + 1;
    }
#pragma unroll
    for (int j = 0; j < 4; ++j) {
        float l = lsum[j]; l += __shfl_xor(l, 16); l += __shfl_xor(l, 32);
        const float inv = 1.f / l;
        bf16* op = YB + ((size_t)b * SEQ + r * 64 + 16 * j + r16) * 1024 + head * 64 + 4 * fq;
#pragma unroll
        for (int dt = 0; dt < 4; ++dt) { pg8::u32x2 w; w.x = pg8::cvt_pk_bf16(O[j][dt][0] * inv, O[j][dt][1] * inv); w.y = pg8::cvt_pk_bf16(O[j][dt][2] * inv, O[j][dt][3] * inv); *(pg8::u32x2*)(op + 16 * dt) = w; }
    }
}
__global__ void __launch_bounds__(NWAVES * 64, 2) mega(Args args) {
    extern __shared__ __attribute__((aligned(16))) unsigned char lds_raw[];
    LAS unsigned char* lds = (LAS unsigned char*)lds_raw;
    volatile LAS unsigned* MISC = (volatile LAS unsigned*)(lds + MISC_OFF);
    const int tid = threadIdx.x, lane = tid & 63, wave = __builtin_amdgcn_readfirstlane(tid >> 6);
    const int G = gridDim.x; const int bx = blockIdx.x; const int vcu = (G % 8 == 0) ? (bx % 8) * (G / 8) + bx / 8 : bx;
    const int gw = vcu * NWAVES + wave, NGW = G * NWAVES;
    unsigned char* ws = args.ws;
    gu32* ctl = (gu32*)(ws + WS_CTL);
    for (int u = tid; u < (LDS_BYTES - LDSCTL_OFF) / 4; u += NWAVES * 64) ((LAS unsigned*)(lds + LDSCTL_OFF))[u] = 0u;
    __syncthreads();
    XcdBarrier bar = xcd_barrier_post((unsigned*)(ctl + CW_BAR) + args.li * XCD_BAR_WORDS, MISC + 8);
    if (tid == 0 && G <= 256) __hip_atomic_store(ctl + CW_XTAB + bx, bar.x + 1u, RLX_AGENT);
    const bool grp_ok = (G == 256) && args.ph_lo == 0 && args.ph_hi == 15;
#define SEAM(k, epoch) do { if (BOTH(k)) { if (grp_ok) grp_barrier(ctl, bx, bar.x, 32u * (epoch), MISC + 10); else xcd_barrier(bar); } } while (0)
    const int lo = args.ph_lo, hi = args.ph_hi;
#define IN(k) (lo <= (k) && (k) < hi)
#define BOTH(k) (IN(k) && IN((k) + 1))
#if defined(TIME_MASK)
    unsigned long long tacc_ = 0ull, tbeg_ = 0ull;
#define TBEG(k) do { if ((TIME_MASK >> (k)) & 1) tbeg_ = __builtin_amdgcn_s_memrealtime(); } while (0)
#define TEND(k) do { if ((TIME_MASK >> (k)) & 1) tacc_ += __builtin_amdgcn_s_memrealtime() - tbeg_; } while (0)
#else
#define TBEG(k) do {} while (0)
#define TEND(k) do {} while (0)
#endif
    float* mod = (float*)(ws + WS_MOD);
    bf16* Hb = (bf16*)(ws + WS_H);

    TBEG(0);
    if (IN(0)) for (int rep_ = 0; rep_ <= ((PROBE_MASK >> 0) & 1) * PROBE_REPS; ++rep_) {
        const float* c = args.in[I_C]; const float* cctx = args.in[I_CCTX]; const float* w_ada = args.in[I_WADA]; const float* b_ada = args.in[I_BADA];
        for (int item = bx; item < 24 * NKP; item += G) {
            const int cc = item % 24, kq = item / 24, col = cc * 256 + lane * 4, kb = kq * (1024 / NKP) + wave * (128 / NKP);
            f32x4 a0 = {0.f, 0.f, 0.f, 0.f}, a1 = a0, a2 = a0;
#pragma unroll 1
            for (int k0 = kb; k0 < kb + 128 / NKP; k0 += 16) {
                f32x4 w[16];
#pragma unroll
                for (int i = 0; i < 16; ++i) w[i] = __builtin_nontemporal_load((const f32x4*)(w_ada + (size_t)(k0 + i) * 6144 + col));
#pragma unroll
                for (int i = 0; i < 16; ++i) { const float s0 = silu_f(c[k0 + i]), s1 = silu_f(c[1024 + k0 + i]), s2 = silu_f(cctx[k0 + i]); a0 += w[i] * s0; a1 += w[i] * s1; a2 += w[i] * s2; }
            }
            LAS f32x4* red = (LAS f32x4*)(lds + RING_OFF);
            __syncthreads();
            red[(wave * 3 + 0) * 64 + lane] = a0; red[(wave * 3 + 1) * 64 + lane] = a1; red[(wave * 3 + 2) * 64 + lane] = a2;
            __syncthreads();
            if (tid < 192) { const int v = tid >> 6, l = tid & 63; f32x4 s = red[v * 64 + l];
#pragma unroll
                for (int w = 1; w < 8; ++w) s += red[(w * 3 + v) * 64 + l];
                if (kq == 0) s += *(const f32x4*)(b_ada + cc * 256 + l * 4);
                *(f32x4*)(mod + kq * MODP + v * 6144 + cc * 256 + l * 4) = s; }
            VM_WAIT(); __syncthreads();
            if (tid == 0) { __builtin_amdgcn_fence(__ATOMIC_RELEASE, "agent"); asm volatile("s_waitcnt vmcnt(0)" ::: "memory");
                __hip_atomic_fetch_add(ctl + CW_ADA, 1u, RLX_AGENT); }
        }
        LAS float* scr = (LAS float*)(lds + RING_OFF + wave * 16384);
        constexpr int I_IN = 16 * 128, I_GLU = 8 * 16, I_PA = 8 * 32, I_OUT = 16 * 32, NIT = I_IN + I_GLU + 2 * I_PA + I_OUT;
        for (int it = gw; it < (G == 256 ? I_IN : NIT); it += NGW) {
            int r = it;
            if (r < I_IN) { transpose_item<1>(args.in[I_WIN], 1024, 4096, (bf16*)(ws + WS_WIN), 1024, scr, r, lane); continue; } r -= I_IN;
            if (r < I_GLU) { transpose_item<0>(args.in[I_WGLU], 512, 512, (bf16*)(ws + WS_WGLU), 512, scr, r, lane); continue; } r -= I_GLU;
            if (r < I_PA) { transpose_item<0>(args.in[I_WPA], 512, 1024, (bf16*)(ws + WS_WPA), 1024, scr, r, lane); continue; } r -= I_PA;
            if (r < I_PA) { transpose_item<0>(args.in[I_WPB], 512, 1024, (bf16*)(ws + WS_WPA) + 512, 1024, scr, r, lane); continue; } r -= I_PA;
            transpose_item<0>(args.in[I_WOUT], 1024, 1024, (bf16*)(ws + WS_WOUT), 1024, scr, r, lane);
        }
        for (int dg = (NGW >= 1200 ? gw - 1024 : gw); dg < 64; dg += NGW) if (dg >= 0) s5_prep(args, ws, dg, lane);
    }
    TEND(0);
    TBEG(1);
    if (IN(1)) for (int rep_ = 0; rep_ <= ((PROBE_MASK >> 1) & 1) * PROBE_REPS; ++rep_) {
        const float* x = args.in[I_X]; const float* ctx = args.in[I_CTX]; const float* gwt = args.in[I_NMIX];
        if (BOTH(0)) {
            if (tid == 0) { unsigned sp = 0u; while (__hip_atomic_load(ctl + CW_ADA, RLX_AGENT) < (unsigned)(24 * NKP)) { __builtin_amdgcn_s_sleep(2); if (++sp > (1u << 20)) { __hip_atomic_store(ctl + CW_TMO, 1u, RLX_AGENT); break; } }
                __builtin_amdgcn_fence(__ATOMIC_ACQUIRE, "agent"); asm volatile("s_waitcnt vmcnt(0)" ::: "memory"); }
            __syncthreads();
        }
        { const int gi = bx * (NWAVES * 64) + tid; if (gi < MODP / 4) *(f32x4*)((float*)(ws + WS_MODF) + 4 * gi) = mod4(mod + 4 * gi); }
        LAS f32x4* smod = (LAS f32x4*)(lds + RING_OFF);
        for (int q = tid; q < 3 * 2 * 256; q += NWAVES * 64) smod[q] = mod4(mod + (q >> 9) * 6144 + (q & 511) * 4);
        __syncthreads();
        for (int blk = gw; blk < MLAT / 8 + MCTX / 2; blk += NGW) {
            if (blk < MLAT / 8) norm1_rows(x + (size_t)blk * 8 * D, Hb + (size_t)blk * 8 * D, 8, gwt, smod + ((blk * 8) >> 13) * 512, lane);
            else { const int r = (blk - MLAT / 8) * 2; norm1_rows(ctx + (size_t)r * D, Hb + (size_t)(MLAT + r) * D, 2, gwt, smod + 2 * 512, lane); }
        }
        if (BOTH(1)) xcd_barrier(bar);
    }
    TEND(1);
    TBEG(2);
    if (IN(2)) for (int rep_ = 0; rep_ <= ((PROBE_MASK >> 2) & 1) * PROBE_REPS; ++rep_) {
        pg8::Gemm g{Hb, (const bf16*)(ws + WS_WIN), MALL, 4096, 1024};
        const int ng2 = (G == 256) ? 208 : G;
        if (bx < ng2) {
            pg8::InprojOrder S; S.init(ng2, bx, true);
            pg8::EpiInproj E{(bf16*)(ws + WS_U), (bf16*)(ws + WS_Q), (bf16*)(ws + WS_K), (bf16*)(ws + WS_V), (bf16*)(ws + WS_SGA), (bf16*)(ws + WS_SGB), args.in[I_QN], args.in[I_KN]};
            pg8::gemm_phase<pg8::EpiInproj, pg8::InprojOrder, true>(lds + RING_OFF, g, S, E);
        } else {
            LAS float* scr = (LAS float*)(lds + RING_OFF + wave * 16384);
            constexpr int I_GLU = 8 * 16, I_PA = 8 * 32, I_OUT = 16 * 32, NS = I_GLU + 2 * I_PA + I_OUT, NIT = NS + 8192 + WGU_NP2 * 1024;
            auto mk = [&](int it) {
                if (it < I_GLU) return TItem{args.in[I_WGLU], (bf16*)(ws + WS_WGLU), 512, 512, it};
                if (it < I_GLU + I_PA) return TItem{args.in[I_WPA], (bf16*)(ws + WS_WPA), 1024, 1024, it - I_GLU};
                if (it < I_GLU + 2 * I_PA) return TItem{args.in[I_WPB], (bf16*)(ws + WS_WPA) + 512, 1024, 1024, it - I_GLU - I_PA};
                if (it < NS) return TItem{args.in[I_WOUT], (bf16*)(ws + WS_WOUT), 1024, 1024, it - I_GLU - 2 * I_PA};
                const int i = it - NS, j = i - 8192, e = j >> 10, which = (j >> 9) & 1;
                return i < 8192 ? TItem{args.in[I_WED] + (size_t)(i >> 9) * 1048576, (bf16*)(ws + WS_WD) + (size_t)(i >> 9) * 1048576, 1024, 1024, i & 511}
                                : TItem{(which ? args.in[I_WEU] : args.in[I_WEG]) + (size_t)e * 1048576, (bf16*)(ws + WS_WGU) + (size_t)e * 2097152, 1024, 1024, j & 511}; };
            auto fin = [&](int it, const f32x4 (&ld)[8]) { if (it < NS + 8192) titem_finish<0>(mk(it), ld, scr, lane); else if (((it - NS - 8192) >> 9) & 1) titem_finish<3>(mk(it), ld, scr, lane); else titem_finish<2>(mk(it), ld, scr, lane); };
            const int NW2 = (G - ng2) * NWAVES; int it = (bx - ng2) * NWAVES + wave; f32x4 lda[8], ldb[8];
            if (it < NIT) titem_load(mk(it), lda, lane);
            while (it < NIT) {
                const int itn = it + NW2, it2 = itn + NW2;
                if (itn < NIT) titem_load(mk(itn), ldb, lane);
                fin(it, lda);
                if (itn >= NIT) break;
                if (it2 < NIT) titem_load(mk(it2), lda, lane);
                fin(itn, ldb);
                it = it2;
            }
        }
        if (ng2 == G) {
            const int maxun = (1036 + G - 1) / G, heavy = 1036 - (maxun - 1) * G, light = heavy < G ? G - heavy : G;
            if (light == G || bx >= heavy) {
                LAS float* scr = (LAS float*)(lds + RING_OFF + wave * 16384);
                for (int it = (light == G ? bx : bx - heavy) * NWAVES + wave; it < 16 * 512; it += light * NWAVES)
                    transpose_item<0>(args.in[I_WED] + (size_t)(it >> 9) * 1048576, 1024, 1024, (bf16*)(ws + WS_WD) + (size_t)(it >> 9) * 1048576, 1024, scr, it & 511, lane);
            }
        }
        if (BOTH(2)) xcd_barrier(bar);
    }
    TEND(2);
#if defined(EXTRA_BARRIERS)
    if (IN(3)) for (int xb_ = 0; xb_ < EXTRA_BARRIERS; ++xb_) xcd_barrier(bar);
#endif
    TBEG(3);
    if (IN(3)) for (int rep_ = 0; rep_ <= ((PROBE_MASK >> 3) & 1) * PROBE_REPS; ++rep_) {
        for (int unit = vcu; unit < 256; unit += G) attn_unit(args, ws, lds + RING_OFF, unit, tid, lane, wave, 7);
        for (int task = gw; task < 128 * S5_NPAIR; task += NGW) s5_pass1(ws, task, lane);
        if (BOTH(3)) xcd_barrier(bar);
    }
    TEND(3);
    TBEG(4);
    if (IN(4)) for (int rep_ = 0; rep_ <= ((PROBE_MASK >> 4) & 1) * PROBE_REPS; ++rep_) {
        for (int chain = bx; chain < 128; chain += G) s5_pass2_wg(ws, lds + RING_OFF, chain, lane, wave);
        if (BOTH(4)) xcd_barrier(bar);
    }
    TEND(4);
    TBEG(5);
    if (IN(5)) for (int rep_ = 0; rep_ <= ((PROBE_MASK >> 5) & 1) * PROBE_REPS; ++rep_) {
        for (int task = gw; task < 4096; task += NGW) s5_pass3(args, ws, lds + RING_OFF + wave * 16384, task, lane, rep_ < ((PROBE_MASK >> 5) & 1) * PROBE_REPS ? PROBE_VARIANT : 7);
        if (BOTH(5)) xcd_barrier(bar);
    }
    TEND(5);
    TBEG(6);
    if (IN(6)) for (int rep_ = 0; rep_ <= ((PROBE_MASK >> 6) & 1) * PROBE_REPS; ++rep_) {
        pg8::Gemm g{(const bf16*)(ws + WS_A), (const bf16*)(ws + WS_WGLU), MLAT, 512, 512};
        pg8::StaticOrder S; S.init(MLAT, 512, G, bx);
        pg8::EpiGlu E{(const bf16*)(ws + WS_A), args.in[I_BGLU], (bf16*)(ws + WS_YAB), 1024};
        pg8::gemm_phase<pg8::EpiGlu, pg8::StaticOrder, true>(lds + RING_OFF, g, S, E);
        if (G > 128 && bx >= 128) {
            LAS float* scr = (LAS float*)(lds + RING_OFF + wave * 16384);
            for (int it = (G == 256 ? WGU_NP2 * 1024 : 0) + (bx - 128) * NWAVES + wave; it < WGU_NLO * 1024; it += (G - 128) * NWAVES) { const int e = it >> 10, which = (it >> 9) & 1;
                if (which == 0) transpose_item<2>(args.in[I_WEG] + (size_t)e * 1048576, 1024, 1024, (bf16*)(ws + WS_WGU) + (size_t)e * 2097152, 1024, scr, it & 511, lane);
                else transpose_item<3>(args.in[I_WEU] + (size_t)e * 1048576, 1024, 1024, (bf16*)(ws + WS_WGU) + (size_t)e * 2097152, 1024, scr, it & 511, lane); }
        }
        SEAM(6, 1u);
    }
    TEND(6);
    TBEG(7);
    if (IN(7)) for (int rep_ = 0; rep_ <= ((PROBE_MASK >> 7) & 1) * PROBE_REPS; ++rep_) {
        pg8::Gemm g{(const bf16*)(ws + WS_YAB), (const bf16*)(ws + WS_WPA), MLAT, 1024, 1024};
        pg8::StaticOrder S; S.init(MLAT, 1024, G, bx);
        pg8::EpiMerge E{(const bf16*)(ws + WS_SGA), (const bf16*)(ws + WS_SGB), (bf16*)(ws + WS_M)};
        pg8::gemm_phase<pg8::EpiMerge, pg8::StaticOrder, true>(lds + RING_OFF, g, S, E);
        SEAM(7, 2u);
    }
    TEND(7);
    TBEG(8);
    if (IN(8)) for (int rep_ = 0; rep_ <= ((PROBE_MASK >> 8) & 1) * PROBE_REPS; ++rep_) {
        pg8::Gemm g{(const bf16*)(ws + WS_M), (const bf16*)(ws + WS_WOUT), MLAT, 1024, 1024};
        pg8::StaticOrder S; S.init(MLAT, 1024, G, bx);
        pg8::EpiOut E{(const float*)(ws + WS_MODF), (bf16*)args.out + DR_OFF};
        pg8::gemm_phase<pg8::EpiOut, pg8::StaticOrder, true>(lds + RING_OFF, g, S, E);
        SEAM(8, 3u);
    }
    TEND(8);
    TBEG(9);
    if (IN(9)) for (int rep_ = 0; rep_ <= ((PROBE_MASK >> 9) & 1) * PROBE_REPS; ++rep_) {
        const float* gwt = args.in[I_NFFN]; const float* w_router = args.in[I_WR]; float* AFF = (float*)(ws + WS_AFF);
        __syncthreads();
#pragma unroll
        for (int k = 0; k < 8; ++k) { const int idx4 = tid + 512 * k, c = idx4 >> 2, e4 = idx4 & 3;
            *(LAS f32x4*)(lds + RING_OFF + (((c >> 8) * 4 + (c & 3)) * 64 + ((c & 255) >> 2)) * 80 + e4 * 16) = *(const f32x4*)(w_router + (size_t)c * 16 + e4 * 4); }
        __syncthreads();
        for (int blk = gw; blk < MLAT / 8; blk += NGW) {
            const int row0 = blk * 8; const float* md = (const float*)(ws + WS_MODF) + (row0 >> 13) * 6144;
            f32x4 ca[4], cb[4];
#pragma unroll
            for (int j = 0; j < 4; ++j) { const int col = j * 256 + lane * 4; ca[j] = *(const f32x4*)(gwt + col) * (*(const f32x4*)(md + 4096 + col) + 1.f); cb[j] = *(const f32x4*)(md + 3072 + col); }
#pragma unroll 1
            for (int rr = 0; rr < 8; rr += 2) {
                const int rowa = row0 + rr, rowb = rowa + 1;
                const float* sa = args.in[I_X] + (size_t)rowa * D; const float* sb = sa + D; const bf16* da = (const bf16*)args.out + DR_OFF + (size_t)rowa * DR_LD; const bf16* db = da + DR_LD;
                f32x4 va[4], vb[4]; float ssa = 0.f, ssb = 0.f;
#pragma unroll
                for (int j = 0; j < 4; ++j) { const pg8::u32x2 wa = *(const pg8::u32x2*)(da + j * 256 + lane * 4), wb = *(const pg8::u32x2*)(db + j * 256 + lane * 4);
                    va[j] = *(const f32x4*)(sa + j * 256 + lane * 4) + (f32x4){__uint_as_float(wa.x << 16), __uint_as_float(wa.x & 0xffff0000u), __uint_as_float(wa.y << 16), __uint_as_float(wa.y & 0xffff0000u)};
                    vb[j] = *(const f32x4*)(sb + j * 256 + lane * 4) + (f32x4){__uint_as_float(wb.x << 16), __uint_as_float(wb.x & 0xffff0000u), __uint_as_float(wb.y << 16), __uint_as_float(wb.y & 0xffff0000u)}; }
#pragma unroll
                for (int j = 0; j < 4; ++j) { ssa += (va[j][0] * va[j][0] + va[j][1] * va[j][1]) + (va[j][2] * va[j][2] + va[j][3] * va[j][3]); ssb += (vb[j][0] * vb[j][0] + vb[j][1] * vb[j][1]) + (vb[j][2] * vb[j][2] + vb[j][3] * vb[j][3]); }
                const float ra = rsqrtf(wave_sum(ssa) * (1.f / D) + EPS), rb = rsqrtf(wave_sum(ssb) * (1.f / D) + EPS);
                float la[16], lb[16];
#pragma unroll
                for (int e = 0; e < 16; ++e) { la[e] = 0.f; lb[e] = 0.f; }
#pragma unroll
                for (int j = 0; j < 4; ++j) {
                    const int col = j * 256 + lane * 4;
                    const f32x4 oa = va[j] * ra * ca[j] + cb[j], ob = vb[j] * rb * ca[j] + cb[j];
                    pg8::u32x2 w; w.x = pk2(oa[0], oa[1]); w.y = pk2(oa[2], oa[3]); *(pg8::u32x2*)(Hb + (size_t)rowa * D + col) = w;
                    w.x = pk2(ob[0], ob[1]); w.y = pk2(ob[2], ob[3]); *(pg8::u32x2*)(Hb + (size_t)rowb * D + col) = w;
#pragma unroll
                    for (int i = 0; i < 4; ++i) {
                        const LAS f32x4* wr = (const LAS f32x4*)(lds + RING_OFF + ((j * 4 + i) * 64 + lane) * 80);
#pragma unroll
                        for (int e4 = 0; e4 < 4; ++e4) { const f32x4 wv = wr[e4];
#pragma unroll
                            for (int e = 0; e < 4; ++e) { la[e4 * 4 + e] = fmaf(oa[i], wv[e], la[e4 * 4 + e]); lb[e4 * 4 + e] = fmaf(ob[i], wv[e], lb[e4 * 4 + e]); } }
                        __builtin_amdgcn_sched_barrier(0);
                    }
                }
#define FOLD_STEP(arr, n, mask) do { const bool hi_ = (lane & (mask)) != 0; _Pragma("unroll") for (int k_ = 0; k_ < (n); ++k_) { \
            const float send_ = hi_ ? arr[k_] : arr[(n) + k_], keep_ = hi_ ? arr[(n) + k_] : arr[k_]; arr[k_] = keep_ + __shfl_xor(send_, (mask)); } } while (0)
                FOLD_STEP(la, 8, 32); FOLD_STEP(lb, 8, 32); FOLD_STEP(la, 4, 16); FOLD_STEP(lb, 4, 16); FOLD_STEP(la, 2, 8); FOLD_STEP(lb, 2, 8); FOLD_STEP(la, 1, 4); FOLD_STEP(lb, 1, 4);
#undef FOLD_STEP
                float xa = la[0], xb = lb[0];
                xa += __shfl_xor(xa, 2); xb += __shfl_xor(xb, 2); xa += __shfl_xor(xa, 1); xb += __shfl_xor(xb, 1);
                float ma = xa, mb = xb;
#pragma unroll
                for (int o = 4; o < 64; o <<= 1) { ma = fmaxf(ma, __shfl_xor(ma, o)); mb = fmaxf(mb, __shfl_xor(mb, o)); }
                const float ea = expf(xa - ma), eb = expf(xb - mb); float sua = ea, sub = eb;
#pragma unroll
                for (int o = 4; o < 64; o <<= 1) { sua += __shfl_xor(sua, o); sub += __shfl_xor(sub, o); }
                if ((lane & 3) == 0) { const int e = ((lane >> 5) & 1) * 8 + ((lane >> 4) & 1) * 4 + ((lane >> 3) & 1) * 2 + ((lane >> 2) & 1);
                    float* ap = AFF + (size_t)((rowa >> 13) * 16 + e) * SEQ + (rowa & (SEQ - 1)); ap[0] = ea / sua; ap[1] = eb / sub; }
            }
        }
        if (BOTH(9)) xcd_barrier(bar);
    }
    TEND(9);
    TBEG(10);
    if (IN(10)) for (int rep_ = 0; rep_ <= ((PROBE_MASK >> 10) & 1) * PROBE_REPS; ++rep_) {
        const bool split = G >= 64;
        if (!split || bx >= 32) {
            const int w2 = split ? (bx - 32) * NWAVES + wave : bx * NWAVES + wave, NW2 = (split ? G - 32 : G) * NWAVES;
            LAS float* scr = (LAS float*)(lds + RING_OFF + wave * 16384);
            auto mk = [&](int it) { const int e = it >> 10, which = (it >> 9) & 1; return TItem{(which ? args.in[I_WEU] : args.in[I_WEG]) + (size_t)e * 1048576, (bf16*)(ws + (e < WGU_NLO ? WS_WGU : WS_WGU_HI)) + (size_t)(e < WGU_NLO ? e : e - WGU_NLO) * 2097152, 1024, 1024, it & 511}; };
            int it = (G > 128 ? WGU_NLO * 1024 : 0) + w2; f32x4 lda[8], ldb[8];
            if (it < 16 * 2 * 512) titem_load(mk(it), lda, lane);
            while (it < 16 * 2 * 512) {
                const int itn = it + NW2, it2 = itn + NW2;
                if (itn < 16 * 2 * 512) titem_load(mk(itn), ldb, lane);
                if ((it >> 9) & 1) titem_finish<3>(mk(it), lda, scr, lane); else titem_finish<2>(mk(it), lda, scr, lane);
                if (itn >= 16 * 2 * 512) break;
                if (it2 < 16 * 2 * 512) titem_load(mk(it2), lda, lane);
                if ((itn >> 9) & 1) titem_finish<3>(mk(itn), ldb, scr, lane); else titem_finish<2>(mk(itn), ldb, scr, lane);
                it = it2;
            }
        }
        if (split) { if (bx < 32) topk_select(ws, lds_raw, bx, tid, lane, wave); }
        else { __syncthreads(); for (int be = bx; be < 32; be += G) topk_select(ws, lds_raw, be, tid, lane, wave); }
        if (BOTH(10)) xcd_barrier(bar);
    }
    TEND(10);
    TBEG(12);
    if (IN(12)) for (int rep_ = 0; rep_ <= ((PROBE_MASK >> 12) & 1) * PROBE_REPS; ++rep_) {
        pg8::Gemm g{Hb, (const bf16*)(ws + WS_WGU), 32768, 2048, 1024};
        pg8::ExpertOrder<8> S; S.init(G, bx, WGU_NLO, WGU_HI_PN);
        pg8::EpiHid E{(bf16*)(ws + WS_HID)};
        pg8::gemm_phase<pg8::EpiHid, pg8::ExpertOrder<8>, true, true, pg8::ExpertGather>(lds + RING_OFF, g, S, E, pg8::ExpertGather{(const int*)(ws + WS_IDX)});
        SEAM(12, 4u);
    }
    TEND(12);
    TBEG(13);
    if (IN(13)) for (int rep_ = 0; rep_ <= ((PROBE_MASK >> 13) & 1) * PROBE_REPS; ++rep_) {
        pg8::Gemm g{(const bf16*)(ws + WS_HID), (const bf16*)(ws + WS_WD), 32768, 1024, 1024};
        pg8::ExpertOrder<4> S; S.init(G, bx);
        pg8::EpiDown E{(const float*)(ws + WS_GSEL), (bf16*)(ws + WS_XE)};
        pg8::gemm_phase<pg8::EpiDown, pg8::ExpertOrder<4>, true>(lds + RING_OFF, g, S, E);
        if (BOTH(13)) xcd_barrier(bar);
    }
    TEND(13);
    TBEG(14);
    if (IN(14)) for (int rep_ = 0; rep_ <= ((PROBE_MASK >> 14) & 1) * PROBE_REPS; ++rep_) {
        const int* SLOT = (const int*)(ws + WS_SLOT); const bf16* Y = (const bf16*)(ws + WS_XE);
        for (int blk = gw; blk < MLAT / 8; blk += NGW) {
            const int row0 = blk * 8, b = row0 >> 13, t0 = row0 & 8191;
            const int sv0 = SLOT[(b * 16 + (lane & 15)) * 8192 + t0 + (lane >> 4)], sv1 = SLOT[(b * 16 + (lane & 15)) * 8192 + t0 + 4 + (lane >> 4)];
            f32x4 cg[4];
#pragma unroll
            for (int j = 0; j < 4; ++j) cg[j] = *(const f32x4*)((const float*)(ws + WS_MODF) + b * 6144 + 5120 + j * 256 + lane * 4);
#pragma unroll 1
            for (int rp = 0; rp < 4; ++rp) {
                const int sv = rp < 2 ? sv0 : sv1, lbase = (rp & 1) * 32;
                unsigned mask = (unsigned)__builtin_amdgcn_readfirstlane((int)(unsigned)(__ballot(sv >= 0) >> lbase));
                float* oa = args.out + (size_t)(row0 + 2 * rp) * D + lane * 4; float* ob = oa + D;
                f32x4 xa[4], xb[4], aa[4], ab[4];
#pragma unroll
                for (int j = 0; j < 4; ++j) { const size_t off = (size_t)(row0 + 2 * rp) * D + lane * 4 + j * 256;
                    const bf16* dr = (const bf16*)args.out + DR_OFF + (size_t)(row0 + 2 * rp) * DR_LD + lane * 4 + j * 256;
                    const pg8::u32x2 wa = *(const pg8::u32x2*)dr, wb = *(const pg8::u32x2*)(dr + DR_LD);
                    xa[j] = *(const f32x4*)(args.in[I_X] + off) + (f32x4){__uint_as_float(wa.x << 16), __uint_as_float(wa.x & 0xffff0000u), __uint_as_float(wa.y << 16), __uint_as_float(wa.y & 0xffff0000u)};
                    xb[j] = *(const f32x4*)(args.in[I_X] + off + D) + (f32x4){__uint_as_float(wb.x << 16), __uint_as_float(wb.x & 0xffff0000u), __uint_as_float(wb.y << 16), __uint_as_float(wb.y & 0xffff0000u)};
                    aa[j] = (f32x4){0.f, 0.f, 0.f, 0.f}; ab[j] = aa[j]; }
                for (;;) {
                    const bf16* p[4]; float fa[4], fb[4];
#pragma unroll
                    for (int q = 0; q < 4; ++q) {
                        if (mask) { const int bit = __builtin_ctz(mask); mask &= mask - 1u; const int s = __builtin_amdgcn_readlane(sv, lbase + bit), e = bit & 15;
                            p[q] = Y + ((size_t)(b * 16 + e) * 1024 + s) * D; fa[q] = bit < 16 ? 1.f : 0.f; fb[q] = 1.f - fa[q]; }
                        else { p[q] = Y; fa[q] = 0.f; fb[q] = 0.f; }
                    }
                    pg8::u32x2 w[4][4];
#pragma unroll
                    for (int q = 0; q < 4; ++q)
#pragma unroll
                        for (int j = 0; j < 4; ++j) w[q][j] = *(const pg8::u32x2*)(p[q] + j * 256 + lane * 4);
#pragma unroll
                    for (int q = 0; q < 4; ++q)
#pragma unroll
                        for (int j = 0; j < 4; ++j) { const f32x4 v = {__uint_as_float(w[q][j].x << 16), __uint_as_float(w[q][j].x & 0xffff0000u), __uint_as_float(w[q][j].y << 16), __uint_as_float(w[q][j].y & 0xffff0000u)};
                            aa[j] += v * fa[q]; ab[j] += v * fb[q]; }
                    if (!mask) break;
                }
#pragma unroll
                for (int j = 0; j < 4; ++j) { *(f32x4*)(oa + j * 256) = xa[j] + cg[j] * aa[j]; *(f32x4*)(ob + j * 256) = xb[j] + cg[j] * ab[j]; }
            }
        }
    }
    TEND(14);
#if defined(TIME_MASK)
    if (bx == 0 && tid == 0) { const unsigned long long te_ = __builtin_amdgcn_s_memrealtime(); while (__builtin_amdgcn_s_memrealtime() - te_ < tacc_) __builtin_amdgcn_s_sleep(4); }
#endif
#undef IN
#undef BOTH
}
extern "C" void kernel_launch(void* const* d_in, const int* in_sizes, int n_in, void* d_out, int out_size, void* d_ws, size_t ws_size, hipStream_t stream) {
    static int grid = 0;
    if (grid == 0) {
        if (n_in != 29 || ws_size < WS_END) { fprintf(stderr, "kernel_launch: bad arguments (n_in %d, ws %zu)\n", n_in, ws_size); grid = -1; return; }
        int dev = 0, cus = 0;
        if (hipGetDevice(&dev) != hipSuccess || hipDeviceGetAttribute(&cus, hipDeviceAttributeMultiprocessorCount, dev) != hipSuccess) { grid = -1; return; }
        if (hipFuncSetAttribute((const void*)mega, hipFuncAttributeMaxDynamicSharedMemorySize, LDS_BYTES) != hipSuccess) { fprintf(stderr, "kernel_launch: hipFuncSetAttribute failed\n"); grid = -1; return; }
        (void)hipGetLastError();
        grid = cus;
    }
    if (grid < 0) return;
    float* out = (float*)d_out; unsigned char* ws = (unsigned char*)d_ws;
    (void)hipMemsetAsync(ws + WS_CTL, 0, CTL_ZERO_BYTES, stream);
    Args a{};
    for (int i = 0; i < 29; ++i) a.in[i] = (const float*)d_in[i];
    a.out = out; a.ws = ws;
#if defined(PROBE_LO)
    a.ph_lo = 0; a.ph_hi = PROBE_HI; a.li = 0;
    hipLaunchKernelGGL(mega, dim3(grid), dim3(NWAVES * 64), LDS_BYTES, stream, a);
    a.ph_lo = PROBE_LO; a.ph_hi = PROBE_HI; a.li = 1;
    hipLaunchKernelGGL(mega, dim3(grid), dim3(NWAVES * 64), LDS_BYTES, stream, a);
    a.ph_lo = PROBE_HI; a.ph_hi = 15; a.li = 2;
    hipLaunchKernelGGL(mega, dim3(grid), dim3(NWAVES * 64), LDS_BYTES, stream, a);
#elif defined(PER_PHASE)
    for (int k = 0; k < 15; ++k) { if (k == 11) continue; a.ph_lo = k; a.ph_hi = k + 1; a.li = 0; hipLaunchKernelGGL(mega, dim3(grid), dim3(NWAVES * 64), LDS_BYTES, stream, a); }
#else
    a.ph_lo = 0; a.ph_hi = 15; a.li = 0;
    hipLaunchKernelGGL(mega, dim3(grid), dim3(NWAVES * 64), LDS_BYTES, stream, a);
#endif
}
```
